# Optimizing an MI355X kernel written in HIP

```python
import math
import jax
import jax.numpy as jnp
from jax import lax
import numpy as np

D_MODEL = 2048
BATCH = 4
SEQ = 4096
DEPTH = 4

N_A_LAYERS = DEPTH // 2
N_B_LAYERS = DEPTH - N_A_LAYERS
HEAD_DIM = 128
ROT_DIM = HEAD_DIM // 4
ROPE_THETA = 500000.0
NORM_EPS = 1e-6
NEG_INF = -1e30
A_PATTERNS = ((128, 1), (512, 4), (2048, 16))
N_A_GROUPS = len(A_PATTERNS)
A_HEADS = 8
A_GROUP_WIDTH = A_HEADS * HEAD_DIM
A_QKV_WIDTH = N_A_GROUPS * 3 * A_GROUP_WIDTH
BAND_BLOCK = 128
B_HEADS = 8
B_QK_WIDTH = B_HEADS * 2 * HEAD_DIM
B_V_DIM = 2 * HEAD_DIM
B_V_WIDTH = B_HEADS * B_V_DIM
Q_BLOCK = 128
D_FF = 4 * D_MODEL
N_MOD = 6

kernel_name = "yoco_dilated_diffattn_adaln_trunk"


def rms_norm(t, gain):
    t32 = t.astype(jnp.float32)
    y = t32 * lax.rsqrt(jnp.mean(t32 * t32, axis=-1, keepdims=True) + NORM_EPS)
    return (y * gain.astype(jnp.float32)).astype(t.dtype)


def modulate(h, shift, scale):
    return h * (1.0 + scale[:, None, :]) + shift[:, None, :]


def rope_tables(positions):
    inv_freq = ROPE_THETA ** (-jnp.arange(0, ROT_DIM, 2, dtype=jnp.float32) / ROT_DIM)
    ang = positions.astype(jnp.float32)[..., None] * inv_freq
    return jnp.cos(ang)[:, :, None, :], jnp.sin(ang)[:, :, None, :]


def apply_rope(t, cos, sin):
    half = ROT_DIM // 2
    cos = cos.astype(t.dtype)
    sin = sin.astype(t.dtype)
    t1 = t[..., :half]
    t2 = t[..., half:ROT_DIM]
    return jnp.concatenate([t1 * cos - t2 * sin, t2 * cos + t1 * sin, t[..., ROT_DIM:]], axis=-1)


def rope_pairs(t, cos, sin):
    b, s, h, two, e = t.shape
    return apply_rope(t.reshape(b, s, h * two, e), cos, sin).reshape(b, s, h, two, e)


def dilated_window_attention(q, k, v, window, dilation):
    bsz, seq, heads, hd = q.shape
    sub_len = seq // dilation
    sub_win = window // dilation
    n_blk = -(-sub_len // BAND_BLOCK)
    pad = n_blk * BAND_BLOCK - sub_len

    def to_blocks(t):
        e = t.shape[-1]
        t = t.reshape(bsz, sub_len, dilation, heads, e).transpose(0, 2, 1, 3, 4)
        t = jnp.pad(t, ((0, 0), (0, 0), (0, pad), (0, 0), (0, 0)))
        return t.reshape(bsz, dilation, n_blk, BAND_BLOCK, heads, e)

    def with_prev(t):
        prev = jnp.pad(t[:, :, :-1], ((0, 0), (0, 0), (1, 0), (0, 0), (0, 0), (0, 0)))
        return jnp.concatenate([prev, t], axis=3)

    def from_blocks(t):
        e = t.shape[-1]
        t = t.reshape(bsz, dilation, n_blk * BAND_BLOCK, heads, e)[:, :, :sub_len]
        return t.transpose(0, 2, 1, 3, 4).reshape(bsz, seq, heads, e)

    qb = to_blocks(q)
    kb = with_prev(to_blocks(k))
    vb = with_prev(to_blocks(v))
    s = jnp.einsum('brnqhe,brnkhe->brnhqk', qb, kb,
                   preferred_element_type=jnp.float32) * (hd ** -0.5)
    qi = jnp.arange(BAND_BLOCK)[:, None]
    ki = jnp.arange(2 * BAND_BLOCK)[None, :]
    dist = BAND_BLOCK + qi - ki
    kpos = jnp.arange(n_blk)[:, None, None] * BAND_BLOCK - BAND_BLOCK + ki[None]
    valid = (dist >= 0) & (dist <= sub_win) & (kpos >= 0)
    s = jnp.where(valid[:, None], s, NEG_INF)
    m = jnp.max(s, axis=-1, keepdims=True)
    p = jnp.exp(s - m)
    den = jnp.sum(p, axis=-1, keepdims=True)
    o = jnp.einsum('brnhqk,brnkhe->brnqhe', p.astype(v.dtype), vb,
                   preferred_element_type=jnp.float32)
    o = o / jnp.swapaxes(den, 3, 4)
    lse = jnp.swapaxes(m + jnp.log(den), 3, 4)
    return from_blocks(o), from_blocks(lse)[..., 0]


def mixer_a(h, cos, sin, w_qkv, q_gain, k_gain, w_o):
    bsz, seq, _ = h.shape
    qkv = (h @ w_qkv).reshape(bsz, seq, N_A_GROUPS, 3, A_HEADS, HEAD_DIM)
    outs, lses = [], []
    for g, (window, dilation) in enumerate(A_PATTERNS):
        q = apply_rope(rms_norm(qkv[:, :, g, 0], q_gain[g]), cos, sin)
        k = apply_rope(rms_norm(qkv[:, :, g, 1], k_gain[g]), cos, sin)
        o, lse = dilated_window_attention(q, k, qkv[:, :, g, 2], window, dilation)
        outs.append(o)
        lses.append(lse)
    alpha = jax.nn.softmax(jnp.stack(lses), axis=0)
    o = jnp.sum(alpha[..., None] * jnp.stack(outs), axis=0)
    return o.reshape(bsz, seq, A_GROUP_WIDTH).astype(h.dtype) @ w_o


def shared_kv(x, c_act, w_ada, b_ada, g, w_k, w_v, k_gain, cos, sin):
    bsz, seq, _ = x.shape
    shift, scale = jnp.split(c_act @ w_ada + b_ada, 2, axis=-1)
    h = modulate(rms_norm(x, g), shift, scale)
    k = rms_norm((h @ w_k).reshape(bsz, seq, B_HEADS, 2, HEAD_DIM), k_gain)
    k = rope_pairs(k, cos, sin)
    v = (h @ w_v).reshape(bsz, seq, B_HEADS, B_V_DIM)
    return k, v


def differential_attention(q, k, v, lam):
    bsz, seq, heads, _, hd = q.shape
    n_blk = seq // Q_BLOCK
    qb = jnp.swapaxes(q.reshape(bsz, n_blk, Q_BLOCK, heads, 2, hd), 0, 1)
    kpos = jnp.arange(seq)

    def block(args):
        q_blk, i = args
        s = jnp.einsum('bqhce,bkhce->bhcqk', q_blk, k,
                       preferred_element_type=jnp.float32) * (hd ** -0.5)
        qpos = i * Q_BLOCK + jnp.arange(Q_BLOCK)
        s = jnp.where(kpos[None, :] <= qpos[:, None], s, NEG_INF)
        p = jax.nn.softmax(s, axis=-1)
        a = p[:, :, 0] - lam * p[:, :, 1]
        return jnp.einsum('bhqk,bkhe->bqhe', a.astype(v.dtype), v,
                          preferred_element_type=jnp.float32)

    o = lax.map(block, (qb, jnp.arange(n_blk)))
    return jnp.swapaxes(o, 0, 1).reshape(bsz, seq, heads, 2 * hd)


def mixer_b(h, k, v, cos, sin, w_q, q_gain, lam_params, subln_g, w_o, lam_init):
    bsz, seq, _ = h.shape
    q = rope_pairs(rms_norm((h @ w_q).reshape(bsz, seq, B_HEADS, 2, HEAD_DIM), q_gain), cos, sin)
    lp = lam_params.astype(jnp.float32)
    lam = jnp.exp(jnp.sum(lp[0] * lp[1])) - jnp.exp(jnp.sum(lp[2] * lp[3])) + lam_init
    o = differential_attention(q, k, v, lam)
    o = rms_norm(o, subln_g) * (1.0 - lam_init)
    return o.reshape(bsz, seq, B_V_WIDTH).astype(h.dtype) @ w_o


def sq_relu_mlp(h, w1, w2):
    return jnp.square(jax.nn.relu(h @ w1)) @ w2


def setup_inputs(seed: int = 0) -> dict:
    key = jax.random.key(seed)
    ks = jax.random.split(key, 24)
    f32 = jnp.float32
    nrm = lambda k, shape, std: jax.random.normal(k, shape, f32) * std
    ada_std = 0.5 * D_MODEL ** -0.5
    x = nrm(ks[0], (BATCH, SEQ, D_MODEL), 1.0)
    c = nrm(ks[1], (BATCH, D_MODEL), 1.0)
    positions = (jnp.arange(SEQ, dtype=jnp.int32)[None, :]
                 + jax.random.randint(ks[2], (BATCH, 1), 0, 4096, dtype=jnp.int32))
    ada_w = nrm(ks[3], (DEPTH, D_MODEL, N_MOD * D_MODEL), ada_std)
    ada_b = nrm(ks[4], (DEPTH, N_MOD * D_MODEL), 0.01)
    norm_g = 1.0 + nrm(ks[5], (DEPTH, 2, D_MODEL), 0.02)
    a_w_qkv = nrm(ks[6], (N_A_LAYERS, D_MODEL, A_QKV_WIDTH), D_MODEL ** -0.5)
    a_q_gain = 1.0 + nrm(ks[7], (N_A_LAYERS, N_A_GROUPS, HEAD_DIM), 0.02)
    a_k_gain = 1.0 + nrm(ks[8], (N_A_LAYERS, N_A_GROUPS, HEAD_DIM), 0.02)
    a_w_o = nrm(ks[9], (N_A_LAYERS, A_GROUP_WIDTH, D_MODEL), A_GROUP_WIDTH ** -0.5)
    kv_ada_w = nrm(ks[10], (D_MODEL, 2 * D_MODEL), ada_std)
    kv_ada_b = nrm(ks[11], (2 * D_MODEL,), 0.01)
    kv_norm_g = 1.0 + nrm(ks[12], (D_MODEL,), 0.02)
    kv_w_k = nrm(ks[13], (D_MODEL, B_QK_WIDTH), D_MODEL ** -0.5)
    kv_w_v = nrm(ks[14], (D_MODEL, B_V_WIDTH), D_MODEL ** -0.5)
    kv_k_gain = 1.0 + nrm(ks[15], (2, HEAD_DIM), 0.02)
    b_w_q = nrm(ks[16], (N_B_LAYERS, D_MODEL, B_QK_WIDTH), D_MODEL ** -0.5)
    b_q_gain = 1.0 + nrm(ks[17], (N_B_LAYERS, 2, HEAD_DIM), 0.02)
    b_lambda = nrm(ks[18], (N_B_LAYERS, 4, HEAD_DIM), 0.1)
    b_subln_g = 1.0 + nrm(ks[19], (N_B_LAYERS, B_V_DIM), 0.02)
    b_w_o = nrm(ks[20], (N_B_LAYERS, B_V_WIDTH, D_MODEL), B_V_WIDTH ** -0.5)
    mlp_w1 = nrm(ks[21], (DEPTH, D_MODEL, D_FF), D_MODEL ** -0.5)
    mlp_w2 = nrm(ks[22], (DEPTH, D_FF, D_MODEL), D_FF ** -0.5)
    return {"x": x, "c": c, "positions": positions, "ada_w": ada_w, "ada_b": ada_b,
            "norm_g": norm_g, "a_w_qkv": a_w_qkv, "a_q_gain": a_q_gain, "a_k_gain": a_k_gain,
            "a_w_o": a_w_o, "kv_ada_w": kv_ada_w, "kv_ada_b": kv_ada_b, "kv_norm_g": kv_norm_g,
            "kv_w_k": kv_w_k, "kv_w_v": kv_w_v, "kv_k_gain": kv_k_gain, "b_w_q": b_w_q,
            "b_q_gain": b_q_gain, "b_lambda": b_lambda, "b_subln_g": b_subln_g, "b_w_o": b_w_o,
            "mlp_w1": mlp_w1, "mlp_w2": mlp_w2}


def reference(x, c, positions, ada_w, ada_b, norm_g, a_w_qkv, a_q_gain, a_k_gain, a_w_o,
              kv_ada_w, kv_ada_b, kv_norm_g, kv_w_k, kv_w_v, kv_k_gain, b_w_q, b_q_gain,
              b_lambda, b_subln_g, b_w_o, mlp_w1, mlp_w2):
    c_act = jax.nn.silu(c)
    cos, sin = rope_tables(positions)
    k_sh = v_sh = None
    for layer in range(DEPTH):
        if layer == N_A_LAYERS:
            k_sh, v_sh = shared_kv(x, c_act, kv_ada_w, kv_ada_b, kv_norm_g, kv_w_k, kv_w_v,
                                   kv_k_gain, cos, sin)
        mod = c_act @ ada_w[layer] + ada_b[layer]
        shift_t, scale_t, gate_t, shift_m, scale_m, gate_m = jnp.split(mod, N_MOD, axis=-1)
        h = modulate(rms_norm(x, norm_g[layer, 0]), shift_t, scale_t)
        if layer < N_A_LAYERS:
            y = mixer_a(h, cos, sin, a_w_qkv[layer], a_q_gain[layer], a_k_gain[layer], a_w_o[layer])
        else:
            j = layer - N_A_LAYERS
            lam_init = 0.8 - 0.6 * math.exp(-0.3 * layer)
            y = mixer_b(h, k_sh, v_sh, cos, sin, b_w_q[j], b_q_gain[j], b_lambda[j],
                        b_subln_g[j], b_w_o[j], lam_init)
        x = x + gate_t[:, None, :] * y
        h = modulate(rms_norm(x, norm_g[layer, 1]), shift_m, scale_m)
        x = x + gate_m[:, None, :] * sq_relu_mlp(h, mlp_w1[layer], mlp_w2[layer])
    return x
```

```cpp
#include <hip/hip_runtime.h>
#include <hip/hip_bf16.h>
#include <cstdio>
#include <cstdint>
#include <cmath>
namespace pg8 {
#define PG8_LAS __attribute__((address_space(3)))
typedef unsigned short bf16_t;
typedef short bf16x8 __attribute__((ext_vector_type(8)));
typedef float f32x4 __attribute__((ext_vector_type(4)));
typedef unsigned u32x4 __attribute__((ext_vector_type(4)));
constexpr int BM = 256, BK = 64, HALF = 128, HTB = HALF * BK * 2  , STAGE_BYTES = 8 * HTB, NXCD = 8, WGM = 8;

__host__ __device__ __forceinline__ int lds_byte(int r, int c) { const int st = (r >> 4) * 2 + (c >> 5), rr = r & 15, cc = c & 31, ob = rr * 64 + cc * 2; return st * 1024 + (ob ^ (((ob >> 9) & 1) << 5)); }
__host__ __device__ __forceinline__ void stage_rc(int b, int& R, int& C) { const int st = b / 1024, sb = b % 1024, swz = sb ^ (((sb >> 9) & 1) << 5); R = (st >> 1) * 16 + swz / 64; C = (st & 1) * 32 + (swz % 64) / 2; }
__host__ __device__ __forceinline__ int perm32(int rho) { const int n = rho >> 4, i = rho & 15; return 8 * (i >> 2) + 4 * n + (i & 3); }

struct Unit { int pm, pn; };
struct Gemm { const bf16_t* A; const bf16_t* Bt; int M, N, K; };

struct StaticOrder {
    int nM, nN, nwg, G, c;
    __host__ __device__ void init(int M, int N, int G_, int c_) { nM = M / BM; nN = N / BM; nwg = nM * nN; G = G_; c = c_; }
    __host__ __device__ bool next(int i, Unit& u) const {
        const long L = (long)i * G + c; if (L >= nwg) return false;
        int wgid = (int)L; { const int q = nwg / NXCD, r = nwg % NXCD, xcd = wgid % NXCD, off = wgid / NXCD; wgid = (xcd < r ? xcd * (q + 1) : r * (q + 1) + (xcd - r) * q) + off; }
        const int nig = WGM * nN, gid = wgid / nig, fm = gid * WGM, gsz = (nM - fm) < WGM ? (nM - fm) : WGM;
        u.pm = fm + ((wgid % nig) % gsz); u.pn = (wgid % nig) / gsz; return true;
    }
    __device__ __forceinline__ void a_ready(const Unit&) const {}
    __device__ __forceinline__ void done(const Unit&) const {}
};


__device__ __forceinline__ unsigned cvt_pk_bf16(float lo, float hi) { unsigned r; asm volatile("v_cvt_pk_bf16_f32 %0, %1, %2" : "=v"(r) : "v"(lo), "v"(hi)); return r; }

template <int ACT  > struct EpiBf16 {
    static constexpr bool PERM = true, AFTER_DRAIN = false;
    bf16_t* O; int ldc;
    __device__ __forceinline__ void operator()(const f32x4 (&acc)[2][2][4][2], const Unit& u, int wr, int wc, int fr, int fq) const {
        const int row0 = u.pm * BM + wr * 64 + fr; const int col0 = u.pn * BM + wc * 32 + 8 * fq;
#pragma unroll
        for (int ai = 0; ai < 2; ++ai)
#pragma unroll
            for (int m = 0; m < 4; ++m) { bf16_t* rowp = O + (size_t)(row0 + ai * HALF + m * 16) * ldc + col0;
#pragma unroll
                for (int bj = 0; bj < 2; ++bj) { f32x4 v0 = acc[ai][bj][m][0], v1 = acc[ai][bj][m][1];
                    if (ACT == 1) {
#pragma unroll
                        for (int e = 0; e < 4; ++e) { const float a = fmaxf(v0[e], 0.f), b = fmaxf(v1[e], 0.f); v0[e] = a * a; v1[e] = b * b; } }
                    u32x4 w; w.x = cvt_pk_bf16(v0[0], v0[1]); w.y = cvt_pk_bf16(v0[2], v0[3]); w.z = cvt_pk_bf16(v1[0], v1[1]); w.w = cvt_pk_bf16(v1[2], v1[3]);
                    *(u32x4*)(rowp + bj * HALF) = w; } }
    }
};

struct EpiRes {
    static constexpr bool PERM = false, AFTER_DRAIN = false;
    const float* base; float* out; int ldc; const float* gate; int gate_bstride; int rows_per_batch;
    __device__ __forceinline__ void operator()(const f32x4 (&acc)[2][2][4][2], const Unit& u, int wr, int wc, int fr, int fq) const {
        const int row0 = u.pm * BM + wr * 64 + fr, col0 = u.pn * BM + wc * 32 + 4 * fq;
        const float* gp = gate + (size_t)((u.pm * BM) / rows_per_batch) * gate_bstride + col0;
        f32x4 gv[2][2];
#pragma unroll
        for (int bj = 0; bj < 2; ++bj)
#pragma unroll
            for (int n = 0; n < 2; ++n) gv[bj][n] = *(const f32x4*)(gp + bj * HALF + n * 16);
#pragma unroll
        for (int ai = 0; ai < 2; ++ai)
#pragma unroll
            for (int m = 0; m < 4; ++m) { const size_t off = (size_t)(row0 + ai * HALF + m * 16) * ldc + col0;
#pragma unroll
                for (int bj = 0; bj < 2; ++bj)
#pragma unroll
                    for (int n = 0; n < 2; ++n) { const f32x4 bs = *(const f32x4*)(base + off + bj * HALF + n * 16);
                        *(f32x4*)(out + off + bj * HALF + n * 16) = bs + gv[bj][n] * acc[ai][bj][m][n]; }
                if (m & 1) asm volatile("" ::: "memory"); }
    }
};

template <class Epi, class Sched, bool ALIGN_EPI = false, bool SP2 = false>
__device__ __forceinline__ void gemm_phase(PG8_LAS unsigned char* lds, const Gemm g, const Sched& S, const Epi& E, const int tid  ) {
    const int wid = __builtin_amdgcn_readfirstlane(tid >> 6), lane = tid & 63, wr = wid >> 2, wc = wid & 3, fr = lane & 15, fq = lane >> 4;
    const int K = g.K, nt = K / BK;
    unsigned voffA[2], voffB[2];
#pragma unroll
    for (int i = 0; i < 2; ++i) { int R, C; stage_rc(tid * 16 + i * 8192, R, C); const int Rb = Epi::PERM ? ((R & ~31) + perm32(R & 31)) : R;
        voffA[i] = (unsigned)(R * K + C) * 2u; voffB[i] = (unsigned)(Rb * K + C) * 2u; }
    const size_t kstep = (size_t)(BK * 2);
    const size_t hstep = (size_t)HALF * K * 2;
    const size_t tstep = 2 * hstep;
    const unsigned ldsw = (unsigned)wid * 1024u;
    const int aoff = lds_byte(wr * 64 + fr, fq * 8), boff = lds_byte(wc * 32 + fr, fq * 8);
#define PG8_SA(b, h) (((b) * 2 + (h)) * HTB)
#define PG8_SB(b, h) ((4 + (b) * 2 + (h)) * HTB)
#define PG8_STAGE(bufoff, gbase, voff) do { _Pragma("unroll") for (int _i = 0; _i < 2; ++_i) \
        __builtin_amdgcn_global_load_lds((const unsigned*)((const char*)(gbase) + (voff)[_i]), (PG8_LAS unsigned*)(lds + (bufoff) + ldsw + _i * 8192), 16, 0, 0); } while (0)
#define PG8_LDA(dst, b, h) do { _Pragma("unroll") for (int m = 0; m < 4; ++m) _Pragma("unroll") for (int k = 0; k < 2; ++k) dst[m][k] = *(const PG8_LAS bf16x8*)(lds + PG8_SA(b, h) + aoff + m * 2048 + k * 1024); } while (0)
#define PG8_LDB(dst, b, h) do { _Pragma("unroll") for (int n = 0; n < 2; ++n) _Pragma("unroll") for (int k = 0; k < 2; ++k) dst[n][k] = *(const PG8_LAS bf16x8*)(lds + PG8_SB(b, h) + boff + n * 2048 + k * 1024); } while (0)
#define PG8_MMA(ai, bj, At, Bt) do { __builtin_amdgcn_s_setprio(1); _Pragma("unroll") for (int m = 0; m < 4; ++m) _Pragma("unroll") for (int n = 0; n < 2; ++n) _Pragma("unroll") for (int k = 0; k < 2; ++k) \
        acc[ai][bj][m][n] = __builtin_amdgcn_mfma_f32_16x16x32_bf16(Bt[n][k], At[m][k], acc[ai][bj][m][n], 0, 0, 0); __builtin_amdgcn_s_setprio(0); } while (0)
#define PG8_WAIT_V(n) asm volatile("s_waitcnt vmcnt(" #n ")" ::: "memory")
#define PG8_WAIT_L(n) asm volatile("s_waitcnt lgkmcnt(" #n ")" ::: "memory")
#define PG8_BAR __builtin_amdgcn_s_barrier()
#define PG8_SCHED __builtin_amdgcn_sched_barrier(0)
    Unit cur, nxt; int ui = 0;
    if (!S.next(0, cur)) return;
    f32x4 acc[2][2][4][2];
#pragma unroll
    for (int a = 0; a < 2; ++a)
#pragma unroll
        for (int b = 0; b < 2; ++b)
#pragma unroll
            for (int m = 0; m < 4; ++m)
#pragma unroll
                for (int n = 0; n < 2; ++n) acc[a][b][m][n] = (f32x4){0.f, 0.f, 0.f, 0.f};
    bf16x8 At[4][2], B0[2][2], B1[2][2];
    const char* cA = (const char*)g.A + (size_t)cur.pm * tstep; const char* cB = (const char*)g.Bt + (size_t)cur.pn * tstep;
    S.a_ready(cur);
    if constexpr (SP2) {
        PG8_STAGE(PG8_SB(0, 0), cB, voffB); PG8_STAGE(PG8_SB(0, 1), cB + hstep, voffB); PG8_STAGE(PG8_SA(0, 0), cA, voffA); PG8_STAGE(PG8_SA(0, 1), cA + hstep, voffA);
        if (wr == 1) PG8_BAR;
        PG8_WAIT_V(2); PG8_BAR;
        PG8_STAGE(PG8_SB(1, 0), cB + kstep, voffB); PG8_STAGE(PG8_SA(1, 0), cA + kstep, voffA); PG8_STAGE(PG8_SB(1, 1), cB + hstep + kstep, voffB);
        PG8_WAIT_V(6); PG8_BAR;
    } else {
        PG8_STAGE(PG8_SB(0, 0), cB, voffB); PG8_STAGE(PG8_SA(0, 0), cA, voffA); PG8_STAGE(PG8_SB(0, 1), cB + hstep, voffB); PG8_STAGE(PG8_SA(0, 1), cA + hstep, voffA);
        if (wr == 1) PG8_BAR;
        PG8_WAIT_V(4); PG8_BAR;
        PG8_STAGE(PG8_SB(1, 0), cB + kstep, voffB); PG8_STAGE(PG8_SA(1, 0), cA + kstep, voffA); PG8_STAGE(PG8_SB(1, 1), cB + hstep + kstep, voffB);
        PG8_WAIT_V(6); PG8_BAR;
    }
    for (;;) {
        const bool has_next = S.next(ui + 1, nxt);
        const char* nA = has_next ? (const char*)g.A + (size_t)nxt.pm * tstep : cA; const char* nB = has_next ? (const char*)g.Bt + (size_t)nxt.pn * tstep : cB;
        for (int t = 0; t < nt; t += 2) {
            const bool last = (t == nt - 2);
            const char* a1 = cA + (size_t)(t + 1) * kstep;
            const char* a2 = last ? nA : cA + (size_t)(t + 2) * kstep; const char* b2 = last ? nB : cB + (size_t)(t + 2) * kstep;
            const char* a3 = a2 + kstep; const char* b3 = b2 + kstep;
            if (last && has_next) S.a_ready(nxt);
            if constexpr (SP2) {
            PG8_LDB(B0, 0, 0); PG8_LDB(B1, 0, 1); PG8_SCHED; PG8_LDA(At, 0, 0); PG8_STAGE(PG8_SA(1, 1), a1 + hstep, voffA);
            PG8_WAIT_V(8); PG8_WAIT_L(0); PG8_BAR; PG8_MMA(0, 0, At, B0); PG8_MMA(0, 1, At, B1); PG8_BAR; PG8_SCHED;
            PG8_LDA(At, 0, 1); PG8_STAGE(PG8_SB(0, 0), b2, voffB); PG8_STAGE(PG8_SB(0, 1), b2 + hstep, voffB); PG8_STAGE(PG8_SA(0, 0), a2, voffA);
            PG8_WAIT_V(8); PG8_WAIT_L(0); PG8_BAR; PG8_MMA(1, 0, At, B0); PG8_MMA(1, 1, At, B1); PG8_BAR; PG8_SCHED;
            PG8_LDB(B0, 1, 0); PG8_LDB(B1, 1, 1); PG8_SCHED; PG8_LDA(At, 1, 0); PG8_STAGE(PG8_SA(0, 1), a2 + hstep, voffA);
            PG8_WAIT_V(8); PG8_WAIT_L(0); PG8_BAR; PG8_MMA(0, 0, At, B0); PG8_MMA(0, 1, At, B1); PG8_BAR; PG8_SCHED;
            PG8_LDA(At, 1, 1); PG8_STAGE(PG8_SB(1, 0), b3, voffB); PG8_STAGE(PG8_SB(1, 1), b3 + hstep, voffB); PG8_STAGE(PG8_SA(1, 0), a3, voffA);
            PG8_WAIT_V(8); PG8_WAIT_L(0); PG8_BAR; PG8_MMA(1, 0, At, B0); PG8_MMA(1, 1, At, B1); PG8_BAR; PG8_SCHED;
            } else {
            PG8_LDB(B0, 0, 0); PG8_SCHED; PG8_LDA(At, 0, 0); PG8_STAGE(PG8_SA(1, 1), a1 + hstep, voffA);
            PG8_WAIT_L(8); PG8_BAR; PG8_WAIT_L(0); PG8_MMA(0, 0, At, B0); PG8_BAR; PG8_SCHED;
            PG8_LDB(B1, 0, 1); PG8_STAGE(PG8_SB(0, 0), b2, voffB);
            PG8_BAR; PG8_WAIT_L(0); PG8_MMA(0, 1, At, B1); PG8_BAR;
            PG8_LDA(At, 0, 1); PG8_STAGE(PG8_SA(0, 0), a2, voffA);
            PG8_BAR; PG8_WAIT_L(0); PG8_MMA(1, 0, At, B0); PG8_BAR; PG8_SCHED;
            PG8_STAGE(PG8_SB(0, 1), b2 + hstep, voffB);
            PG8_WAIT_V(6); PG8_BAR; PG8_MMA(1, 1, At, B1); PG8_BAR;
            PG8_LDB(B0, 1, 0); PG8_SCHED; PG8_LDA(At, 1, 0); PG8_STAGE(PG8_SA(0, 1), a2 + hstep, voffA);
            PG8_WAIT_L(8); PG8_BAR; PG8_WAIT_L(0); PG8_MMA(0, 0, At, B0); PG8_BAR; PG8_SCHED;
            PG8_LDB(B1, 1, 1); PG8_STAGE(PG8_SB(1, 0), b3, voffB);
            PG8_BAR; PG8_WAIT_L(0); PG8_MMA(0, 1, At, B1); PG8_BAR;
            PG8_LDA(At, 1, 1); PG8_STAGE(PG8_SA(1, 0), a3, voffA);
            PG8_BAR; PG8_WAIT_L(0); PG8_MMA(1, 0, At, B0); PG8_BAR; PG8_SCHED;
            PG8_STAGE(PG8_SB(1, 1), b3 + hstep, voffB);
            PG8_WAIT_V(6); PG8_BAR; PG8_MMA(1, 1, At, B1); PG8_BAR;
            }
        }
        if constexpr (ALIGN_EPI) { if (wr == 0) PG8_BAR; }
        if constexpr (!Epi::AFTER_DRAIN) { E(acc, cur, wr, wc, fr, fq); S.done(cur); }
        if (!has_next) break;
#pragma unroll
        for (int a = 0; a < 2; ++a)
#pragma unroll
            for (int b = 0; b < 2; ++b)
#pragma unroll
                for (int m = 0; m < 4; ++m)
#pragma unroll
                    for (int n = 0; n < 2; ++n) acc[a][b][m][n] = (f32x4){0.f, 0.f, 0.f, 0.f};
        cur = nxt; cA = nA; cB = nB; ++ui;
        if constexpr (ALIGN_EPI) { if (wr == 1) PG8_BAR; }
    }
    PG8_WAIT_V(0);
    if constexpr (!ALIGN_EPI) { if (wr == 0) PG8_BAR; }
    PG8_BAR;
    if constexpr (Epi::AFTER_DRAIN) { E.fused(acc, cur, wr, wc, fr, fq, lds, wid, lane); S.done(cur); }
#undef PG8_SA
#undef PG8_SB
#undef PG8_STAGE
#undef PG8_LDA
#undef PG8_LDB
#undef PG8_MMA
#undef PG8_WAIT_V
#undef PG8_WAIT_L
#undef PG8_BAR
#undef PG8_SCHED
}
}
namespace swa {
using bf16 = __hip_bfloat16;
constexpr int D = 128;
constexpr float SCALE = 0.08838834764831845f;
constexpr float THR = 8.f;
constexpr int NW = 8, QBLK = 32, KVBLK = 64, QB = NW * QBLK;
constexpr int SHM_V = KVBLK * D * 2, SHM_K = KVBLK * D * 2;
constexpr int LDS_BYTES = 2 * SHM_V + 2 * SHM_K + NW * 64 * 4;

typedef short bf16x8 __attribute__((ext_vector_type(8)));
typedef short s16x4 __attribute__((ext_vector_type(4)));
typedef float f32x16 __attribute__((ext_vector_type(16)));
typedef float f32x4 __attribute__((ext_vector_type(4)));
typedef unsigned u32x4 __attribute__((ext_vector_type(4)));

#define KSWZ(row, colB) ((row) * 256 + ((colB) ^ (((row) & 7) << 4)))
#define SBAR() __builtin_amdgcn_sched_barrier(0)
__device__ __forceinline__ int v_st(int k, int c) { const int kk = (k & ~0xC) | ((k & 4) << 1) | ((k & 8) >> 1); return ((kk >> 3) * 4 + (c >> 5)) * 512 + ((kk & 7) * 32 + (c & 31)) * 2; }
__device__ __forceinline__ int v_rd_base(int lane) { return ((lane & 3) << 3) | (((lane >> 2) & 3) << 6) | (((lane >> 4) & 1) << 5) | (((lane >> 5) & 1) << 8); }
constexpr int v_rd_off(int d0, int ks, int half) { return d0 * 512 + ks * 4096 + half * 2048; }
__device__ __forceinline__ int crow(int r, int hi) { return (r & 3) + 8 * (r >> 2) + 4 * hi; }
__device__ __forceinline__ unsigned cvtpk(float lo, float hi) {
    unsigned r; asm volatile("v_cvt_pk_bf16_f32 %0, %1, %2" : "=v"(r) : "v"(lo), "v"(hi)); return r;
}
__device__ __forceinline__ bf16x8 load8(const bf16* p) { return *reinterpret_cast<const bf16x8*>(p); }
__device__ __forceinline__ void mask_tile(f32x16& p0, f32x16& p1, int dq, unsigned W) {
    const float NEG = -__builtin_inff();
#pragma unroll
    for (int r = 0; r < 16; ++r) {
        const int c = (r & 3) + 8 * (r >> 2);
        if ((unsigned)(dq - c) >= W) p0[r] = NEG;
        if ((unsigned)(dq - c - 32) >= W) p1[r] = NEG;
    }
}
__device__ __forceinline__ void partialSM(f32x16& p0, f32x16& p1, float& m_reg, float& mn, float& alpha) {
    float pmax = p0[0]; for (int r = 1; r < 16; ++r) pmax = fmaxf(pmax, p0[r]); for (int r = 0; r < 16; ++r) pmax = fmaxf(pmax, p1[r]);
    { auto rr = __builtin_amdgcn_permlane32_swap(__float_as_uint(pmax), __float_as_uint(pmax), false, false);
      pmax = fmaxf(__uint_as_float(rr[0]), __uint_as_float(rr[1])); }
    constexpr float C2 = 1.4426950408889634f * SCALE;
    if (__builtin_expect(__all((pmax - m_reg) * SCALE <= THR), 1)) { mn = m_reg; alpha = 1.f; }
    else { mn = fmaxf(m_reg, pmax); alpha = __builtin_amdgcn_exp2f((m_reg - mn) * C2); m_reg = mn; }
    const float mnL = -mn * C2;
    for (int r = 0; r < 16; ++r) p0[r] = fmaf(p0[r], C2, mnL); for (int r = 0; r < 16; ++r) p1[r] = fmaf(p1[r], C2, mnL);
    for (int r = 0; r < 16; ++r) p0[r] = __builtin_amdgcn_exp2f(p0[r]);
}
__device__ __forceinline__ void finishSM(f32x16& p0, f32x16& p1, float alpha, float& l_reg, bf16x8& pa0, bf16x8& pa1, bf16x8& pa2, bf16x8& pa3) {
    for (int r = 0; r < 16; ++r) p1[r] = __builtin_amdgcn_exp2f(p1[r]);
    float ps = 0; for (int r = 0; r < 16; ++r) ps += p0[r]; for (int r = 0; r < 16; ++r) ps += p1[r];
    { auto rr = __builtin_amdgcn_permlane32_swap(__float_as_uint(ps), __float_as_uint(ps), false, false);
      ps = __uint_as_float(rr[0]) + __uint_as_float(rr[1]); }
    l_reg = l_reg * alpha + ps;
#define PK4(P, B_, OUT) do { unsigned a0 = cvtpk(P[B_+0], P[B_+1]), a1 = cvtpk(P[B_+2], P[B_+3]);                          \
        unsigned b0 = cvtpk(P[B_+4], P[B_+5]), b1 = cvtpk(P[B_+6], P[B_+7]);                                             \
        auto r0 = __builtin_amdgcn_permlane32_swap(a0, b0, false, false); auto r1 = __builtin_amdgcn_permlane32_swap(a1, b1, false, false); \
        u32x4 w = {r0[0], r1[0], r0[1], r1[1]}; OUT = *reinterpret_cast<bf16x8*>(&w); } while (0)
    PK4(p0, 0, pa0); PK4(p0, 8, pa1); PK4(p1, 0, pa2); PK4(p1, 8, pa3);
#undef PK4
}
template <int KB, bool SK>
__device__ __forceinline__ void qkt(f32x16& p0, f32x16& p1, const char* K_lds, int r32, int hi, const bf16x8* qr, bool act) {
    if (SK && !act) { const float NEG = -__builtin_inff();
#pragma unroll
        for (int r = 0; r < 16; ++r) { p0[r] = NEG; p1[r] = NEG; } return; }
    p0 = f32x16{}; p1 = f32x16{};
    const char* kb[4];
#pragma unroll
    for (int dd = 0; dd < 4; ++dd) kb[dd] = K_lds + KB * SHM_K + KSWZ(r32, (dd * 16 + hi * 8) * 2);
#pragma unroll
    for (int d0 = 0; d0 < 8; ++d0) { const char* a = kb[d0 & 3] + (d0 >> 2) * 128;
        bf16x8 b0 = *reinterpret_cast<const bf16x8*>(a);
        bf16x8 b1 = *reinterpret_cast<const bf16x8*>(a + 32 * 256);
        p0 = __builtin_amdgcn_mfma_f32_32x32x16_bf16(b0, qr[d0], p0, 0, 0, 0);
        p1 = __builtin_amdgcn_mfma_f32_32x32x16_bf16(b1, qr[d0], p1, 0, 0, 0); }
}
template <int VB, bool SK>
__device__ __forceinline__ void pv_tile(f32x16* o, int vb0, bf16x8 pa0, bf16x8 pa1, bf16x8 pa2, bf16x8 pa3, bool act) {
    if (SK && !act) return;
#define TRRD(dst, off) asm volatile("ds_read_b64_tr_b16 %0, %1 offset:%2" : "=&v"(dst) : "v"(vb0), "i"(off) : "memory")
#define PV_D0(d0) do { s16x4 l0, l1, l2, l3, h0, h1, h2, h3; constexpr int b_ = VB * SHM_V + v_rd_off(d0, 0, 0);     \
        TRRD(l0, b_); TRRD(h0, b_ + 2048); TRRD(l1, b_ + 4096); TRRD(h1, b_ + 6144); TRRD(l2, b_ + 8192); TRRD(h2, b_ + 10240); TRRD(l3, b_ + 12288); TRRD(h3, b_ + 14336); \
        asm volatile("s_waitcnt lgkmcnt(0)" ::: "memory"); SBAR();                 \
        o[d0] = __builtin_amdgcn_mfma_f32_32x32x16_bf16(pa0, (bf16x8){l0[0], l0[1], l0[2], l0[3], h0[0], h0[1], h0[2], h0[3]}, o[d0], 0, 0, 0);   \
        o[d0] = __builtin_amdgcn_mfma_f32_32x32x16_bf16(pa1, (bf16x8){l1[0], l1[1], l1[2], l1[3], h1[0], h1[1], h1[2], h1[3]}, o[d0], 0, 0, 0);   \
        o[d0] = __builtin_amdgcn_mfma_f32_32x32x16_bf16(pa2, (bf16x8){l2[0], l2[1], l2[2], l2[3], h2[0], h2[1], h2[2], h2[3]}, o[d0], 0, 0, 0);   \
        o[d0] = __builtin_amdgcn_mfma_f32_32x32x16_bf16(pa3, (bf16x8){l3[0], l3[1], l3[2], l3[3], h3[0], h3[1], h3[2], h3[3]}, o[d0], 0, 0, 0); } while (0)
    PV_D0(0); PV_D0(1); PV_D0(2); PV_D0(3);
#undef PV_D0
#undef TRRD
}

struct BlockRef { const bf16* Q; const bf16* K; const bf16* V; float* O; float* L; int qs, kvs, os, ls, P0, skv; };
struct Seam {
    bf16x8 qr[8];
    bf16x8 st_v0, st_v1, st_k0, st_k1;
};
__device__ __forceinline__ int swa_jlo(int P0, int W) { const int lowk = P0 - W + 1; return lowk > 0 ? lowk / KVBLK : 0; }
#define ROWP(p, st, k0) ((p) + (size_t)(k0) * (size_t)(st))
#define VMW() asm volatile("s_waitcnt vmcnt(0)" ::: "memory")
#define VMWN(n) asm volatile("s_waitcnt vmcnt(%0)" :: "i"(n) : "memory")
#define SLOAD_H(Kp, Vp, st, k0) do { const bf16* kp_ = ROWP(Kp, st, k0); const bf16* vp_ = ROWP(Vp, st, k0); const unsigned o0_ = (unsigned)(sr * (st) + sc), o1_ = o0_ + 32u * (unsigned)(st); \
                         S.st_v0 = load8(vp_ + o0_); S.st_v1 = load8(vp_ + o1_); S.st_k0 = load8(kp_ + o0_); S.st_k1 = load8(kp_ + o1_); } while (0)
#define SWRITE_HK(bf) do { *(bf16x8*)(K_lds + (bf) * SHM_K + kws) = S.st_k0; *(bf16x8*)(K_lds + (bf) * SHM_K + kws + 32 * 256) = S.st_k1; } while (0)
#define SWRITE_HV(bf) do { *(bf16x8*)(V_lds + (bf) * SHM_V + vst0) = S.st_v0; *(bf16x8*)(V_lds + (bf) * SHM_V + vst1) = S.st_v1; } while (0)
#define SWRITE_H(bf) do { SWRITE_HV(bf); SWRITE_HK(bf); } while (0)
__device__ __forceinline__ void causal_swa_prime(const BlockRef& cur, int W, char* lds, Seam& S, int tid) {
    const int wid = __builtin_amdgcn_readfirstlane(tid >> 6), lane = tid & 63, r32 = lane & 31, hi = lane >> 5;
    const int sr = tid >> 4, sc = (tid & 15) * 8, kws = KSWZ(sr, sc * 2); char* K_lds = lds + 2 * SHM_V;
    const int kb0 = swa_jlo(cur.P0, W) * KVBLK;
    { const unsigned qo_ = (unsigned)((wid * QBLK + r32) * cur.qs + hi * 8);
    for (int d0 = 0; d0 < 8; ++d0) S.qr[d0] = load8(cur.Q + qo_ + d0 * 16); }
    SLOAD_H(cur.K, cur.V, cur.kvs, kb0); VMW(); SWRITE_HK(0);
    __syncthreads();
}
template <bool WSK>
__device__ __forceinline__ void causal_swa_block(const BlockRef& cur, const BlockRef& nxt, int W, char* lds, Seam& S, int tid) {
    const int wid = __builtin_amdgcn_readfirstlane(tid >> 6), lane = tid & 63, r32 = lane & 31, hi = lane >> 5;
    const int skv = cur.skv;
    const int j_lo = swa_jlo(cur.P0, W);
    int j_hi = (cur.P0 + QB - 1) / KVBLK + 1; if (j_hi > skv / KVBLK) j_hi = skv / KVBLK;
    const int NT = j_hi - j_lo;
    const int kbn = swa_jlo(nxt.P0, W) * KVBLK;
    const int qlo = cur.P0 + wid * QBLK, qm = qlo + r32 - 4 * hi;
    char* V_lds = lds; char* K_lds = lds + 2 * SHM_V;
    float* ws = (float*)(lds + 2 * SHM_V + 2 * SHM_K) + wid * 64; float* li_l = ws, * al_l = ws + 32;
    float m_reg = -1e30f, l_reg = 0; f32x16 o[4] = {};
    const int sr = tid >> 4, sc = (tid & 15) * 8, vst0 = v_st(sr, sc), vst1 = v_st(32 + sr, sc), kws = KSWZ(sr, sc * 2);
    const int vb0 = (int)(uintptr_t)V_lds + v_rd_base(lane);
    const bf16* Kh = cur.K; const bf16* Vh = cur.V; const int kvs = cur.kvs;
#define RESC(a) do { if (__any((a) < 1.f)) { if (hi == 0) al_l[r32] = (a); asm volatile("s_waitcnt lgkmcnt(0)" ::: "memory");              \
                     for (int d_ = 0; d_ < 4; ++d_) for (int r = 0; r < 16; ++r) o[d_][r] *= al_l[crow(r, hi)]; } } while (0)
#define KBASE(t) ((j_lo + (t)) * KVBLK)
#define ACT(t) (KBASE(t) <= qlo + QBLK - 1 && KBASE(t) + KVBLK - 1 >= qlo - W + 1)
#define MASKT(P0_, P1_, t) do { const int kb_ = KBASE(t); if ((!SK || ACT(t)) && (kb_ + KVBLK - 1 > qlo || kb_ <= qlo + QBLK - 1 - W)) mask_tile(P0_, P1_, qm - kb_, (unsigned)W); } while (0)
    constexpr int NQL = 8;
    constexpr bool SK = WSK;
#define SEAM_K0() do { VMWN(NQL); SWRITE_HK(0); SBAR(); } while (0)
    f32x16 pA0, pA1, pB0, pB1; float mnA, mnB, alA, alB; bf16x8 pa0, pa1, pa2, pa3;
    SWRITE_HV(0); SBAR();
    if (NT > 1) { SLOAD_H(Kh, Vh, kvs, KBASE(1)); }
    SBAR(); qkt<0, SK>(pA0, pA1, K_lds, r32, hi, S.qr, ACT(0));
    MASKT(pA0, pA1, 0); partialSM(pA0, pA1, m_reg, mnA, alA);
    if (NT > 1) { VMW(); SWRITE_H(1); }
    __syncthreads();
#define HALF_STEP(PX0, PX1, mnX, alX, PY0, PY1, alY, t, KB, VB, SB) do {                                                      \
        SBAR(); qkt<KB, SK>(PX0, PX1, K_lds, r32, hi, S.qr, ACT(t));                                             \
        finishSM(PY0, PY1, alY, l_reg, pa0, pa1, pa2, pa3); SBAR();                                                           \
        if ((t) + 1 < NT) { SLOAD_H(Kh, Vh, kvs, KBASE((t) + 1)); SBAR(); }                                               \
        pv_tile<VB, SK>(o, vb0, pa0, pa1, pa2, pa3, ACT((t) - 1)); MASKT(PX0, PX1, (t)); partialSM(PX0, PX1, m_reg, mnX, alX);                                        \
        __syncthreads();                                                                                                      \
        if ((t) + 1 < NT) { VMW(); SWRITE_H(SB); }                                                                          \
        RESC(alX); __syncthreads(); } while (0)
    for (int t = 1; t + 1 < NT; t += 2) {
        HALF_STEP(pB0, pB1, mnB, alB, pA0, pA1, alA, t, 1, 0, 0);
        HALF_STEP(pA0, pA1, mnA, alA, pB0, pB1, alB, t + 1, 0, 1, 1);
    }
    const bool even = (NT & 1) == 0;
    if (even) { SBAR(); qkt<1, SK>(pB0, pB1, K_lds, r32, hi, S.qr, ACT(NT - 1)); SBAR(); }
    { SLOAD_H(nxt.K, nxt.V, nxt.kvs, kbn); SBAR();
#pragma unroll
        for (int d0 = 0; d0 < 8; ++d0) S.qr[d0] = load8(nxt.Q + (unsigned)((wid * QBLK + r32) * nxt.qs + hi * 8) + d0 * 16); }
    SBAR();
    finishSM(pA0, pA1, alA, l_reg, pa0, pa1, pa2, pa3); SBAR();
    pv_tile<0, SK>(o, vb0, pa0, pa1, pa2, pa3, ACT(even ? NT - 2 : NT - 1));
    if (even) { MASKT(pB0, pB1, NT - 1); partialSM(pB0, pB1, m_reg, mnB, alB); __syncthreads(); RESC(alB);
        finishSM(pB0, pB1, alB, l_reg, pa0, pa1, pa2, pa3); SBAR(); pv_tile<1, SK>(o, vb0, pa0, pa1, pa2, pa3, ACT(NT - 1)); }
    SBAR(); SEAM_K0();
    if (hi == 0) li_l[r32] = l_reg; asm volatile("s_waitcnt lgkmcnt(0)" ::: "memory");
    if (cur.L != nullptr && hi == 0) cur.L[(unsigned)((wid * QBLK + r32) * cur.ls)] = m_reg * SCALE + __logf(l_reg);
    float rli[16];
#pragma unroll
    for (int r = 0; r < 16; ++r) rli[r] = __builtin_amdgcn_rcpf(li_l[crow(r, hi)]);
    float* Ow = cur.O + (size_t)(wid * QBLK) * (size_t)cur.os;
#pragma unroll
    for (int r = 0; r < 16; ++r) { const int orow = crow(r, hi);
#pragma unroll
        for (int d0 = 0; d0 < 4; ++d0) { const float v = o[d0][r] * rli[r];
            Ow[(unsigned)(orow * cur.os + d0 * 32 + r32)] = v; } }
    __syncthreads();
#undef RESC
#undef KBASE
#undef ACT
#undef MASKT
#undef SEAM_K0
#undef HALF_STEP
}
#undef ROWP
#undef VMW
#undef VMWN
#undef SLOAD_H
#undef SWRITE_HK
#undef SWRITE_HV
#undef SWRITE_H
#undef KSWZ
#undef SBAR
}
#define GAS __attribute__((address_space(1)))
#define LAS __attribute__((address_space(3)))
typedef unsigned short bf16;
typedef unsigned v4u __attribute__((ext_vector_type(4)));
typedef float f32x4 __attribute__((ext_vector_type(4)));
typedef short bf16x8 __attribute__((ext_vector_type(8)));
typedef GAS unsigned gu32;
typedef GAS unsigned long long gu64;
#define RLX_AGENT __ATOMIC_RELAXED, __HIP_MEMORY_SCOPE_AGENT
#define LDS_WAIT() asm volatile("s_waitcnt lgkmcnt(0)" ::: "memory")
#define VM_WAIT() asm volatile("s_waitcnt vmcnt(0)" ::: "memory")
__device__ __forceinline__ unsigned long long rt() { return __builtin_amdgcn_s_memrealtime(); }
__device__ __forceinline__ unsigned f2bf(float f) { unsigned u = __builtin_bit_cast(unsigned, f); return (u + 0x7fffu + ((u >> 16) & 1u)) >> 16; }
__device__ __forceinline__ unsigned pk2(float lo, float hi) { return f2bf(lo) | (f2bf(hi) << 16); }

#define XB_TMO      128
#define XB_XCNT(j)  (256  + 64 * (j))
#define XB_XSUB(j)  (1280 + 64 * (j))
#define XB_XGEN(j)  (2304 + 64 * (j))
#define XB_TOP      3328
#define XB_TOPGEN   3392
#define XCD_BAR_WORDS 3456
#define XB_SPIN_CAP (1u << 18)

__device__ __forceinline__ unsigned xb_ld(unsigned* p)              { return __hip_atomic_load(p, __ATOMIC_RELAXED, __HIP_MEMORY_SCOPE_AGENT); }
__device__ __forceinline__ unsigned xb_add(unsigned* p, unsigned v) { return __hip_atomic_fetch_add(p, v, __ATOMIC_RELAXED, __HIP_MEMORY_SCOPE_AGENT); }
__device__ __forceinline__ unsigned xb_xcc_id() { return (unsigned)__builtin_amdgcn_s_getreg((3 << 11) | 20) & 0xFu; }
#define XB_SPIN(cond, bar) do { unsigned _sp = 0; while (cond) { __builtin_amdgcn_s_sleep(1); \
    if ((++_sp & 255u) == 0u) { if (xb_ld(&(bar)[XB_TMO])) break; if (_sp > XB_SPIN_CAP) { atomicAdd(&(bar)[XB_TMO], 1u); break; } } } } while (0)

struct XcdBarrier {
    unsigned* bar; unsigned x;
    volatile LAS unsigned* st;
};

__device__ __forceinline__ XcdBarrier xcd_barrier_post(unsigned* bar, volatile LAS unsigned* st, bool leader  ) {
    XcdBarrier b; b.bar = bar; b.x = xb_xcc_id(); b.st = st;
    if (leader) (void)xb_add(&bar[XB_XCNT(b.x)], 1u);
    return b;
}
__device__ __forceinline__ void xcd_barrier_complete(unsigned* bar, unsigned x, unsigned& nloc, unsigned& nx) {
    const unsigned G = gridDim.x * gridDim.y * gridDim.z;
    unsigned sum, cnt, mine, sp = 0u;
    for (;;) {
        sum = 0u; cnt = 0u; mine = 0u;
#pragma unroll
        for (unsigned j = 0; j < 16; ++j) { const unsigned c = xb_ld(&bar[XB_XCNT(j)]); sum += c; cnt += (c > 0u) ? 1u : 0u; mine = (j == x) ? c : mine; }
        if (sum == G) break;
        __builtin_amdgcn_s_sleep(1);
        if ((++sp & 255u) == 0u) { if (xb_ld(&bar[XB_TMO])) break; if (sp > XB_SPIN_CAP) { atomicAdd(&bar[XB_TMO], 1u); break; } }
    }
    nloc = mine > 0u ? mine : 1u; nx = cnt > 0u ? cnt : 1u;
}

__device__ __forceinline__ void xcd_barrier(const XcdBarrier& b, bool leader  ) {
    asm volatile("s_waitcnt vmcnt(0)" ::: "memory");
    __syncthreads();
    if (leader) {
        unsigned* bar = b.bar;
        __builtin_amdgcn_s_waitcnt(0);
        unsigned nloc = b.st[0], nx = b.st[1];
        if (nloc == 0u) { xcd_barrier_complete(bar, b.x, nloc, nx); b.st[0] = nloc; b.st[1] = nx; }
        const unsigned old = xb_add(&bar[XB_XSUB(b.x)], 1u);
        const unsigned gen = old / nloc;
        if (old + 1u == (gen + 1u) * nloc) {
            __builtin_amdgcn_fence(__ATOMIC_RELEASE, "agent");
            asm volatile("s_waitcnt vmcnt(0)" ::: "memory");
            const unsigned og = xb_add(&bar[XB_TOP], 1u);
            const unsigned tg = og / nx;
            if (og + 1u == (tg + 1u) * nx) xb_add(&bar[XB_TOPGEN], 1u);
            else XB_SPIN(xb_ld(&bar[XB_TOPGEN]) == tg, bar);
            __builtin_amdgcn_fence(__ATOMIC_ACQUIRE, "agent");
            xb_add(&bar[XB_XGEN(b.x)], 1u);
            asm volatile("s_waitcnt vmcnt(0)" ::: "memory");
        } else {
            XB_SPIN(xb_ld(&bar[XB_XGEN(b.x)]) == gen, bar);
            __builtin_amdgcn_fence(__ATOMIC_ACQUIRE, "agent");
            asm volatile("s_waitcnt vmcnt(0)" ::: "memory");
        }
    }
    __syncthreads();
}

constexpr int NWAVES = 8;
#ifndef MK_ONE_LAUNCH
#define MK_ONE_LAUNCH 0
#endif

constexpr int BATCH = 4, SEQ = 4096, DM = 2048, M = BATCH * SEQ, HD = 128;
constexpr int NQKV_A = 9216, AGW = 1024, DFF = 8192, NMOD = 6 * DM, NKV = 2 * DM;
constexpr float NORM_EPS = 1e-6f;
constexpr int N_STAGE = 5;
constexpr int N_PHASE = 41;

constexpr size_t MiB = 1u << 20;
constexpr size_t WS_CTL = 0, CTL_ZERO_BYTES = 1 * MiB;
constexpr size_t WS_MOD = 1 * MiB;
constexpr size_t WS_COS = 2 * MiB, WS_SIN = 3 * MiB;
constexpr size_t WS_LA = 4 * MiB;
constexpr size_t WS_MODP = 8 * MiB;
constexpr size_t WS_WQKVA = 40 * MiB;
constexpr size_t WS_WOA = 112 * MiB;
constexpr size_t WS_WKV = 120 * MiB;
constexpr size_t WS_WQB = 136 * MiB;
constexpr size_t WS_WOB = 152 * MiB;
constexpr size_t WS_W1 = 168 * MiB;
constexpr size_t WS_W2 = 296 * MiB;
constexpr size_t WS_H = 424 * MiB;
constexpr size_t WS_AO = 488 * MiB;
constexpr size_t WS_KVB = 552 * MiB;
constexpr size_t WS_QKV = 680 * MiB;
constexpr size_t WS_OP = 968 * MiB;
constexpr size_t WS_END = 1224 * MiB;
constexpr int MOD_TOTAL = 4 * BATCH * NMOD + BATCH * NKV;
constexpr int MOD_KV_OFF = 4 * BATCH * NMOD;
constexpr int GEMV_KC = 32, GEMV_KLEN = DM / GEMV_KC;
constexpr int CW_BAR = 4096;

constexpr int RING_OFF = 0, RING_BYTES = 131072;
constexpr int LDSCTL_OFF = RING_BYTES, MISC_OFF = LDSCTL_OFF + 320;
constexpr int LDS_BYTES = 147456;


struct Args {
    const float* x; const float* c; const int* pos; const float* ada_w; const float* ada_b; const float* norm_g;
    const float* a_w_qkv; const float* a_q_gain; const float* a_k_gain; const float* a_w_o;
    const float* kv_ada_w; const float* kv_ada_b; const float* kv_norm_g; const float* kv_w_k; const float* kv_w_v; const float* kv_k_gain;
    const float* b_w_q; const float* b_q_gain; const float* b_lambda; const float* b_subln_g; const float* b_w_o;
    const float* mlp_w1; const float* mlp_w2;
    float* out; unsigned char* ws;
    float inv_freq[16]; float lam_init[2];
    int ph_lo, ph_hi;
};
static_assert(sizeof(Args) == 25 * 8 + 16 * 4 + 2 * 4 + 2 * 4, "Args has no padding bytes");
typedef __attribute__((address_space(4))) const Args* ArgsP;
__device__ __forceinline__ ArgsP get_args() { ArgsP p = (ArgsP)__builtin_amdgcn_kernarg_segment_ptr(); asm volatile("" : "+s"(p)); return p; }
struct Ctx { int tid, lane, wave, G, bx, vcu, gw, NGW; };
__device__ __forceinline__ Ctx fresh_ctx(int wave_s) {
    Ctx c; int ln; asm volatile("v_mbcnt_lo_u32_b32 %0, -1, 0\n\tv_mbcnt_hi_u32_b32 %0, -1, %0" : "=v"(ln));     const int t = wave_s * 64 + ln;
    int G = gridDim.x, bx = blockIdx.x; asm volatile("" : "+s"(G), "+s"(bx));
    c.tid = t; c.lane = t & 63; c.wave = __builtin_amdgcn_readfirstlane(t >> 6); c.G = G; c.bx = bx;
    c.vcu = (G % 8 == 0) ? (bx % 8) * (G / 8) + bx / 8 : bx;
    c.gw = c.vcu * 8 + c.wave; c.NGW = G * 8; return c;
}

typedef unsigned short bfu;
typedef unsigned u32x2 __attribute__((ext_vector_type(2)));

__device__ __forceinline__ float shx(float v, int o, int lane) { return __int_as_float(__builtin_amdgcn_ds_bpermute((lane ^ o) << 2, __float_as_int(v))); }
__device__ __forceinline__ float wave_sum(float v, int lane) {
#pragma unroll
    for (int o = 1; o < 64; o <<= 1) v += shx(v, o, lane);
    return v;
}
__device__ __forceinline__ float bf2f(unsigned bits16) { return __uint_as_float(bits16 << 16); }
__device__ __forceinline__ unsigned pkbf(float lo, float hi) { return pg8::cvt_pk_bf16(lo, hi); }

__device__ __forceinline__ void transpose_item(const float* __restrict__ W, int K, int N, bfu* __restrict__ WT, int item, int lane) {
    const int nb = N >> 6, kb = item / nb, nbi = item - kb * nb, k0 = kb << 6, n0 = nbi << 6;
    const float* src = W + (size_t)k0 * N + n0 + lane;
    float v[64];
#pragma unroll
    for (int i = 0; i < 64; ++i) v[i] = src[(size_t)i * N];
    bfu* dst = WT + (size_t)(n0 + lane) * K + k0;
#pragma unroll
    for (int kk = 0; kk < 8; ++kk) { v4u o; o.x = pkbf(v[8 * kk + 0], v[8 * kk + 1]); o.y = pkbf(v[8 * kk + 2], v[8 * kk + 3]); o.z = pkbf(v[8 * kk + 4], v[8 * kk + 5]); o.w = pkbf(v[8 * kk + 6], v[8 * kk + 7]);
        *(v4u*)(dst + 8 * kk) = o; }
}

__device__ __forceinline__ void p0_prologue(ArgsP a, LAS unsigned char* lds, int tid, int lane, int wave, int vcu, int G) {
    unsigned char* ws = a->ws;
    LAS float* cact = (LAS float*)lds;
    LAS float* ifr = (LAS float*)(lds + 32768);
    for (int i = tid; i < BATCH * DM; i += NWAVES * 64) { const int b = i / DM, k = i - b * DM; const float v = a->c[i]; cact[k * 4 + b] = v / (1.f + expf(-v)); }
    if (tid == 0) {
        ifr[0] = a->inv_freq[0]; ifr[1] = a->inv_freq[1]; ifr[2] = a->inv_freq[2]; ifr[3] = a->inv_freq[3]; ifr[4] = a->inv_freq[4]; ifr[5] = a->inv_freq[5]; ifr[6] = a->inv_freq[6]; ifr[7] = a->inv_freq[7];
        ifr[8] = a->inv_freq[8]; ifr[9] = a->inv_freq[9]; ifr[10] = a->inv_freq[10]; ifr[11] = a->inv_freq[11]; ifr[12] = a->inv_freq[12]; ifr[13] = a->inv_freq[13]; ifr[14] = a->inv_freq[14]; ifr[15] = a->inv_freq[15];
    }
    __syncthreads();
    const int gw = vcu * NWAVES + wave, NGW = G * NWAVES;
    {
        constexpr int ITEMS_L = (NMOD / 256) * GEMV_KC, ITEMS_KV = (NKV / 256) * GEMV_KC, NITEMS = 4 * ITEMS_L + ITEMS_KV;
        float* MODP = (float*)(ws + WS_MODP);
        for (int it = gw; it < NITEMS; it += NGW) {
            const float* W; int N, slab, kc, moff;
            if (it < 4 * ITEMS_L) { const int l = it / ITEMS_L, r = it - l * ITEMS_L; slab = r / GEMV_KC; kc = r - slab * GEMV_KC; W = a->ada_w + (size_t)l * DM * NMOD; N = NMOD; moff = l * BATCH * NMOD; }
            else { const int r = it - 4 * ITEMS_L; slab = r / GEMV_KC; kc = r - slab * GEMV_KC; W = a->kv_ada_w; N = NKV; moff = MOD_KV_OFF; }
            const int n0 = slab * 256 + lane * 4, k0 = kc * GEMV_KLEN;
            f32x4 acc0 = {0.f, 0.f, 0.f, 0.f}, acc1 = acc0, acc2 = acc0, acc3 = acc0;
            const float* wp = W + (size_t)k0 * N + n0;
#pragma unroll 16
            for (int k = 0; k < GEMV_KLEN; ++k) {
                const f32x4 w = *(const f32x4*)(wp + (size_t)k * N);
                const f32x4 cv = *(const LAS f32x4*)(cact + (k0 + k) * 4);
                acc0 += w * cv.x; acc1 += w * cv.y; acc2 += w * cv.z; acc3 += w * cv.w;
            }
            float* mp = MODP + (size_t)kc * MOD_TOTAL + moff + n0;
            *(f32x4*)(mp) = acc0; *(f32x4*)(mp + N) = acc1; *(f32x4*)(mp + 2 * N) = acc2; *(f32x4*)(mp + 3 * N) = acc3;
        }
    }
    {
        float* cosT = (float*)(ws + WS_COS); float* sinT = (float*)(ws + WS_SIN);
        for (int i = vcu * (NWAVES * 64) + tid; i < M * 16; i += G * NWAVES * 64) {
            const int row = i >> 4, j = i & 15; const float ang = (float)a->pos[row] * ifr[j];
            cosT[i] = cosf(ang); sinT[i] = sinf(ang); }
    }
    {
        bfu* WQKVA = (bfu*)(ws + WS_WQKVA); bfu* WOA = (bfu*)(ws + WS_WOA); bfu* WKV = (bfu*)(ws + WS_WKV); bfu* WQB = (bfu*)(ws + WS_WQB); bfu* WOB = (bfu*)(ws + WS_WOB);
        bfu* W1 = (bfu*)(ws + WS_W1); bfu* W2 = (bfu*)(ws + WS_W2);
        constexpr int NT_ITEMS = 49152;
        for (int it = gw; it < NT_ITEMS; it += NGW) {
            int r = it; const float* W; bfu* WT; int K, N, item;
            if (r < 9216) { const int l = r / 4608; W = a->a_w_qkv + (size_t)l * DM * NQKV_A; K = DM; N = NQKV_A; WT = WQKVA + (size_t)l * NQKV_A * DM; item = r - l * 4608; }
            else if ((r -= 9216) < 1024) { const int l = r / 512; W = a->a_w_o + (size_t)l * AGW * DM; K = AGW; N = DM; WT = WOA + (size_t)l * DM * AGW; item = r - l * 512; }
            else if ((r -= 1024) < 1024) { W = a->kv_w_k; K = DM; N = DM; WT = WKV; item = r; }
            else if ((r -= 1024) < 1024) { W = a->kv_w_v; K = DM; N = DM; WT = WKV + (size_t)DM * DM; item = r; }
            else if ((r -= 1024) < 2048) { const int j = r / 1024; W = a->b_w_q + (size_t)j * DM * DM; K = DM; N = DM; WT = WQB + (size_t)j * DM * DM; item = r - j * 1024; }
            else if ((r -= 2048) < 2048) { const int j = r / 1024; W = a->b_w_o + (size_t)j * DM * DM; K = DM; N = DM; WT = WOB + (size_t)j * DM * DM; item = r - j * 1024; }
            else if ((r -= 2048) < 16384) { const int l = r / 4096; W = a->mlp_w1 + (size_t)l * DM * DFF; K = DM; N = DFF; WT = W1 + (size_t)l * DFF * DM; item = r - l * 4096; }
            else { r -= 16384; const int l = r / 4096; W = a->mlp_w2 + (size_t)l * DFF * DM; K = DFF; N = DM; WT = W2 + (size_t)l * DM * DFF; item = r - l * 4096; }
            transpose_item(W, K, N, WT, item, lane);
        }
    }
}

__device__ __forceinline__ void p0b_modreduce(ArgsP a, int tid, int vcu, int G) {
    const float* MODP = (const float*)(a->ws + WS_MODP); float* MOD = (float*)(a->ws + WS_MOD);
    for (int i4 = vcu * (NWAVES * 64) + tid; i4 < MOD_TOTAL / 4; i4 += G * NWAVES * 64) {
        const int i = i4 * 4; f32x4 s;
        if (i < MOD_KV_OFF) { const int l = i / (BATCH * NMOD), n = i % NMOD; s = *(const f32x4*)(a->ada_b + (size_t)l * NMOD + n); }
        else { const int n = (i - MOD_KV_OFF) % NKV; s = *(const f32x4*)(a->kv_ada_b + n); }
#pragma unroll 8
        for (int kc = 0; kc < GEMV_KC; ++kc) s += *(const f32x4*)(MODP + (size_t)kc * MOD_TOTAL + i);
        *(f32x4*)(MOD + i) = s;
    }
}

__device__ __forceinline__ void norm_phase(const float* X, const float* g, const float* shift, const float* scale, int bstride, bfu* H, int lane, int gw, int NGW) {
    for (int rb = gw; rb < M / 8; rb += NGW) {
        const int row0 = rb * 8, b = row0 / SEQ;
        f32x4 gs[8], sh[8];
#pragma unroll
        for (int j = 0; j < 8; ++j) { const int col = 4 * lane + 256 * j;
            const f32x4 gv = *(const f32x4*)(g + col), sc = *(const f32x4*)(scale + (size_t)b * bstride + col);
            gs[j] = gv * (sc + 1.0f); sh[j] = *(const f32x4*)(shift + (size_t)b * bstride + col); }
        for (int r = 0; r < 8; ++r) {
            const float* xr = X + (size_t)(row0 + r) * DM + 4 * lane; f32x4 v[8]; float ss = 0.f;
#pragma unroll
            for (int j = 0; j < 8; ++j) { v[j] = *(const f32x4*)(xr + 256 * j); ss += (v[j].x * v[j].x + v[j].y * v[j].y) + (v[j].z * v[j].z + v[j].w * v[j].w); }
            ss = wave_sum(ss, lane);
            const float rstd = 1.0f / sqrtf(ss * (1.0f / DM) + NORM_EPS);
            bfu* hr = H + (size_t)(row0 + r) * DM + 4 * lane;
#pragma unroll
            for (int j = 0; j < 8; ++j) { const f32x4 o = v[j] * rstd * gs[j] + sh[j]; u32x2 w; w.x = pkbf(o.x, o.y); w.y = pkbf(o.z, o.w); *(u32x2*)(hr + 256 * j) = w; }
        }
    }
}

template <int KIND>
__device__ __forceinline__ void qknorm_phase(bfu* buf, const float* gq, const float* gk, const float* cosT, const float* sinT, int lane, int gw, int NGW) {
    constexpr int NQUAD = KIND == 0 ? 12 : 4; constexpr int LD = KIND == 0 ? NQKV_A : (KIND == 1 ? NKV : DM);
    const int sub = lane & 15, ql = lane >> 4;
    for (int it = gw; it < M * NQUAD; it += NGW) {
        const int row = it / NQUAD, q = it - row * NQUAD; const int j = q * 4 + ql;
        int col; const float* gain;
        if (KIND == 0) { const int g = j >> 4, typ = (j >> 3) & 1, h = j & 7; col = g * 3072 + typ * 1024 + h * 128; gain = (typ ? gk : gq) + g * 128; }
        else { col = j * 128; gain = gq + (j & 1) * 128; }
        bfu* p = buf + (size_t)row * LD + col + sub * 8;
        const v4u raw = *(const v4u*)p;
        float v[8];
        v[0] = bf2f(raw.x & 0xffffu); v[1] = bf2f(raw.x >> 16); v[2] = bf2f(raw.y & 0xffffu); v[3] = bf2f(raw.y >> 16);
        v[4] = bf2f(raw.z & 0xffffu); v[5] = bf2f(raw.z >> 16); v[6] = bf2f(raw.w & 0xffffu); v[7] = bf2f(raw.w >> 16);
        float ss = 0.f;
#pragma unroll
        for (int i = 0; i < 8; ++i) ss += v[i] * v[i];
        ss += shx(ss, 1, lane); ss += shx(ss, 2, lane); ss += shx(ss, 4, lane); ss += shx(ss, 8, lane);
        const float rstd = 1.0f / sqrtf(ss * (1.0f / HD) + NORM_EPS);
        const f32x4 g0 = *(const f32x4*)(gain + sub * 8), g1 = *(const f32x4*)(gain + sub * 8 + 4);
        v[0] *= rstd * g0.x; v[1] *= rstd * g0.y; v[2] *= rstd * g0.z; v[3] *= rstd * g0.w; v[4] *= rstd * g1.x; v[5] *= rstd * g1.y; v[6] *= rstd * g1.z; v[7] *= rstd * g1.w;
        float pv[8];
#pragma unroll
        for (int i = 0; i < 8; ++i) pv[i] = shx(v[i], 2, lane);
        if (sub < 4) {
            const float* cp = cosT + (size_t)row * 16 + (sub & 1) * 8; const float* sp = sinT + (size_t)row * 16 + (sub & 1) * 8;
            const f32x4 c0 = *(const f32x4*)cp, c1 = *(const f32x4*)(cp + 4), s0 = *(const f32x4*)sp, s1 = *(const f32x4*)(sp + 4);
            const float cs[8] = {c0.x, c0.y, c0.z, c0.w, c1.x, c1.y, c1.z, c1.w}; const float sn[8] = {s0.x, s0.y, s0.z, s0.w, s1.x, s1.y, s1.z, s1.w};
            const float sgn = (sub < 2) ? -1.0f : 1.0f;
#pragma unroll
            for (int i = 0; i < 8; ++i) v[i] = v[i] * cs[i] + sgn * pv[i] * sn[i];
        }
        v4u o; o.x = pkbf(v[0], v[1]); o.y = pkbf(v[2], v[3]); o.z = pkbf(v[4], v[5]); o.w = pkbf(v[6], v[7]);
        *(v4u*)p = o;
    }
}

__device__ __forceinline__ void combineA_phase(const float* OP, const float* LA, bfu* AO, int lane, int gw, int NGW) {
    for (int row = gw; row < M; row += NGW) {
#pragma unroll
        for (int j = 0; j < 4; ++j) { const int col = 4 * lane + 256 * j, h = col >> 7;
            const float l0 = LA[(size_t)row * 8 + h], l1 = LA[(size_t)M * 8 + (size_t)row * 8 + h], l2 = LA[(size_t)2 * M * 8 + (size_t)row * 8 + h];
            const float mx = fmaxf(l0, fmaxf(l1, l2)); const float e0 = expf(l0 - mx), e1 = expf(l1 - mx), e2 = expf(l2 - mx); const float inv = 1.0f / (e0 + e1 + e2);
            const f32x4 o0 = *(const f32x4*)(OP + (size_t)row * AGW + col), o1 = *(const f32x4*)(OP + (size_t)M * AGW + (size_t)row * AGW + col), o2 = *(const f32x4*)(OP + (size_t)2 * M * AGW + (size_t)row * AGW + col);
            const f32x4 o = (o0 * e0 + o1 * e1 + o2 * e2) * inv;
            u32x2 w; w.x = pkbf(o.x, o.y); w.y = pkbf(o.z, o.w); *(u32x2*)(AO + (size_t)row * AGW + col) = w; }
    }
}
__device__ __forceinline__ void combineB_phase(const float* OP, const float* lp, const float* subg, float lam_init, bfu* AO, int lane, int gw, int NGW) {
    float s1 = lp[lane] * lp[128 + lane] + lp[64 + lane] * lp[192 + lane], s2 = lp[256 + lane] * lp[384 + lane] + lp[320 + lane] * lp[448 + lane];
    s1 = wave_sum(s1, lane); s2 = wave_sum(s2, lane);
    const float lam = expf(s1) - expf(s2) + lam_init;
    const f32x4 sg = *(const f32x4*)(subg + 4 * lane) * (1.0f - lam_init);
    for (int row = gw; row < M; row += NGW) {
        const float* p0 = OP + (size_t)row * DM + 4 * lane; const float* p1 = p0 + (size_t)M * DM;
        bfu* ao = AO + (size_t)row * DM + 4 * lane;
#pragma unroll
        for (int j = 0; j < 8; ++j) {
            const f32x4 o = *(const f32x4*)(p0 + 256 * j) - *(const f32x4*)(p1 + 256 * j) * lam;
            float ss = (o.x * o.x + o.y * o.y) + (o.z * o.z + o.w * o.w); ss = wave_sum(ss, lane);
            const float rstd = 1.0f / sqrtf(ss * (1.0f / 256.0f) + NORM_EPS);
            const f32x4 r = o * rstd * sg; u32x2 w; w.x = pkbf(r.x, r.y); w.y = pkbf(r.z, r.w); *(u32x2*)(ao + 256 * j) = w; }
    }
}

__device__ __forceinline__ swa::BlockRef attnA_ref(int L, const bfu* QKV, float* OP, float* LA) {
    const int g = L >> 9, rem = L & 511, bh = rem >> 4, sub = rem & 15, dsh = 2 * g, d = 1 << dsh;
    const int r = sub >> (4 - dsh), qb = sub & ((16 >> dsh) - 1), b = bh >> 3, h = bh & 7;
    const size_t tok0 = (size_t)b * SEQ + r, tq = tok0 + (size_t)d * 256 * qb;
    swa::BlockRef R;
    R.Q = (const swa::bf16*)(QKV + tq * NQKV_A + g * 3072 + h * 128);
    R.K = (const swa::bf16*)(QKV + tok0 * NQKV_A + g * 3072 + 1024 + h * 128);
    R.V = (const swa::bf16*)(QKV + tok0 * NQKV_A + g * 3072 + 2048 + h * 128);
    R.O = OP + (size_t)g * M * AGW + tq * AGW + h * 128; R.L = LA + (size_t)g * M * 8 + tq * 8 + h;
    R.qs = d * NQKV_A; R.kvs = d * NQKV_A; R.os = d * AGW; R.ls = d * 8; R.P0 = 256 * qb; R.skv = SEQ >> dsh;
    return R;
}
__device__ __forceinline__ swa::BlockRef attnB_ref(int I, int pass, const bfu* Qb, const bfu* KVB, float* OP) {
    const int bh = I >> 5, slot = I & 31, c = slot >> 4, vh = (slot >> 3) & 1, x = slot & 7, qb = pass ? 15 - x : x, b = bh >> 3, h = bh & 7;
    const size_t tq = (size_t)b * SEQ + 256 * qb;
    swa::BlockRef R;
    R.Q = (const swa::bf16*)(Qb + tq * DM + h * 256 + c * 128);
    R.K = (const swa::bf16*)(KVB + (size_t)b * SEQ * NKV + h * 256 + c * 128);
    R.V = (const swa::bf16*)(KVB + (size_t)b * SEQ * NKV + DM + h * 256 + vh * 128);
    R.O = OP + (size_t)c * M * DM + tq * DM + h * 256 + vh * 128; R.L = nullptr;
    R.qs = DM; R.kvs = NKV; R.os = DM; R.ls = 0; R.P0 = 256 * qb; R.skv = SEQ;
    return R;
}

__global__ void __launch_bounds__(NWAVES * 64, 2) yoco_fwd(Args args_unused) {
    (void)args_unused;
    extern __shared__ __attribute__((aligned(16))) unsigned char lds_raw[];
    LAS unsigned char* lds = (LAS unsigned char*)lds_raw;
    volatile LAS unsigned* MISC = (volatile LAS unsigned*)(lds + MISC_OFF);
    const int wave_s = __builtin_amdgcn_readfirstlane((int)threadIdx.x >> 6);
    for (int u = threadIdx.x; u < (LDS_BYTES - LDSCTL_OFF) / 4; u += NWAVES * 64) ((LAS unsigned*)(lds + LDSCTL_OFF))[u] = 0u;
    __syncthreads();
    int lo, hi; XcdBarrier bar;
    { ArgsP a = get_args(); const Ctx c = fresh_ctx(wave_s); lo = a->ph_lo; hi = a->ph_hi; unsigned* bw = (unsigned*)(a->ws + WS_CTL) + CW_BAR;
      bar.bar = bw; bar.x = 0; bar.st = nullptr;
      if (hi - lo > 1) bar = xcd_barrier_post(bw, MISC + 8, threadIdx.x == 0); }
#define IN(k) (lo <= (k) && (k) < hi)
#define SEAM(k) do { if (IN(k) && IN((k) + 1)) { XcdBarrier bb_ = bar; { GAS unsigned* gb_ = (GAS unsigned*)bar.bar; asm volatile("" : "+s"(gb_), "+s"(bb_.x)); bb_.bar = (unsigned*)gb_; } const Ctx cb_ = fresh_ctx(wave_s); xcd_barrier(bb_, cb_.tid == 0); } } while (0)
#define WSP(T, off) ((T*)(a->ws + (off)))

    if (IN(0)) { const Ctx c = fresh_ctx(wave_s); p0_prologue(get_args(), lds, c.tid, c.lane, c.wave, c.vcu, c.G); }
    SEAM(0);
    if (IN(1)) { const Ctx c = fresh_ctx(wave_s); p0b_modreduce(get_args(), c.tid, c.vcu, c.G); }
    SEAM(1);

    for (int s = 0; s < N_STAGE; ++s) {
        const int kind = (s < 2) ? 0 : (s == 2 ? 1 : 2);
        const int layer = (s < 2) ? s : s - 1;
        const int jb = s - 3;
        const int pb = (s == 0) ? 2 : (s == 1) ? 11 : (s == 2) ? 20 : (s == 3) ? 23 : 32;

        if (IN(pb + 0)) {
            ArgsP a = get_args(); const Ctx c = fresh_ctx(wave_s); const float* MOD = WSP(const float, WS_MOD); bfu* Hb = WSP(bfu, WS_H);
            if (kind == 1) norm_phase(a->out, a->kv_norm_g, MOD + MOD_KV_OFF, MOD + MOD_KV_OFF + DM, NKV, Hb, c.lane, c.gw, c.NGW);
            else { const float* modl = MOD + (size_t)layer * BATCH * NMOD; norm_phase((s == 0) ? a->x : (const float*)a->out, a->norm_g + (size_t)(layer * 2) * DM, modl, modl + DM, NMOD, Hb, c.lane, c.gw, c.NGW); }
        }
        SEAM(pb + 0);
        if (IN(pb + 1)) {
            ArgsP a = get_args(); const Ctx c = fresh_ctx(wave_s);
            const bfu* Wt; int N; bfu* O;
            if (kind == 0) { Wt = WSP(const bfu, WS_WQKVA) + (size_t)layer * NQKV_A * DM; N = NQKV_A; O = WSP(bfu, WS_QKV); }
            else if (kind == 1) { Wt = WSP(const bfu, WS_WKV); N = NKV; O = WSP(bfu, WS_KVB); }
            else { Wt = WSP(const bfu, WS_WQB) + (size_t)jb * DM * DM; N = DM; O = WSP(bfu, WS_QKV); }
            pg8::Gemm g{WSP(const bfu, WS_H), Wt, M, N, DM}; pg8::StaticOrder S; S.init(M, N, c.G, c.bx);
            pg8::EpiBf16<0> E{O, N};
            pg8::gemm_phase<pg8::EpiBf16<0>, pg8::StaticOrder, true, true>(lds + RING_OFF, g, S, E, c.tid);
        }
        SEAM(pb + 1);
        if (IN(pb + 2)) {
            ArgsP a = get_args(); const Ctx c = fresh_ctx(wave_s); const float* cosT = WSP(const float, WS_COS); const float* sinT = WSP(const float, WS_SIN);
            if (kind == 0) qknorm_phase<0>(WSP(bfu, WS_QKV), a->a_q_gain + (size_t)layer * 3 * HD, a->a_k_gain + (size_t)layer * 3 * HD, cosT, sinT, c.lane, c.gw, c.NGW);
            else if (kind == 1) qknorm_phase<1>(WSP(bfu, WS_KVB), a->kv_k_gain, nullptr, cosT, sinT, c.lane, c.gw, c.NGW);
            else qknorm_phase<2>(WSP(bfu, WS_QKV), a->b_q_gain + (size_t)jb * 2 * HD, nullptr, cosT, sinT, c.lane, c.gw, c.NGW);
        }
        SEAM(pb + 2);
        if (kind == 1) continue;
        if (IN(pb + 3)) {
            ArgsP a = get_args(); const Ctx c = fresh_ctx(wave_s);
            const bfu* QKV = WSP(const bfu, WS_QKV); float* OP = WSP(float, WS_OP);
            if (kind == 0) {
                float* LA = WSP(float, WS_LA);
                const int total = 1536; const int G = c.G; int L = c.bx;
                if (L < total) {
                    swa::BlockRef cur = attnA_ref(L, QKV, OP, LA); swa::Seam SS;
                    swa::causal_swa_prime(cur, 129, (char*)lds_raw, SS, c.tid);
                    for (;;) {
                        const bool more = L + G < total;
                        const swa::BlockRef nxt = more ? attnA_ref(L + G, QKV, OP, LA) : cur;
                        swa::causal_swa_block<true>(cur, nxt, 129, (char*)lds_raw, SS, c.tid);
                        if (!more) break;
                        cur = nxt; L += G;
                    }
                }
            } else {
                const bfu* KVB = WSP(const bfu, WS_KVB); const int G = c.G, vcu = c.vcu;
                const int nit = (G == 256) ? 4 : (vcu < 1024 ? (1024 - vcu + G - 1) / G : 0);
                int n = 0; const int nblk = 2 * nit;
#define ITEM_OF(i) ((G == 256) ? ((vcu >> 5) * 128 + (i) * 32 + (vcu & 31)) : (vcu + (i) * G))
                if (nblk > 0) {
                    swa::BlockRef cur = attnB_ref(ITEM_OF(0), 0, QKV, KVB, OP); swa::Seam SS;
                    swa::causal_swa_prime(cur, SEQ, (char*)lds_raw, SS, c.tid);
                    for (;;) {
                        const bool more = n + 1 < nblk;
                        const swa::BlockRef nxt = more ? attnB_ref(ITEM_OF((n + 1) >> 1), (n + 1) & 1, QKV, KVB, OP) : cur;
                        swa::causal_swa_block<false>(cur, nxt, SEQ, (char*)lds_raw, SS, c.tid);
                        if (!more) break;
                        cur = nxt; ++n;
                    }
                }
#undef ITEM_OF
            }
        }
        SEAM(pb + 3);
        if (IN(pb + 4)) {
            ArgsP a = get_args(); const Ctx c = fresh_ctx(wave_s);
            if (kind == 0) combineA_phase(WSP(const float, WS_OP), WSP(const float, WS_LA), WSP(bfu, WS_AO), c.lane, c.gw, c.NGW);
            else combineB_phase(WSP(const float, WS_OP), a->b_lambda + (size_t)jb * 4 * HD, a->b_subln_g + (size_t)jb * 256, jb == 0 ? a->lam_init[0] : a->lam_init[1], WSP(bfu, WS_AO), c.lane, c.gw, c.NGW);
        }
        SEAM(pb + 4);
        if (IN(pb + 5)) {
            ArgsP a = get_args(); const Ctx c = fresh_ctx(wave_s);
            const bfu* Wt; int K;
            if (kind == 0) { Wt = WSP(const bfu, WS_WOA) + (size_t)layer * DM * AGW; K = AGW; }
            else { Wt = WSP(const bfu, WS_WOB) + (size_t)jb * DM * DM; K = DM; }
            pg8::Gemm g{WSP(const bfu, WS_AO), Wt, M, DM, K}; pg8::StaticOrder S; S.init(M, DM, c.G, c.bx);
            pg8::EpiRes E{(s == 0) ? a->x : (const float*)a->out, a->out, DM, WSP(const float, WS_MOD) + (size_t)layer * BATCH * NMOD + 2 * DM, NMOD, SEQ};
            pg8::gemm_phase<pg8::EpiRes, pg8::StaticOrder, true, true>(lds + RING_OFF, g, S, E, c.tid);
        }
        SEAM(pb + 5);
        if (IN(pb + 6)) {
            ArgsP a = get_args(); const Ctx c = fresh_ctx(wave_s); const float* modl = WSP(const float, WS_MOD) + (size_t)layer * BATCH * NMOD;
            norm_phase(a->out, a->norm_g + (size_t)(layer * 2 + 1) * DM, modl + 3 * DM, modl + 4 * DM, NMOD, WSP(bfu, WS_H), c.lane, c.gw, c.NGW);
        }
        SEAM(pb + 6);
        if (IN(pb + 7)) {
            ArgsP a = get_args(); const Ctx c = fresh_ctx(wave_s);
            pg8::Gemm g{WSP(const bfu, WS_H), WSP(const bfu, WS_W1) + (size_t)layer * DFF * DM, M, DFF, DM}; pg8::StaticOrder S; S.init(M, DFF, c.G, c.bx);
            pg8::EpiBf16<1> E{WSP(bfu, WS_QKV), DFF};
            pg8::gemm_phase<pg8::EpiBf16<1>, pg8::StaticOrder, true, true>(lds + RING_OFF, g, S, E, c.tid);
        }
        SEAM(pb + 7);
        if (IN(pb + 8)) {
            ArgsP a = get_args(); const Ctx c = fresh_ctx(wave_s);
            pg8::Gemm g{WSP(const bfu, WS_QKV), WSP(const bfu, WS_W2) + (size_t)layer * DM * DFF, M, DM, DFF}; pg8::StaticOrder S; S.init(M, DM, c.G, c.bx);
            pg8::EpiRes E{a->out, a->out, DM, WSP(const float, WS_MOD) + (size_t)layer * BATCH * NMOD + 5 * DM, NMOD, SEQ};
            pg8::gemm_phase<pg8::EpiRes, pg8::StaticOrder, true, true>(lds + RING_OFF, g, S, E, c.tid);
        }
        SEAM(pb + 8);
    }
#undef IN
#undef SEAM
#undef WSP
}

extern "C" void kernel_launch(void* const* d_in, const int* in_sizes, int n_in, void* d_out, int out_size, void* d_ws, size_t ws_size, hipStream_t stream) {
    static int grid = 0;
    if (grid == 0) {
        if (n_in != 23 || in_sizes[0] != M * DM || out_size != M * DM || ws_size < WS_END) { fprintf(stderr, "kernel_launch: unexpected shapes (n_in %d, in0 %d, out %d, ws %zu); nothing launched\n", n_in, n_in > 0 ? in_sizes[0] : -1, out_size, ws_size); grid = -1; return; }
        int dev = 0, cus = 0, per_cu = 0;
        if (hipGetDevice(&dev) != hipSuccess || hipDeviceGetAttribute(&cus, hipDeviceAttributeMultiprocessorCount, dev) != hipSuccess) { fprintf(stderr, "kernel_launch: hipGetDevice / hipDeviceGetAttribute failed\n"); grid = -1; return; }
        if (hipFuncSetAttribute((const void*)yoco_fwd, hipFuncAttributeMaxDynamicSharedMemorySize, LDS_BYTES) != hipSuccess) { fprintf(stderr, "kernel_launch: hipFuncSetAttribute failed\n"); grid = -1; return; }
        if (hipOccupancyMaxActiveBlocksPerMultiprocessor(&per_cu, (const void*)yoco_fwd, NWAVES * 64, LDS_BYTES) != hipSuccess || per_cu < 1)
            fprintf(stderr, "kernel_launch: note: occupancy query reports %d workgroups per CU\n", per_cu);
        (void)hipGetLastError();
        grid = cus;
    }
    if (grid < 0) return;
    if (hipMemsetAsync((char*)d_ws + WS_CTL, 0, CTL_ZERO_BYTES, stream) != hipSuccess) { fprintf(stderr, "kernel_launch: hipMemsetAsync failed\n"); return; }
    Args ha{};
    ha.x = (const float*)d_in[0]; ha.c = (const float*)d_in[1]; ha.pos = (const int*)d_in[2]; ha.ada_w = (const float*)d_in[3]; ha.ada_b = (const float*)d_in[4]; ha.norm_g = (const float*)d_in[5];
    ha.a_w_qkv = (const float*)d_in[6]; ha.a_q_gain = (const float*)d_in[7]; ha.a_k_gain = (const float*)d_in[8]; ha.a_w_o = (const float*)d_in[9];
    ha.kv_ada_w = (const float*)d_in[10]; ha.kv_ada_b = (const float*)d_in[11]; ha.kv_norm_g = (const float*)d_in[12]; ha.kv_w_k = (const float*)d_in[13]; ha.kv_w_v = (const float*)d_in[14]; ha.kv_k_gain = (const float*)d_in[15];
    ha.b_w_q = (const float*)d_in[16]; ha.b_q_gain = (const float*)d_in[17]; ha.b_lambda = (const float*)d_in[18]; ha.b_subln_g = (const float*)d_in[19]; ha.b_w_o = (const float*)d_in[20];
    ha.mlp_w1 = (const float*)d_in[21]; ha.mlp_w2 = (const float*)d_in[22];
    ha.out = (float*)d_out; ha.ws = (unsigned char*)d_ws;
    for (int j = 0; j < 16; ++j) ha.inv_freq[j] = (float)pow(500000.0, -(double)(2 * j) / 32.0);
    ha.lam_init[0] = (float)(0.8 - 0.6 * exp(-0.3 * 2.0)); ha.lam_init[1] = (float)(0.8 - 0.6 * exp(-0.3 * 3.0));
#if MK_ONE_LAUNCH
    ha.ph_lo = 0; ha.ph_hi = N_PHASE;
    hipLaunchKernelGGL(yoco_fwd, dim3(grid), dim3(NWAVES * 64), LDS_BYTES, stream, ha);
    { const hipError_t le = hipPeekAtLastError(); if (le != hipSuccess) fprintf(stderr, "kernel_launch: launch failed: %s\n", hipGetErrorName(le)); }
#else
    for (int p = 0; p < N_PHASE; ++p) {
        ha.ph_lo = p; ha.ph_hi = p + 1;
        hipLaunchKernelGGL(yoco_fwd, dim3(grid), dim3(NWAVES * 64), LDS_BYTES, stream, ha);
        const hipError_t le = hipPeekAtLastError(); if (le != hipSuccess) { fprintf(stderr, "kernel_launch: launch %d failed: %s\n", p, hipGetErrorName(le)); break; }
    }
#endif
}
```

```cpp
#include <hip/hip_runtime.h>
#include <hip/hip_bf16.h>
#include <cstdio>
#include <cstdint>
#include <cmath>
namespace pg8 {
#define PG8_LAS __attribute__((address_space(3)))
typedef unsigned short bf16_t;
typedef short bf16x8 __attribute__((ext_vector_type(8)));
typedef float f32x4 __attribute__((ext_vector_type(4)));
typedef unsigned u32x4 __attribute__((ext_vector_type(4)));
constexpr int BM = 256, BK = 64, HALF = 128, HTB = HALF * BK * 2  , STAGE_BYTES = 8 * HTB, NXCD = 8, WGM = 8;

__host__ __device__ __forceinline__ int lds_byte(int r, int c) { const int st = (r >> 4) * 2 + (c >> 5), rr = r & 15, cc = c & 31, ob = rr * 64 + cc * 2; return st * 1024 + (ob ^ (((ob >> 9) & 1) << 5)); }
__host__ __device__ __forceinline__ void stage_rc(int b, int& R, int& C) { const int st = b / 1024, sb = b % 1024, swz = sb ^ (((sb >> 9) & 1) << 5); R = (st >> 1) * 16 + swz / 64; C = (st & 1) * 32 + (swz % 64) / 2; }
__host__ __device__ __forceinline__ int perm32(int rho) { const int n = rho >> 4, i = rho & 15; return 8 * (i >> 2) + 4 * n + (i & 3); }

struct Unit { int pm, pn; };
struct Gemm { const bf16_t* A; const bf16_t* Bt; int M, N, K; };

struct StaticOrder {
    int nM, nN, nwg, G, c;
    __host__ __device__ void init(int M, int N, int G_, int c_) { nM = M / BM; nN = N / BM; nwg = nM * nN; G = G_; c = c_; }
    __host__ __device__ bool next(int i, Unit& u) const {
        const long L = (long)i * G + c; if (L >= nwg) return false;
        int wgid = (int)L; { const int q = nwg / NXCD, r = nwg % NXCD, xcd = wgid % NXCD, off = wgid / NXCD; wgid = (xcd < r ? xcd * (q + 1) : r * (q + 1) + (xcd - r) * q) + off; }
        const int nig = WGM * nN, gid = wgid / nig, fm = gid * WGM, gsz = (nM - fm) < WGM ? (nM - fm) : WGM;
        u.pm = fm + ((wgid % nig) % gsz); u.pn = (wgid % nig) / gsz; return true;
    }
    __device__ __forceinline__ void a_ready(const Unit&) const {}
    __device__ __forceinline__ void done(const Unit&) const {}
};


__device__ __forceinline__ unsigned cvt_pk_bf16(float lo, float hi) { unsigned r; asm volatile("v_cvt_pk_bf16_f32 %0, %1, %2" : "=v"(r) : "v"(lo), "v"(hi)); return r; }

template <int ACT  > struct EpiBf16 {
    static constexpr bool PERM = true, AFTER_DRAIN = false;
    bf16_t* O; int ldc;
    __device__ __forceinline__ void operator()(const f32x4 (&acc)[2][2][4][2], const Unit& u, int wr, int wc, int fr, int fq) const {
        const int row0 = u.pm * BM + wr * 64 + fr; const int col0 = u.pn * BM + wc * 32 + 8 * fq;
#pragma unroll
        for (int ai = 0; ai < 2; ++ai)
#pragma unroll
            for (int m = 0; m < 4; ++m) { bf16_t* rowp = O + (size_t)(row0 + ai * HALF + m * 16) * ldc + col0;
#pragma unroll
                for (int bj = 0; bj < 2; ++bj) { f32x4 v0 = acc[ai][bj][m][0], v1 = acc[ai][bj][m][1];
                    if (ACT == 1) {
#pragma unroll
                        for (int e = 0; e < 4; ++e) { const float a = fmaxf(v0[e], 0.f), b = fmaxf(v1[e], 0.f); v0[e] = a * a; v1[e] = b * b; } }
                    u32x4 w; w.x = cvt_pk_bf16(v0[0], v0[1]); w.y = cvt_pk_bf16(v0[2], v0[3]); w.z = cvt_pk_bf16(v1[0], v1[1]); w.w = cvt_pk_bf16(v1[2], v1[3]);
                    *(u32x4*)(rowp + bj * HALF) = w; } }
    }
};

struct EpiRes {
    static constexpr bool PERM = false, AFTER_DRAIN = false;
    const float* base; float* out; int ldc; const float* gate; int gate_bstride; int rows_per_batch;
    __device__ __forceinline__ void operator()(const f32x4 (&acc)[2][2][4][2], const Unit& u, int wr, int wc, int fr, int fq) const {
        const int row0 = u.pm * BM + wr * 64 + fr, col0 = u.pn * BM + wc * 32 + 4 * fq;
        const float* gp = gate + (size_t)((u.pm * BM) / rows_per_batch) * gate_bstride + col0;
        f32x4 gv[2][2];
#pragma unroll
        for (int bj = 0; bj < 2; ++bj)
#pragma unroll
            for (int n = 0; n < 2; ++n) gv[bj][n] = *(const f32x4*)(gp + bj * HALF + n * 16);
#pragma unroll
        for (int ai = 0; ai < 2; ++ai)
#pragma unroll
            for (int m = 0; m < 4; ++m) { const size_t off = (size_t)(row0 + ai * HALF + m * 16) * ldc + col0;
#pragma unroll
                for (int bj = 0; bj < 2; ++bj)
#pragma unroll
                    for (int n = 0; n < 2; ++n) { const f32x4 bs = *(const f32x4*)(base + off + bj * HALF + n * 16);
                        *(f32x4*)(out + off + bj * HALF + n * 16) = bs + gv[bj][n] * acc[ai][bj][m][n]; }
                if (m & 1) asm volatile("" ::: "memory"); }
    }
};

template <class Epi, class Sched, bool ALIGN_EPI = false, bool SP2 = false>
__device__ __forceinline__ void gemm_phase(PG8_LAS unsigned char* lds, const Gemm g, const Sched& S, const Epi& E, const int tid  ) {
    const int wid = __builtin_amdgcn_readfirstlane(tid >> 6), lane = tid & 63, wr = wid >> 2, wc = wid & 3, fr = lane & 15, fq = lane >> 4;
    const int K = g.K, nt = K / BK;
    unsigned voffA[2], voffB[2];
#pragma unroll
    for (int i = 0; i < 2; ++i) { int R, C; stage_rc(tid * 16 + i * 8192, R, C); const int Rb = Epi::PERM ? ((R & ~31) + perm32(R & 31)) : R;
        voffA[i] = (unsigned)(R * K + C) * 2u; voffB[i] = (unsigned)(Rb * K + C) * 2u; }
    const size_t kstep = (size_t)(BK * 2);
    const size_t hstep = (size_t)HALF * K * 2;
    const size_t tstep = 2 * hstep;
    const unsigned ldsw = (unsigned)wid * 1024u;
    const int aoff = lds_byte(wr * 64 + fr, fq * 8), boff = lds_byte(wc * 32 + fr, fq * 8);
#define PG8_SA(b, h) (((b) * 2 + (h)) * HTB)
#define PG8_SB(b, h) ((4 + (b) * 2 + (h)) * HTB)
#define PG8_STAGE(bufoff, gbase, voff) do { _Pragma("unroll") for (int _i = 0; _i < 2; ++_i) \
        __builtin_amdgcn_global_load_lds((const unsigned*)((const char*)(gbase) + (voff)[_i]), (PG8_LAS unsigned*)(lds + (bufoff) + ldsw + _i * 8192), 16, 0, 0); } while (0)
#define PG8_LDA(dst, b, h) do { _Pragma("unroll") for (int m = 0; m < 4; ++m) _Pragma("unroll") for (int k = 0; k < 2; ++k) dst[m][k] = *(const PG8_LAS bf16x8*)(lds + PG8_SA(b, h) + aoff + m * 2048 + k * 1024); } while (0)
#define PG8_LDB(dst, b, h) do { _Pragma("unroll") for (int n = 0; n < 2; ++n) _Pragma("unroll") for (int k = 0; k < 2; ++k) dst[n][k] = *(const PG8_LAS bf16x8*)(lds + PG8_SB(b, h) + boff + n * 2048 + k * 1024); } while (0)
#define PG8_MMA(ai, bj, At, Bt) do { __builtin_amdgcn_s_setprio(1); _Pragma("unroll") for (int m = 0; m < 4; ++m) _Pragma("unroll") for (int n = 0; n < 2; ++n) _Pragma("unroll") for (int k = 0; k < 2; ++k) \
        acc[ai][bj][m][n] = __builtin_amdgcn_mfma_f32_16x16x32_bf16(Bt[n][k], At[m][k], acc[ai][bj][m][n], 0, 0, 0); __builtin_amdgcn_s_setprio(0); } while (0)
#define PG8_WAIT_V(n) asm volatile("s_waitcnt vmcnt(" #n ")" ::: "memory")
#define PG8_WAIT_L(n) asm volatile("s_waitcnt lgkmcnt(" #n ")" ::: "memory")
#define PG8_BAR __builtin_amdgcn_s_barrier()
#define PG8_SCHED __builtin_amdgcn_sched_barrier(0)
    Unit cur, nxt; int ui = 0;
    if (!S.next(0, cur)) return;
    f32x4 acc[2][2][4][2];
#pragma unroll
    for (int a = 0; a < 2; ++a)
#pragma unroll
        for (int b = 0; b < 2; ++b)
#pragma unroll
            for (int m = 0; m < 4; ++m)
#pragma unroll
                for (int n = 0; n < 2; ++n) acc[a][b][m][n] = (f32x4){0.f, 0.f, 0.f, 0.f};
    bf16x8 At[4][2], B0[2][2], B1[2][2];
    const char* cA = (const char*)g.A + (size_t)cur.pm * tstep; const char* cB = (const char*)g.Bt + (size_t)cur.pn * tstep;
    S.a_ready(cur);
    if constexpr (SP2) {
        PG8_STAGE(PG8_SB(0, 0), cB, voffB); PG8_STAGE(PG8_SB(0, 1), cB + hstep, voffB); PG8_STAGE(PG8_SA(0, 0), cA, voffA); PG8_STAGE(PG8_SA(0, 1), cA + hstep, voffA);
        if (wr == 1) PG8_BAR;
        PG8_WAIT_V(2); PG8_BAR;
        PG8_STAGE(PG8_SB(1, 0), cB + kstep, voffB); PG8_STAGE(PG8_SA(1, 0), cA + kstep, voffA); PG8_STAGE(PG8_SB(1, 1), cB + hstep + kstep, voffB);
        PG8_WAIT_V(6); PG8_BAR;
    } else {
        PG8_STAGE(PG8_SB(0, 0), cB, voffB); PG8_STAGE(PG8_SA(0, 0), cA, voffA); PG8_STAGE(PG8_SB(0, 1), cB + hstep, voffB); PG8_STAGE(PG8_SA(0, 1), cA + hstep, voffA);
        if (wr == 1) PG8_BAR;
        PG8_WAIT_V(4); PG8_BAR;
        PG8_STAGE(PG8_SB(1, 0), cB + kstep, voffB); PG8_STAGE(PG8_SA(1, 0), cA + kstep, voffA); PG8_STAGE(PG8_SB(1, 1), cB + hstep + kstep, voffB);
        PG8_WAIT_V(6); PG8_BAR;
    }
    for (;;) {
        const bool has_next = S.next(ui + 1, nxt);
        const char* nA = has_next ? (const char*)g.A + (size_t)nxt.pm * tstep : cA; const char* nB = has_next ? (const char*)g.Bt + (size_t)nxt.pn * tstep : cB;
        for (int t = 0; t < nt; t += 2) {
            const bool last = (t == nt - 2);
            const char* a1 = cA + (size_t)(t + 1) * kstep;
            const char* a2 = last ? nA : cA + (size_t)(t + 2) * kstep; const char* b2 = last ? nB : cB + (size_t)(t + 2) * kstep;
            const char* a3 = a2 + kstep; const char* b3 = b2 + kstep;
            if (last && has_next) S.a_ready(nxt);
            if constexpr (SP2) {
            PG8_LDB(B0, 0, 0); PG8_LDB(B1, 0, 1); PG8_SCHED; PG8_LDA(At, 0, 0); PG8_STAGE(PG8_SA(1, 1), a1 + hstep, voffA);
            PG8_WAIT_V(8); PG8_WAIT_L(0); PG8_BAR; PG8_MMA(0, 0, At, B0); PG8_MMA(0, 1, At, B1); PG8_BAR; PG8_SCHED;
            PG8_LDA(At, 0, 1); PG8_STAGE(PG8_SB(0, 0), b2, voffB); PG8_STAGE(PG8_SB(0, 1), b2 + hstep, voffB); PG8_STAGE(PG8_SA(0, 0), a2, voffA);
            PG8_WAIT_V(8); PG8_WAIT_L(0); PG8_BAR; PG8_MMA(1, 0, At, B0); PG8_MMA(1, 1, At, B1); PG8_BAR; PG8_SCHED;
            PG8_LDB(B0, 1, 0); PG8_LDB(B1, 1, 1); PG8_SCHED; PG8_LDA(At, 1, 0); PG8_STAGE(PG8_SA(0, 1), a2 + hstep, voffA);
            PG8_WAIT_V(8); PG8_WAIT_L(0); PG8_BAR; PG8_MMA(0, 0, At, B0); PG8_MMA(0, 1, At, B1); PG8_BAR; PG8_SCHED;
            PG8_LDA(At, 1, 1); PG8_STAGE(PG8_SB(1, 0), b3, voffB); PG8_STAGE(PG8_SB(1, 1), b3 + hstep, voffB); PG8_STAGE(PG8_SA(1, 0), a3, voffA);
            PG8_WAIT_V(8); PG8_WAIT_L(0); PG8_BAR; PG8_MMA(1, 0, At, B0); PG8_MMA(1, 1, At, B1); PG8_BAR; PG8_SCHED;
            } else {
            PG8_LDB(B0, 0, 0); PG8_SCHED; PG8_LDA(At, 0, 0); PG8_STAGE(PG8_SA(1, 1), a1 + hstep, voffA);
            PG8_WAIT_L(8); PG8_BAR; PG8_WAIT_L(0); PG8_MMA(0, 0, At, B0); PG8_BAR; PG8_SCHED;
            PG8_LDB(B1, 0, 1); PG8_STAGE(PG8_SB(0, 0), b2, voffB);
            PG8_BAR; PG8_WAIT_L(0); PG8_MMA(0, 1, At, B1); PG8_BAR;
            PG8_LDA(At, 0, 1); PG8_STAGE(PG8_SA(0, 0), a2, voffA);
            PG8_BAR; PG8_WAIT_L(0); PG8_MMA(1, 0, At, B0); PG8_BAR; PG8_SCHED;
            PG8_STAGE(PG8_SB(0, 1), b2 + hstep, voffB);
            PG8_WAIT_V(6); PG8_BAR; PG8_MMA(1, 1, At, B1); PG8_BAR;
            PG8_LDB(B0, 1, 0); PG8_SCHED; PG8_LDA(At, 1, 0); PG8_STAGE(PG8_SA(0, 1), a2 + hstep, voffA);
            PG8_WAIT_L(8); PG8_BAR; PG8_WAIT_L(0); PG8_MMA(0, 0, At, B0); PG8_BAR; PG8_SCHED;
            PG8_LDB(B1, 1, 1); PG8_STAGE(PG8_SB(1, 0), b3, voffB);
            PG8_BAR; PG8_WAIT_L(0); PG8_MMA(0, 1, At, B1); PG8_BAR;
            PG8_LDA(At, 1, 1); PG8_STAGE(PG8_SA(1, 0), a3, voffA);
            PG8_BAR; PG8_WAIT_L(0); PG8_MMA(1, 0, At, B0); PG8_BAR; PG8_SCHED;
            PG8_STAGE(PG8_SB(1, 1), b3 + hstep, voffB);
            PG8_WAIT_V(6); PG8_BAR; PG8_MMA(1, 1, At, B1); PG8_BAR;
            }
        }
        if constexpr (ALIGN_EPI) { if (wr == 0) PG8_BAR; }
        if constexpr (!Epi::AFTER_DRAIN) { E(acc, cur, wr, wc, fr, fq); S.done(cur); }
        if (!has_next) break;
#pragma unroll
        for (int a = 0; a < 2; ++a)
#pragma unroll
            for (int b = 0; b < 2; ++b)
#pragma unroll
                for (int m = 0; m < 4; ++m)
#pragma unroll
                    for (int n = 0; n < 2; ++n) acc[a][b][m][n] = (f32x4){0.f, 0.f, 0.f, 0.f};
        cur = nxt; cA = nA; cB = nB; ++ui;
        if constexpr (ALIGN_EPI) { if (wr == 1) PG8_BAR; }
    }
    PG8_WAIT_V(0);
    if constexpr (!ALIGN_EPI) { if (wr == 0) PG8_BAR; }
    PG8_BAR;
    if constexpr (Epi::AFTER_DRAIN) { E.fused(acc, cur, wr, wc, fr, fq, lds, wid, lane); S.done(cur); }
#undef PG8_SA
#undef PG8_SB
#undef PG8_STAGE
#undef PG8_LDA
#undef PG8_LDB
#undef PG8_MMA
#undef PG8_WAIT_V
#undef PG8_WAIT_L
#undef PG8_BAR
#undef PG8_SCHED
}
}
namespace swa {
using bf16 = __hip_bfloat16;
constexpr int D = 128;
constexpr float SCALE = 0.08838834764831845f;
constexpr float THR = 8.f;
constexpr int NW = 8, QBLK = 32, KVBLK = 64, QB = NW * QBLK;
constexpr int SHM_V = KVBLK * D * 2, SHM_K = KVBLK * D * 2;
constexpr int LDS_BYTES = 2 * SHM_V + 2 * SHM_K + NW * 64 * 4;

typedef short bf16x8 __attribute__((ext_vector_type(8)));
typedef short s16x4 __attribute__((ext_vector_type(4)));
typedef float f32x16 __attribute__((ext_vector_type(16)));
typedef float f32x4 __attribute__((ext_vector_type(4)));
typedef unsigned u32x4 __attribute__((ext_vector_type(4)));

#define KSWZ(row, colB) ((row) * 256 + ((colB) ^ (((row) & 7) << 4)))
#define SBAR() __builtin_amdgcn_sched_barrier(0)
__device__ __forceinline__ int v_st(int k, int c) { const int kk = (k & ~0xC) | ((k & 4) << 1) | ((k & 8) >> 1); return ((kk >> 3) * 4 + (c >> 5)) * 512 + ((kk & 7) * 32 + (c & 31)) * 2; }
__device__ __forceinline__ int v_rd_base(int lane) { return ((lane & 3) << 3) | (((lane >> 2) & 3) << 6) | (((lane >> 4) & 1) << 5) | (((lane >> 5) & 1) << 8); }
constexpr int v_rd_off(int d0, int ks, int half) { return d0 * 512 + ks * 4096 + half * 2048; }
__device__ __forceinline__ int crow(int r, int hi) { return (r & 3) + 8 * (r >> 2) + 4 * hi; }
__device__ __forceinline__ unsigned cvtpk(float lo, float hi) {
    unsigned r; asm volatile("v_cvt_pk_bf16_f32 %0, %1, %2" : "=v"(r) : "v"(lo), "v"(hi)); return r;
}
__device__ __forceinline__ bf16x8 load8(const bf16* p) { return *reinterpret_cast<const bf16x8*>(p); }
__device__ __forceinline__ void mask_tile(f32x16& p0, f32x16& p1, int dq, unsigned W) {
    const float NEG = -__builtin_inff();
#pragma unroll
    for (int r = 0; r < 16; ++r) {
        const int c = (r & 3) + 8 * (r >> 2);
        if ((unsigned)(dq - c) >= W) p0[r] = NEG;
        if ((unsigned)(dq - c - 32) >= W) p1[r] = NEG;
    }
}
__device__ __forceinline__ void partialSM(f32x16& p0, f32x16& p1, float& m_reg, float& mn, float& alpha) {
    float pmax = p0[0]; for (int r = 1; r < 16; ++r) pmax = fmaxf(pmax, p0[r]); for (int r = 0; r < 16; ++r) pmax = fmaxf(pmax, p1[r]);
    { auto rr = __builtin_amdgcn_permlane32_swap(__float_as_uint(pmax), __float_as_uint(pmax), false, false);
      pmax = fmaxf(__uint_as_float(rr[0]), __uint_as_float(rr[1])); }
    constexpr float C2 = 1.4426950408889634f * SCALE;
    if (__builtin_expect(__all((pmax - m_reg) * SCALE <= THR), 1)) { mn = m_reg; alpha = 1.f; }
    else { mn = fmaxf(m_reg, pmax); alpha = __builtin_amdgcn_exp2f((m_reg - mn) * C2); m_reg = mn; }
    const float mnL = -mn * C2;
    for (int r = 0; r < 16; ++r) p0[r] = fmaf(p0[r], C2, mnL); for (int r = 0; r < 16; ++r) p1[r] = fmaf(p1[r], C2, mnL);
    for (int r = 0; r < 16; ++r) p0[r] = __builtin_amdgcn_exp2f(p0[r]);
}
__device__ __forceinline__ void finishSM(f32x16& p0, f32x16& p1, float alpha, float& l_reg, bf16x8& pa0, bf16x8& pa1, bf16x8& pa2, bf16x8& pa3) {
    for (int r = 0; r < 16; ++r) p1[r] = __builtin_amdgcn_exp2f(p1[r]);
    float ps = 0; for (int r = 0; r < 16; ++r) ps += p0[r]; for (int r = 0; r < 16; ++r) ps += p1[r];
    { auto rr = __builtin_amdgcn_permlane32_swap(__float_as_uint(ps), __float_as_uint(ps), false, false);
      ps = __uint_as_float(rr[0]) + __uint_as_float(rr[1]); }
    l_reg = l_reg * alpha + ps;
#define PK4(P, B_, OUT) do { unsigned a0 = cvtpk(P[B_+0], P[B_+1]), a1 = cvtpk(P[B_+2], P[B_+3]);                          \
        unsigned b0 = cvtpk(P[B_+4], P[B_+5]), b1 = cvtpk(P[B_+6], P[B_+7]);                                             \
        auto r0 = __builtin_amdgcn_permlane32_swap(a0, b0, false, false); auto r1 = __builtin_amdgcn_permlane32_swap(a1, b1, false, false); \
        u32x4 w = {r0[0], r1[0], r0[1], r1[1]}; OUT = *reinterpret_cast<bf16x8*>(&w); } while (0)
    PK4(p0, 0, pa0); PK4(p0, 8, pa1); PK4(p1, 0, pa2); PK4(p1, 8, pa3);
#undef PK4
}
template <int KB, bool SK>
__device__ __forceinline__ void qkt(f32x16& p0, f32x16& p1, const char* K_lds, int r32, int hi, const bf16x8* qr, bool act) {
    if (SK && !act) { const float NEG = -__builtin_inff();
#pragma unroll
        for (int r = 0; r < 16; ++r) { p0[r] = NEG; p1[r] = NEG; } return; }
    p0 = f32x16{}; p1 = f32x16{};
    const char* kb[4];
#pragma unroll
    for (int dd = 0; dd < 4; ++dd) kb[dd] = K_lds + KB * SHM_K + KSWZ(r32, (dd * 16 + hi * 8) * 2);
#pragma unroll
    for (int d0 = 0; d0 < 8; ++d0) { const char* a = kb[d0 & 3] + (d0 >> 2) * 128;
        bf16x8 b0 = *reinterpret_cast<const bf16x8*>(a);
        bf16x8 b1 = *reinterpret_cast<const bf16x8*>(a + 32 * 256);
        p0 = __builtin_amdgcn_mfma_f32_32x32x16_bf16(b0, qr[d0], p0, 0, 0, 0);
        p1 = __builtin_amdgcn_mfma_f32_32x32x16_bf16(b1, qr[d0], p1, 0, 0, 0); }
}
template <int VB, bool SK>
__device__ __forceinline__ void pv_tile(f32x16* o, int vb0, bf16x8 pa0, bf16x8 pa1, bf16x8 pa2, bf16x8 pa3, bool act) {
    if (SK && !act) return;
#define TRRD(dst, off) asm volatile("ds_read_b64_tr_b16 %0, %1 offset:%2" : "=&v"(dst) : "v"(vb0), "i"(off) : "memory")
#define PV_D0(d0) do { s16x4 l0, l1, l2, l3, h0, h1, h2, h3; constexpr int b_ = VB * SHM_V + v_rd_off(d0, 0, 0);     \
        TRRD(l0, b_); TRRD(h0, b_ + 2048); TRRD(l1, b_ + 4096); TRRD(h1, b_ + 6144); TRRD(l2, b_ + 8192); TRRD(h2, b_ + 10240); TRRD(l3, b_ + 12288); TRRD(h3, b_ + 14336); \
        asm volatile("s_waitcnt lgkmcnt(0)" ::: "memory"); SBAR();                 \
        o[d0] = __builtin_amdgcn_mfma_f32_32x32x16_bf16(pa0, (bf16x8){l0[0], l0[1], l0[2], l0[3], h0[0], h0[1], h0[2], h0[3]}, o[d0], 0, 0, 0);   \
        o[d0] = __builtin_amdgcn_mfma_f32_32x32x16_bf16(pa1, (bf16x8){l1[0], l1[1], l1[2], l1[3], h1[0], h1[1], h1[2], h1[3]}, o[d0], 0, 0, 0);   \
        o[d0] = __builtin_amdgcn_mfma_f32_32x32x16_bf16(pa2, (bf16x8){l2[0], l2[1], l2[2], l2[3], h2[0], h2[1], h2[2], h2[3]}, o[d0], 0, 0, 0);   \
        o[d0] = __builtin_amdgcn_mfma_f32_32x32x16_bf16(pa3, (bf16x8){l3[0], l3[1], l3[2], l3[3], h3[0], h3[1], h3[2], h3[3]}, o[d0], 0, 0, 0); } while (0)
    PV_D0(0); PV_D0(1); PV_D0(2); PV_D0(3);
#undef PV_D0
#undef TRRD
}

struct BlockRef { const bf16* Q; const bf16* K; const bf16* V; float* O; float* L; int qs, kvs, os, ls, P0, skv; };
struct Seam {
    bf16x8 qr[8];
    bf16x8 st_v0, st_v1, st_k0, st_k1;
};
__device__ __forceinline__ int swa_jlo(int P0, int W) { const int lowk = P0 - W + 1; return lowk > 0 ? lowk / KVBLK : 0; }
#define ROWP(p, st, k0) ((p) + (size_t)(k0) * (size_t)(st))
#define VMW() asm volatile("s_waitcnt vmcnt(0)" ::: "memory")
#define VMWN(n) asm volatile("s_waitcnt vmcnt(%0)" :: "i"(n) : "memory")
#define SLOAD_H(Kp, Vp, st, k0) do { const bf16* kp_ = ROWP(Kp, st, k0); const bf16* vp_ = ROWP(Vp, st, k0); const unsigned o0_ = (unsigned)(sr * (st) + sc), o1_ = o0_ + 32u * (unsigned)(st); \
                         S.st_v0 = load8(vp_ + o0_); S.st_v1 = load8(vp_ + o1_); S.st_k0 = load8(kp_ + o0_); S.st_k1 = load8(kp_ + o1_); } while (0)
#define SWRITE_HK(bf) do { *(bf16x8*)(K_lds + (bf) * SHM_K + kws) = S.st_k0; *(bf16x8*)(K_lds + (bf) * SHM_K + kws + 32 * 256) = S.st_k1; } while (0)
#define SWRITE_HV(bf) do { *(bf16x8*)(V_lds + (bf) * SHM_V + vst0) = S.st_v0; *(bf16x8*)(V_lds + (bf) * SHM_V + vst1) = S.st_v1; } while (0)
#define SWRITE_H(bf) do { SWRITE_HV(bf); SWRITE_HK(bf); } while (0)
__device__ __forceinline__ void causal_swa_prime(const BlockRef& cur, int W, char* lds, Seam& S, int tid) {
    const int wid = __builtin_amdgcn_readfirstlane(tid >> 6), lane = tid & 63, r32 = lane & 31, hi = lane >> 5;
    const int sr = tid >> 4, sc = (tid & 15) * 8, kws = KSWZ(sr, sc * 2); char* K_lds = lds + 2 * SHM_V;
    const int kb0 = swa_jlo(cur.P0, W) * KVBLK;
    { const unsigned qo_ = (unsigned)((wid * QBLK + r32) * cur.qs + hi * 8);
    for (int d0 = 0; d0 < 8; ++d0) S.qr[d0] = load8(cur.Q + qo_ + d0 * 16); }
    SLOAD_H(cur.K, cur.V, cur.kvs, kb0); VMW(); SWRITE_HK(0);
    __syncthreads();
}
template <bool WSK>
__device__ __forceinline__ void causal_swa_block(const BlockRef& cur, const BlockRef& nxt, int W, char* lds, Seam& S, int tid) {
    const int wid = __builtin_amdgcn_readfirstlane(tid >> 6), lane = tid & 63, r32 = lane & 31, hi = lane >> 5;
    const int skv = cur.skv;
    const int j_lo = swa_jlo(cur.P0, W);
    int j_hi = (cur.P0 + QB - 1) / KVBLK + 1; if (j_hi > skv / KVBLK) j_hi = skv / KVBLK;
    const int NT = j_hi - j_lo;
    const int kbn = swa_jlo(nxt.P0, W) * KVBLK;
    const int qlo = cur.P0 + wid * QBLK, qm = qlo + r32 - 4 * hi;
    char* V_lds = lds; char* K_lds = lds + 2 * SHM_V;
    float* ws = (float*)(lds + 2 * SHM_V + 2 * SHM_K) + wid * 64; float* li_l = ws, * al_l = ws + 32;
    float m_reg = -1e30f, l_reg = 0; f32x16 o[4] = {};
    const int sr = tid >> 4, sc = (tid & 15) * 8, vst0 = v_st(sr, sc), vst1 = v_st(32 + sr, sc), kws = KSWZ(sr, sc * 2);
    const int vb0 = (int)(uintptr_t)V_lds + v_rd_base(lane);
    const bf16* Kh = cur.K; const bf16* Vh = cur.V; const int kvs = cur.kvs;
#define RESC(a) do { if (__any((a) < 1.f)) { if (hi == 0) al_l[r32] = (a); asm volatile("s_waitcnt lgkmcnt(0)" ::: "memory");              \
                     for (int d_ = 0; d_ < 4; ++d_) for (int r = 0; r < 16; ++r) o[d_][r] *= al_l[crow(r, hi)]; } } while (0)
#define KBASE(t) ((j_lo + (t)) * KVBLK)
#define ACT(t) (KBASE(t) <= qlo + QBLK - 1 && KBASE(t) + KVBLK - 1 >= qlo - W + 1)
#define MASKT(P0_, P1_, t) do { const int kb_ = KBASE(t); if ((!SK || ACT(t)) && (kb_ + KVBLK - 1 > qlo || kb_ <= qlo + QBLK - 1 - W)) mask_tile(P0_, P1_, qm - kb_, (unsigned)W); } while (0)
    constexpr int NQL = 8;
    constexpr bool SK = WSK;
#define SEAM_K0() do { VMWN(NQL); SWRITE_HK(0); SBAR(); } while (0)
    f32x16 pA0, pA1, pB0, pB1; float mnA, mnB, alA, alB; bf16x8 pa0, pa1, pa2, pa3;
    SWRITE_HV(0); SBAR();
    if (NT > 1) { SLOAD_H(Kh, Vh, kvs, KBASE(1)); }
    SBAR(); qkt<0, SK>(pA0, pA1, K_lds, r32, hi, S.qr, ACT(0));
    MASKT(pA0, pA1, 0); partialSM(pA0, pA1, m_reg, mnA, alA);
    if (NT > 1) { VMW(); SWRITE_H(1); }
    __syncthreads();
#define HALF_STEP(PX0, PX1, mnX, alX, PY0, PY1, alY, t, KB, VB, SB) do {                                                      \
        SBAR(); qkt<KB, SK>(PX0, PX1, K_lds, r32, hi, S.qr, ACT(t));                                             \
        finishSM(PY0, PY1, alY, l_reg, pa0, pa1, pa2, pa3); SBAR();                                                           \
        if ((t) + 1 < NT) { SLOAD_H(Kh, Vh, kvs, KBASE((t) + 1)); SBAR(); }                                               \
        pv_tile<VB, SK>(o, vb0, pa0, pa1, pa2, pa3, ACT((t) - 1)); MASKT(PX0, PX1, (t)); partialSM(PX0, PX1, m_reg, mnX, alX);                                        \
        __syncthreads();                                                                                                      \
        if ((t) + 1 < NT) { VMW(); SWRITE_H(SB); }                                                                          \
        RESC(alX); __syncthreads(); } while (0)
    for (int t = 1; t + 1 < NT; t += 2) {
        HALF_STEP(pB0, pB1, mnB, alB, pA0, pA1, alA, t, 1, 0, 0);
        HALF_STEP(pA0, pA1, mnA, alA, pB0, pB1, alB, t + 1, 0, 1, 1);
    }
    const bool even = (NT & 1) == 0;
    if (even) { SBAR(); qkt<1, SK>(pB0, pB1, K_lds, r32, hi, S.qr, ACT(NT - 1)); SBAR(); }
    { SLOAD_H(nxt.K, nxt.V, nxt.kvs, kbn); SBAR();
#pragma unroll
        for (int d0 = 0; d0 < 8; ++d0) S.qr[d0] = load8(nxt.Q + (unsigned)((wid * QBLK + r32) * nxt.qs + hi * 8) + d0 * 16); }
    SBAR();
    finishSM(pA0, pA1, alA, l_reg, pa0, pa1, pa2, pa3); SBAR();
    pv_tile<0, SK>(o, vb0, pa0, pa1, pa2, pa3, ACT(even ? NT - 2 : NT - 1));
    if (even) { MASKT(pB0, pB1, NT - 1); partialSM(pB0, pB1, m_reg, mnB, alB); __syncthreads(); RESC(alB);
        finishSM(pB0, pB1, alB, l_reg, pa0, pa1, pa2, pa3); SBAR(); pv_tile<1, SK>(o, vb0, pa0, pa1, pa2, pa3, ACT(NT - 1)); }
    SBAR(); SEAM_K0();
    if (hi == 0) li_l[r32] = l_reg; asm volatile("s_waitcnt lgkmcnt(0)" ::: "memory");
    if (cur.L != nullptr && hi == 0) cur.L[(unsigned)((wid * QBLK + r32) * cur.ls)] = m_reg * SCALE + __logf(l_reg);
    float rli[16];
#pragma unroll
    for (int r = 0; r < 16; ++r) rli[r] = __builtin_amdgcn_rcpf(li_l[crow(r, hi)]);
    float* Ow = cur.O + (size_t)(wid * QBLK) * (size_t)cur.os;
#pragma unroll
    for (int r = 0; r < 16; ++r) { const int orow = crow(r, hi);
#pragma unroll
        for (int d0 = 0; d0 < 4; ++d0) { const float v = o[d0][r] * rli[r];
            Ow[(unsigned)(orow * cur.os + d0 * 32 + r32)] = v; } }
    __syncthreads();
#undef RESC
#undef KBASE
#undef ACT
#undef MASKT
#undef SEAM_K0
#undef HALF_STEP
}
#undef ROWP
#undef VMW
#undef VMWN
#undef SLOAD_H
#undef SWRITE_HK
#undef SWRITE_HV
#undef SWRITE_H
#undef KSWZ
#undef SBAR
}
#define GAS __attribute__((address_space(1)))
#define LAS __attribute__((address_space(3)))
typedef unsigned short bf16;
typedef unsigned v4u __attribute__((ext_vector_type(4)));
typedef float f32x4 __attribute__((ext_vector_type(4)));
typedef short bf16x8 __attribute__((ext_vector_type(8)));
typedef GAS unsigned gu32;
typedef GAS unsigned long long gu64;
#define RLX_AGENT __ATOMIC_RELAXED, __HIP_MEMORY_SCOPE_AGENT
#define LDS_WAIT() asm volatile("s_waitcnt lgkmcnt(0)" ::: "memory")
#define VM_WAIT() asm volatile("s_waitcnt vmcnt(0)" ::: "memory")
__device__ __forceinline__ unsigned long long rt() { return __builtin_amdgcn_s_memrealtime(); }
__device__ __forceinline__ unsigned f2bf(float f) { unsigned u = __builtin_bit_cast(unsigned, f); return (u + 0x7fffu + ((u >> 16) & 1u)) >> 16; }
__device__ __forceinline__ unsigned pk2(float lo, float hi) { return f2bf(lo) | (f2bf(hi) << 16); }

#define XB_TMO      128
#define XB_XCNT(j)  (256  + 64 * (j))
#define XB_XSUB(j)  (1280 + 64 * (j))
#define XB_XGEN(j)  (2304 + 64 * (j))
#define XB_TOP      3328
#define XB_TOPGEN   3392
#define XCD_BAR_WORDS 3456
#define XB_SPIN_CAP (1u << 18)

__device__ __forceinline__ unsigned xb_ld(unsigned* p)              { return __hip_atomic_load(p, __ATOMIC_RELAXED, __HIP_MEMORY_SCOPE_AGENT); }
__device__ __forceinline__ unsigned xb_add(unsigned* p, unsigned v) { return __hip_atomic_fetch_add(p, v, __ATOMIC_RELAXED, __HIP_MEMORY_SCOPE_AGENT); }
__device__ __forceinline__ unsigned xb_xcc_id() { return (unsigned)__builtin_amdgcn_s_getreg((3 << 11) | 20) & 0xFu; }
#define XB_SPIN(cond, bar) do { unsigned _sp = 0; while (cond) { __builtin_amdgcn_s_sleep(1); \
    if ((++_sp & 255u) == 0u) { if (xb_ld(&(bar)[XB_TMO])) break; if (_sp > XB_SPIN_CAP) { atomicAdd(&(bar)[XB_TMO], 1u); break; } } } } while (0)

struct XcdBarrier {
    unsigned* bar; unsigned x;
    volatile LAS unsigned* st;
};

__device__ __forceinline__ XcdBarrier xcd_barrier_post(unsigned* bar, volatile LAS unsigned* st, bool leader  ) {
    XcdBarrier b; b.bar = bar; b.x = xb_xcc_id(); b.st = st;
    if (leader) (void)xb_add(&bar[XB_XCNT(b.x)], 1u);
    return b;
}
__device__ __forceinline__ void xcd_barrier_complete(unsigned* bar, unsigned x, unsigned& nloc, unsigned& nx) {
    const unsigned G = gridDim.x * gridDim.y * gridDim.z;
    unsigned sum, cnt, mine, sp = 0u;
    for (;;) {
        sum = 0u; cnt = 0u; mine = 0u;
#pragma unroll
        for (unsigned j = 0; j < 16; ++j) { const unsigned c = xb_ld(&bar[XB_XCNT(j)]); sum += c; cnt += (c > 0u) ? 1u : 0u; mine = (j == x) ? c : mine; }
        if (sum == G) break;
        __builtin_amdgcn_s_sleep(1);
        if ((++sp & 255u) == 0u) { if (xb_ld(&bar[XB_TMO])) break; if (sp > XB_SPIN_CAP) { atomicAdd(&bar[XB_TMO], 1u); break; } }
    }
    nloc = mine > 0u ? mine : 1u; nx = cnt > 0u ? cnt : 1u;
}

__device__ __forceinline__ void xcd_barrier(const XcdBarrier& b, bool leader  ) {
    asm volatile("s_waitcnt vmcnt(0)" ::: "memory");
    __syncthreads();
    if (leader) {
        unsigned* bar = b.bar;
        __builtin_amdgcn_s_waitcnt(0);
        unsigned nloc = b.st[0], nx = b.st[1];
        if (nloc == 0u) { xcd_barrier_complete(bar, b.x, nloc, nx); b.st[0] = nloc; b.st[1] = nx; }
        const unsigned old = xb_add(&bar[XB_XSUB(b.x)], 1u);
        const unsigned gen = old / nloc;
        if (old + 1u == (gen + 1u) * nloc) {
            __builtin_amdgcn_fence(__ATOMIC_RELEASE, "agent");
            asm volatile("s_waitcnt vmcnt(0)" ::: "memory");
            const unsigned og = xb_add(&bar[XB_TOP], 1u);
            const unsigned tg = og / nx;
            if (og + 1u == (tg + 1u) * nx) xb_add(&bar[XB_TOPGEN], 1u);
            else XB_SPIN(xb_ld(&bar[XB_TOPGEN]) == tg, bar);
            __builtin_amdgcn_fence(__ATOMIC_ACQUIRE, "agent");
            xb_add(&bar[XB_XGEN(b.x)], 1u);
            asm volatile("s_waitcnt vmcnt(0)" ::: "memory");
        } else {
            XB_SPIN(xb_ld(&bar[XB_XGEN(b.x)]) == gen, bar);
            __builtin_amdgcn_fence(__ATOMIC_ACQUIRE, "agent");
            asm volatile("s_waitcnt vmcnt(0)" ::: "memory");
        }
    }
    __syncthreads();
}

constexpr int NWAVES = 8;
#ifndef MK_ONE_LAUNCH
#define MK_ONE_LAUNCH 1
#endif

constexpr int BATCH = 4, SEQ = 4096, DM = 2048, M = BATCH * SEQ, HD = 128;
constexpr int NQKV_A = 9216, AGW = 1024, DFF = 8192, NMOD = 6 * DM, NKV = 2 * DM;
constexpr float NORM_EPS = 1e-6f;
constexpr int N_STAGE = 5;
constexpr int N_PHASE = 41;

constexpr size_t MiB = 1u << 20;
constexpr size_t WS_CTL = 0, CTL_ZERO_BYTES = 1 * MiB;
constexpr size_t WS_MOD = 1 * MiB;
constexpr size_t WS_COS = 2 * MiB, WS_SIN = 3 * MiB;
constexpr size_t WS_LA = 4 * MiB;
constexpr size_t WS_MODP = 8 * MiB;
constexpr size_t WS_WQKVA = 40 * MiB;
constexpr size_t WS_WOA = 112 * MiB;
constexpr size_t WS_WKV = 120 * MiB;
constexpr size_t WS_WQB = 136 * MiB;
constexpr size_t WS_WOB = 152 * MiB;
constexpr size_t WS_W1 = 168 * MiB;
constexpr size_t WS_W2 = 296 * MiB;
constexpr size_t WS_H = 424 * MiB;
constexpr size_t WS_AO = 488 * MiB;
constexpr size_t WS_KVB = 552 * MiB;
constexpr size_t WS_QKV = 680 * MiB;
constexpr size_t WS_OP = 968 * MiB;
constexpr size_t WS_END = 1224 * MiB;
constexpr int MOD_TOTAL = 4 * BATCH * NMOD + BATCH * NKV;
constexpr int MOD_KV_OFF = 4 * BATCH * NMOD;
constexpr int GEMV_KC = 32, GEMV_KLEN = DM / GEMV_KC;
constexpr int CW_BAR = 4096;

constexpr int RING_OFF = 0, RING_BYTES = 131072;
constexpr int LDSCTL_OFF = RING_BYTES, MISC_OFF = LDSCTL_OFF + 320;
constexpr int LDS_BYTES = 147456;


struct Args {
    const float* x; const float* c; const int* pos; const float* ada_w; const float* ada_b; const float* norm_g;
    const float* a_w_qkv; const float* a_q_gain; const float* a_k_gain; const float* a_w_o;
    const float* kv_ada_w; const float* kv_ada_b; const float* kv_norm_g; const float* kv_w_k; const float* kv_w_v; const float* kv_k_gain;
    const float* b_w_q; const float* b_q_gain; const float* b_lambda; const float* b_subln_g; const float* b_w_o;
    const float* mlp_w1; const float* mlp_w2;
    float* out; unsigned char* ws;
    float inv_freq[16]; float lam_init[2];
    int ph_lo, ph_hi;
};
static_assert(sizeof(Args) == 25 * 8 + 16 * 4 + 2 * 4 + 2 * 4, "Args has no padding bytes");
typedef __attribute__((address_space(4))) const Args* ArgsP;
__device__ __forceinline__ ArgsP get_args() { ArgsP p = (ArgsP)__builtin_amdgcn_kernarg_segment_ptr(); asm volatile("" : "+s"(p)); return p; }
struct Ctx { int tid, lane, wave, G, bx, vcu, gw, NGW; };
__device__ __forceinline__ Ctx fresh_ctx(int wave_s) {
    Ctx c; int ln; asm volatile("v_mbcnt_lo_u32_b32 %0, -1, 0\n\tv_mbcnt_hi_u32_b32 %0, -1, %0" : "=v"(ln));     const int t = wave_s * 64 + ln;
    int G = gridDim.x, bx = blockIdx.x; asm volatile("" : "+s"(G), "+s"(bx));
    c.tid = t; c.lane = t & 63; c.wave = __builtin_amdgcn_readfirstlane(t >> 6); c.G = G; c.bx = bx;
    c.vcu = (G % 8 == 0) ? (bx % 8) * (G / 8) + bx / 8 : bx;
    c.gw = c.vcu * 8 + c.wave; c.NGW = G * 8; return c;
}

typedef unsigned short bfu;
typedef unsigned u32x2 __attribute__((ext_vector_type(2)));

__device__ __forceinline__ float shx(float v, int o, int lane) { return __int_as_float(__builtin_amdgcn_ds_bpermute((lane ^ o) << 2, __float_as_int(v))); }
__device__ __forceinline__ float wave_sum(float v, int lane) {
#pragma unroll
    for (int o = 1; o < 64; o <<= 1) v += shx(v, o, lane);
    return v;
}
__device__ __forceinline__ float bf2f(unsigned bits16) { return __uint_as_float(bits16 << 16); }
__device__ __forceinline__ unsigned pkbf(float lo, float hi) { return pg8::cvt_pk_bf16(lo, hi); }

__device__ __forceinline__ void transpose_item(const float* __restrict__ W, int K, int N, bfu* __restrict__ WT, int item, int lane) {
    const int nb = N >> 6, kb = item / nb, nbi = item - kb * nb, k0 = kb << 6, n0 = nbi << 6;
    const float* src = W + (size_t)k0 * N + n0 + lane;
    float v[64];
#pragma unroll
    for (int i = 0; i < 64; ++i) v[i] = src[(size_t)i * N];
    bfu* dst = WT + (size_t)(n0 + lane) * K + k0;
#pragma unroll
    for (int kk = 0; kk < 8; ++kk) { v4u o; o.x = pkbf(v[8 * kk + 0], v[8 * kk + 1]); o.y = pkbf(v[8 * kk + 2], v[8 * kk + 3]); o.z = pkbf(v[8 * kk + 4], v[8 * kk + 5]); o.w = pkbf(v[8 * kk + 6], v[8 * kk + 7]);
        *(v4u*)(dst + 8 * kk) = o; }
}

__device__ __forceinline__ void p0_prologue(ArgsP a, LAS unsigned char* lds, int tid, int lane, int wave, int vcu, int G) {
    unsigned char* ws = a->ws;
    LAS float* cact = (LAS float*)lds;
    LAS float* ifr = (LAS float*)(lds + 32768);
    for (int i = tid; i < BATCH * DM; i += NWAVES * 64) { const int b = i / DM, k = i - b * DM; const float v = a->c[i]; cact[k * 4 + b] = v / (1.f + expf(-v)); }
    if (tid == 0) {
        ifr[0] = a->inv_freq[0]; ifr[1] = a->inv_freq[1]; ifr[2] = a->inv_freq[2]; ifr[3] = a->inv_freq[3]; ifr[4] = a->inv_freq[4]; ifr[5] = a->inv_freq[5]; ifr[6] = a->inv_freq[6]; ifr[7] = a->inv_freq[7];
        ifr[8] = a->inv_freq[8]; ifr[9] = a->inv_freq[9]; ifr[10] = a->inv_freq[10]; ifr[11] = a->inv_freq[11]; ifr[12] = a->inv_freq[12]; ifr[13] = a->inv_freq[13]; ifr[14] = a->inv_freq[14]; ifr[15] = a->inv_freq[15];
    }
    __syncthreads();
    const int gw = vcu * NWAVES + wave, NGW = G * NWAVES;
    {
        constexpr int ITEMS_L = (NMOD / 256) * GEMV_KC, ITEMS_KV = (NKV / 256) * GEMV_KC, NITEMS = 4 * ITEMS_L + ITEMS_KV;
        float* MODP = (float*)(ws + WS_MODP);
        for (int it = gw; it < NITEMS; it += NGW) {
            const float* W; int N, slab, kc, moff;
            if (it < 4 * ITEMS_L) { const int l = it / ITEMS_L, r = it - l * ITEMS_L; slab = r / GEMV_KC; kc = r - slab * GEMV_KC; W = a->ada_w + (size_t)l * DM * NMOD; N = NMOD; moff = l * BATCH * NMOD; }
            else { const int r = it - 4 * ITEMS_L; slab = r / GEMV_KC; kc = r - slab * GEMV_KC; W = a->kv_ada_w; N = NKV; moff = MOD_KV_OFF; }
            const int n0 = slab * 256 + lane * 4, k0 = kc * GEMV_KLEN;
            f32x4 acc0 = {0.f, 0.f, 0.f, 0.f}, acc1 = acc0, acc2 = acc0, acc3 = acc0;
            const float* wp = W + (size_t)k0 * N + n0;
#pragma unroll 16
            for (int k = 0; k < GEMV_KLEN; ++k) {
                const f32x4 w = *(const f32x4*)(wp + (size_t)k * N);
                const f32x4 cv = *(const LAS f32x4*)(cact + (k0 + k) * 4);
                acc0 += w * cv.x; acc1 += w * cv.y; acc2 += w * cv.z; acc3 += w * cv.w;
            }
            float* mp = MODP + (size_t)kc * MOD_TOTAL + moff + n0;
            *(f32x4*)(mp) = acc0; *(f32x4*)(mp + N) = acc1; *(f32x4*)(mp + 2 * N) = acc2; *(f32x4*)(mp + 3 * N) = acc3;
        }
    }
    {
        float* cosT = (float*)(ws + WS_COS); float* sinT = (float*)(ws + WS_SIN);
        for (int i = vcu * (NWAVES * 64) + tid; i < M * 16; i += G * NWAVES * 64) {
            const int row = i >> 4, j = i & 15; const float ang = (float)a->pos[row] * ifr[j];
            cosT[i] = cosf(ang); sinT[i] = sinf(ang); }
    }
    {
        bfu* WQKVA = (bfu*)(ws + WS_WQKVA); bfu* WOA = (bfu*)(ws + WS_WOA); bfu* WKV = (bfu*)(ws + WS_WKV); bfu* WQB = (bfu*)(ws + WS_WQB); bfu* WOB = (bfu*)(ws + WS_WOB);
        bfu* W1 = (bfu*)(ws + WS_W1); bfu* W2 = (bfu*)(ws + WS_W2);
        constexpr int NT_ITEMS = 49152;
        for (int it = gw; it < NT_ITEMS; it += NGW) {
            int r = it; const float* W; bfu* WT; int K, N, item;
            if (r < 9216) { const int l = r / 4608; W = a->a_w_qkv + (size_t)l * DM * NQKV_A; K = DM; N = NQKV_A; WT = WQKVA + (size_t)l * NQKV_A * DM; item = r - l * 4608; }
            else if ((r -= 9216) < 1024) { const int l = r / 512; W = a->a_w_o + (size_t)l * AGW * DM; K = AGW; N = DM; WT = WOA + (size_t)l * DM * AGW; item = r - l * 512; }
            else if ((r -= 1024) < 1024) { W = a->kv_w_k; K = DM; N = DM; WT = WKV; item = r; }
            else if ((r -= 1024) < 1024) { W = a->kv_w_v; K = DM; N = DM; WT = WKV + (size_t)DM * DM; item = r; }
            else if ((r -= 1024) < 2048) { const int j = r / 1024; W = a->b_w_q + (size_t)j * DM * DM; K = DM; N = DM; WT = WQB + (size_t)j * DM * DM; item = r - j * 1024; }
            else if ((r -= 2048) < 2048) { const int j = r / 1024; W = a->b_w_o + (size_t)j * DM * DM; K = DM; N = DM; WT = WOB + (size_t)j * DM * DM; item = r - j * 1024; }
            else if ((r -= 2048) < 16384) { const int l = r / 4096; W = a->mlp_w1 + (size_t)l * DM * DFF; K = DM; N = DFF; WT = W1 + (size_t)l * DFF * DM; item = r - l * 4096; }
            else { r -= 16384; const int l = r / 4096; W = a->mlp_w2 + (size_t)l * DFF * DM; K = DFF; N = DM; WT = W2 + (size_t)l * DM * DFF; item = r - l * 4096; }
            transpose_item(W, K, N, WT, item, lane);
        }
    }
}

__device__ __forceinline__ void p0b_modreduce(ArgsP a, int tid, int vcu, int G) {
    const float* MODP = (const float*)(a->ws + WS_MODP); float* MOD = (float*)(a->ws + WS_MOD);
    for (int i4 = vcu * (NWAVES * 64) + tid; i4 < MOD_TOTAL / 4; i4 += G * NWAVES * 64) {
        const int i = i4 * 4; f32x4 s;
        if (i < MOD_KV_OFF) { const int l = i / (BATCH * NMOD), n = i % NMOD; s = *(const f32x4*)(a->ada_b + (size_t)l * NMOD + n); }
        else { const int n = (i - MOD_KV_OFF) % NKV; s = *(const f32x4*)(a->kv_ada_b + n); }
#pragma unroll 8
        for (int kc = 0; kc < GEMV_KC; ++kc) s += *(const f32x4*)(MODP + (size_t)kc * MOD_TOTAL + i);
        *(f32x4*)(MOD + i) = s;
    }
}

__device__ __forceinline__ void norm_phase(const float* X, const float* g, const float* shift, const float* scale, int bstride, bfu* H, int lane, int gw, int NGW) {
    for (int rb = gw; rb < M / 8; rb += NGW) {
        const int row0 = rb * 8, b = row0 / SEQ;
        f32x4 gs[8], sh[8];
#pragma unroll
        for (int j = 0; j < 8; ++j) { const int col = 4 * lane + 256 * j;
            const f32x4 gv = *(const f32x4*)(g + col), sc = *(const f32x4*)(scale + (size_t)b * bstride + col);
            gs[j] = gv * (sc + 1.0f); sh[j] = *(const f32x4*)(shift + (size_t)b * bstride + col); }
        for (int r = 0; r < 8; ++r) {
            const float* xr = X + (size_t)(row0 + r) * DM + 4 * lane; f32x4 v[8]; float ss = 0.f;
#pragma unroll
            for (int j = 0; j < 8; ++j) { v[j] = *(const f32x4*)(xr + 256 * j); ss += (v[j].x * v[j].x + v[j].y * v[j].y) + (v[j].z * v[j].z + v[j].w * v[j].w); }
            ss = wave_sum(ss, lane);
            const float rstd = 1.0f / sqrtf(ss * (1.0f / DM) + NORM_EPS);
            bfu* hr = H + (size_t)(row0 + r) * DM + 4 * lane;
#pragma unroll
            for (int j = 0; j < 8; ++j) { const f32x4 o = v[j] * rstd * gs[j] + sh[j]; u32x2 w; w.x = pkbf(o.x, o.y); w.y = pkbf(o.z, o.w); *(u32x2*)(hr + 256 * j) = w; }
        }
    }
}

template <int KIND>
__device__ __forceinline__ void qknorm_phase(bfu* buf, const float* gq, const float* gk, const float* cosT, const float* sinT, int lane, int gw, int NGW) {
    constexpr int NQUAD = KIND == 0 ? 12 : 4; constexpr int LD = KIND == 0 ? NQKV_A : (KIND == 1 ? NKV : DM);
    const int sub = lane & 15, ql = lane >> 4;
    for (int it = gw; it < M * NQUAD; it += NGW) {
        const int row = it / NQUAD, q = it - row * NQUAD; const int j = q * 4 + ql;
        int col; const float* gain;
        if (KIND == 0) { const int g = j >> 4, typ = (j >> 3) & 1, h = j & 7; col = g * 3072 + typ * 1024 + h * 128; gain = (typ ? gk : gq) + g * 128; }
        else { col = j * 128; gain = gq + (j & 1) * 128; }
        bfu* p = buf + (size_t)row * LD + col + sub * 8;
        const v4u raw = *(const v4u*)p;
        float v[8];
        v[0] = bf2f(raw.x & 0xffffu); v[1] = bf2f(raw.x >> 16); v[2] = bf2f(raw.y & 0xffffu); v[3] = bf2f(raw.y >> 16);
        v[4] = bf2f(raw.z & 0xffffu); v[5] = bf2f(raw.z >> 16); v[6] = bf2f(raw.w & 0xffffu); v[7] = bf2f(raw.w >> 16);
        float ss = 0.f;
#pragma unroll
        for (int i = 0; i < 8; ++i) ss += v[i] * v[i];
        ss += shx(ss, 1, lane); ss += shx(ss, 2, lane); ss += shx(ss, 4, lane); ss += shx(ss, 8, lane);
        const float rstd = 1.0f / sqrtf(ss * (1.0f / HD) + NORM_EPS);
        const f32x4 g0 = *(const f32x4*)(gain + sub * 8), g1 = *(const f32x4*)(gain + sub * 8 + 4);
        v[0] *= rstd * g0.x; v[1] *= rstd * g0.y; v[2] *= rstd * g0.z; v[3] *= rstd * g0.w; v[4] *= rstd * g1.x; v[5] *= rstd * g1.y; v[6] *= rstd * g1.z; v[7] *= rstd * g1.w;
        float pv[8];
#pragma unroll
        for (int i = 0; i < 8; ++i) pv[i] = shx(v[i], 2, lane);
        if (sub < 4) {
            const float* cp = cosT + (size_t)row * 16 + (sub & 1) * 8; const float* sp = sinT + (size_t)row * 16 + (sub & 1) * 8;
            const f32x4 c0 = *(const f32x4*)cp, c1 = *(const f32x4*)(cp + 4), s0 = *(const f32x4*)sp, s1 = *(const f32x4*)(sp + 4);
            const float cs[8] = {c0.x, c0.y, c0.z, c0.w, c1.x, c1.y, c1.z, c1.w}; const float sn[8] = {s0.x, s0.y, s0.z, s0.w, s1.x, s1.y, s1.z, s1.w};
            const float sgn = (sub < 2) ? -1.0f : 1.0f;
#pragma unroll
            for (int i = 0; i < 8; ++i) v[i] = v[i] * cs[i] + sgn * pv[i] * sn[i];
        }
        v4u o; o.x = pkbf(v[0], v[1]); o.y = pkbf(v[2], v[3]); o.z = pkbf(v[4], v[5]); o.w = pkbf(v[6], v[7]);
        *(v4u*)p = o;
    }
}

__device__ __forceinline__ void combineA_phase(const float* OP, const float* LA, bfu* AO, int lane, int gw, int NGW) {
    for (int row = gw; row < M; row += NGW) {
#pragma unroll
        for (int j = 0; j < 4; ++j) { const int col = 4 * lane + 256 * j, h = col >> 7;
            const float l0 = LA[(size_t)row * 8 + h], l1 = LA[(size_t)M * 8 + (size_t)row * 8 + h], l2 = LA[(size_t)2 * M * 8 + (size_t)row * 8 + h];
            const float mx = fmaxf(l0, fmaxf(l1, l2)); const float e0 = expf(l0 - mx), e1 = expf(l1 - mx), e2 = expf(l2 - mx); const float inv = 1.0f / (e0 + e1 + e2);
            const f32x4 o0 = *(const f32x4*)(OP + (size_t)row * AGW + col), o1 = *(const f32x4*)(OP + (size_t)M * AGW + (size_t)row * AGW + col), o2 = *(const f32x4*)(OP + (size_t)2 * M * AGW + (size_t)row * AGW + col);
            const f32x4 o = (o0 * e0 + o1 * e1 + o2 * e2) * inv;
            u32x2 w; w.x = pkbf(o.x, o.y); w.y = pkbf(o.z, o.w); *(u32x2*)(AO + (size_t)row * AGW + col) = w; }
    }
}
__device__ __forceinline__ void combineB_phase(const float* OP, const float* lp, const float* subg, float lam_init, bfu* AO, int lane, int gw, int NGW) {
    float s1 = lp[lane] * lp[128 + lane] + lp[64 + lane] * lp[192 + lane], s2 = lp[256 + lane] * lp[384 + lane] + lp[320 + lane] * lp[448 + lane];
    s1 = wave_sum(s1, lane); s2 = wave_sum(s2, lane);
    const float lam = expf(s1) - expf(s2) + lam_init;
    const f32x4 sg = *(const f32x4*)(subg + 4 * lane) * (1.0f - lam_init);
    for (int row = gw; row < M; row += NGW) {
        const float* p0 = OP + (size_t)row * DM + 4 * lane; const float* p1 = p0 + (size_t)M * DM;
        bfu* ao = AO + (size_t)row * DM + 4 * lane;
#pragma unroll
        for (int j = 0; j < 8; ++j) {
            const f32x4 o = *(const f32x4*)(p0 + 256 * j) - *(const f32x4*)(p1 + 256 * j) * lam;
            float ss = (o.x * o.x + o.y * o.y) + (o.z * o.z + o.w * o.w); ss = wave_sum(ss, lane);
            const float rstd = 1.0f / sqrtf(ss * (1.0f / 256.0f) + NORM_EPS);
            const f32x4 r = o * rstd * sg; u32x2 w; w.x = pkbf(r.x, r.y); w.y = pkbf(r.z, r.w); *(u32x2*)(ao + 256 * j) = w; }
    }
}

__device__ __forceinline__ swa::BlockRef attnA_ref(int L, const bfu* QKV, float* OP, float* LA) {
    const int g = L >> 9, rem = L & 511, bh = rem >> 4, sub = rem & 15, dsh = 2 * g, d = 1 << dsh;
    const int r = sub >> (4 - dsh), qb = sub & ((16 >> dsh) - 1), b = bh >> 3, h = bh & 7;
    const size_t tok0 = (size_t)b * SEQ + r, tq = tok0 + (size_t)d * 256 * qb;
    swa::BlockRef R;
    R.Q = (const swa::bf16*)(QKV + tq * NQKV_A + g * 3072 + h * 128);
    R.K = (const swa::bf16*)(QKV + tok0 * NQKV_A + g * 3072 + 1024 + h * 128);
    R.V = (const swa::bf16*)(QKV + tok0 * NQKV_A + g * 3072 + 2048 + h * 128);
    R.O = OP + (size_t)g * M * AGW + tq * AGW + h * 128; R.L = LA + (size_t)g * M * 8 + tq * 8 + h;
    R.qs = d * NQKV_A; R.kvs = d * NQKV_A; R.os = d * AGW; R.ls = d * 8; R.P0 = 256 * qb; R.skv = SEQ >> dsh;
    return R;
}
__device__ __forceinline__ swa::BlockRef attnB_ref(int I, int pass, const bfu* Qb, const bfu* KVB, float* OP) {
    const int bh = I >> 5, slot = I & 31, c = slot >> 4, vh = (slot >> 3) & 1, x = slot & 7, qb = pass ? 15 - x : x, b = bh >> 3, h = bh & 7;
    const size_t tq = (size_t)b * SEQ + 256 * qb;
    swa::BlockRef R;
    R.Q = (const swa::bf16*)(Qb + tq * DM + h * 256 + c * 128);
    R.K = (const swa::bf16*)(KVB + (size_t)b * SEQ * NKV + h * 256 + c * 128);
    R.V = (const swa::bf16*)(KVB + (size_t)b * SEQ * NKV + DM + h * 256 + vh * 128);
    R.O = OP + (size_t)c * M * DM + tq * DM + h * 256 + vh * 128; R.L = nullptr;
    R.qs = DM; R.kvs = NKV; R.os = DM; R.ls = 0; R.P0 = 256 * qb; R.skv = SEQ;
    return R;
}

__global__ void __launch_bounds__(NWAVES * 64, 2) yoco_fwd(Args args_unused) {
    (void)args_unused;
    extern __shared__ __attribute__((aligned(16))) unsigned char lds_raw[];
    LAS unsigned char* lds = (LAS unsigned char*)lds_raw;
    volatile LAS unsigned* MISC = (volatile LAS unsigned*)(lds + MISC_OFF);
    const int wave_s = __builtin_amdgcn_readfirstlane((int)threadIdx.x >> 6);
    for (int u = threadIdx.x; u < (LDS_BYTES - LDSCTL_OFF) / 4; u += NWAVES * 64) ((LAS unsigned*)(lds + LDSCTL_OFF))[u] = 0u;
    __syncthreads();
    int lo, hi; XcdBarrier bar;
    { ArgsP a = get_args(); const Ctx c = fresh_ctx(wave_s); lo = a->ph_lo; hi = a->ph_hi; unsigned* bw = (unsigned*)(a->ws + WS_CTL) + CW_BAR;
      bar.bar = bw; bar.x = 0; bar.st = nullptr;
      if (hi - lo > 1) bar = xcd_barrier_post(bw, MISC + 8, threadIdx.x == 0); }
#define IN(k) (lo <= (k) && (k) < hi)
#define SEAM(k) do { if (IN(k) && IN((k) + 1)) { XcdBarrier bb_ = bar; { GAS unsigned* gb_ = (GAS unsigned*)bar.bar; asm volatile("" : "+s"(gb_), "+s"(bb_.x)); bb_.bar = (unsigned*)gb_; } const Ctx cb_ = fresh_ctx(wave_s); xcd_barrier(bb_, cb_.tid == 0); } } while (0)
#define WSP(T, off) ((T*)(a->ws + (off)))

    if (IN(0)) { const Ctx c = fresh_ctx(wave_s); p0_prologue(get_args(), lds, c.tid, c.lane, c.wave, c.vcu, c.G); }
    SEAM(0);
    if (IN(1)) { const Ctx c = fresh_ctx(wave_s); p0b_modreduce(get_args(), c.tid, c.vcu, c.G); }
    SEAM(1);

    for (int s = 0; s < N_STAGE; ++s) {
        const int kind = (s < 2) ? 0 : (s == 2 ? 1 : 2);
        const int layer = (s < 2) ? s : s - 1;
        const int jb = s - 3;
        const int pb = (s == 0) ? 2 : (s == 1) ? 11 : (s == 2) ? 20 : (s == 3) ? 23 : 32;

        if (IN(pb + 0)) {
            ArgsP a = get_args(); const Ctx c = fresh_ctx(wave_s); const float* MOD = WSP(const float, WS_MOD); bfu* Hb = WSP(bfu, WS_H);
            if (kind == 1) norm_phase(a->out, a->kv_norm_g, MOD + MOD_KV_OFF, MOD + MOD_KV_OFF + DM, NKV, Hb, c.lane, c.gw, c.NGW);
            else { const float* modl = MOD + (size_t)layer * BATCH * NMOD; norm_phase((s == 0) ? a->x : (const float*)a->out, a->norm_g + (size_t)(layer * 2) * DM, modl, modl + DM, NMOD, Hb, c.lane, c.gw, c.NGW); }
        }
        SEAM(pb + 0);
        if (IN(pb + 1)) {
            ArgsP a = get_args(); const Ctx c = fresh_ctx(wave_s);
            const bfu* Wt; int N; bfu* O;
            if (kind == 0) { Wt = WSP(const bfu, WS_WQKVA) + (size_t)layer * NQKV_A * DM; N = NQKV_A; O = WSP(bfu, WS_QKV); }
            else if (kind == 1) { Wt = WSP(const bfu, WS_WKV); N = NKV; O = WSP(bfu, WS_KVB); }
            else { Wt = WSP(const bfu, WS_WQB) + (size_t)jb * DM * DM; N = DM; O = WSP(bfu, WS_QKV); }
            pg8::Gemm g{WSP(const bfu, WS_H), Wt, M, N, DM}; pg8::StaticOrder S; S.init(M, N, c.G, c.bx);
            pg8::EpiBf16<0> E{O, N};
            pg8::gemm_phase<pg8::EpiBf16<0>, pg8::StaticOrder, true, true>(lds + RING_OFF, g, S, E, c.tid);
        }
        SEAM(pb + 1);
        if (IN(pb + 2)) {
            ArgsP a = get_args(); const Ctx c = fresh_ctx(wave_s); const float* cosT = WSP(const float, WS_COS); const float* sinT = WSP(const float, WS_SIN);
            if (kind == 0) qknorm_phase<0>(WSP(bfu, WS_QKV), a->a_q_gain + (size_t)layer * 3 * HD, a->a_k_gain + (size_t)layer * 3 * HD, cosT, sinT, c.lane, c.gw, c.NGW);
            else if (kind == 1) qknorm_phase<1>(WSP(bfu, WS_KVB), a->kv_k_gain, nullptr, cosT, sinT, c.lane, c.gw, c.NGW);
            else qknorm_phase<2>(WSP(bfu, WS_QKV), a->b_q_gain + (size_t)jb * 2 * HD, nullptr, cosT, sinT, c.lane, c.gw, c.NGW);
        }
        SEAM(pb + 2);
        if (kind == 1) continue;
        if (IN(pb + 3)) {
            ArgsP a = get_args(); const Ctx c = fresh_ctx(wave_s);
            const bfu* QKV = WSP(const bfu, WS_QKV); float* OP = WSP(float, WS_OP);
            if (kind == 0) {
                float* LA = WSP(float, WS_LA);
                const int total = 1536; const int G = c.G; int L = c.bx;
                if (L < total) {
                    swa::BlockRef cur = attnA_ref(L, QKV, OP, LA); swa::Seam SS;
                    swa::causal_swa_prime(cur, 129, (char*)lds_raw, SS, c.tid);
                    for (;;) {
                        const bool more = L + G < total;
                        const swa::BlockRef nxt = more ? attnA_ref(L + G, QKV, OP, LA) : cur;
                        swa::causal_swa_block<true>(cur, nxt, 129, (char*)lds_raw, SS, c.tid);
                        if (!more) break;
                        cur = nxt; L += G;
                    }
                }
            } else {
                const bfu* KVB = WSP(const bfu, WS_KVB); const int G = c.G, vcu = c.vcu;
                const int nit = (G == 256) ? 4 : (vcu < 1024 ? (1024 - vcu + G - 1) / G : 0);
                int n = 0; const int nblk = 2 * nit;
#define ITEM_OF(i) ((G == 256) ? ((vcu >> 5) * 128 + (i) * 32 + (vcu & 31)) : (vcu + (i) * G))
                if (nblk > 0) {
                    swa::BlockRef cur = attnB_ref(ITEM_OF(0), 0, QKV, KVB, OP); swa::Seam SS;
                    swa::causal_swa_prime(cur, SEQ, (char*)lds_raw, SS, c.tid);
                    for (;;) {
                        const bool more = n + 1 < nblk;
                        const swa::BlockRef nxt = more ? attnB_ref(ITEM_OF((n + 1) >> 1), (n + 1) & 1, QKV, KVB, OP) : cur;
                        swa::causal_swa_block<false>(cur, nxt, SEQ, (char*)lds_raw, SS, c.tid);
                        if (!more) break;
                        cur = nxt; ++n;
                    }
                }
#undef ITEM_OF
            }
        }
        SEAM(pb + 3);
        if (IN(pb + 4)) {
            ArgsP a = get_args(); const Ctx c = fresh_ctx(wave_s);
            if (kind == 0) combineA_phase(WSP(const float, WS_OP), WSP(const float, WS_LA), WSP(bfu, WS_AO), c.lane, c.gw, c.NGW);
            else combineB_phase(WSP(const float, WS_OP), a->b_lambda + (size_t)jb * 4 * HD, a->b_subln_g + (size_t)jb * 256, jb == 0 ? a->lam_init[0] : a->lam_init[1], WSP(bfu, WS_AO), c.lane, c.gw, c.NGW);
        }
        SEAM(pb + 4);
        if (IN(pb + 5)) {
            ArgsP a = get_args(); const Ctx c = fresh_ctx(wave_s);
            const bfu* Wt; int K;
            if (kind == 0) { Wt = WSP(const bfu, WS_WOA) + (size_t)layer * DM * AGW; K = AGW; }
            else { Wt = WSP(const bfu, WS_WOB) + (size_t)jb * DM * DM; K = DM; }
            pg8::Gemm g{WSP(const bfu, WS_AO), Wt, M, DM, K}; pg8::StaticOrder S; S.init(M, DM, c.G, c.bx);
            pg8::EpiRes E{(s == 0) ? a->x : (const float*)a->out, a->out, DM, WSP(const float, WS_MOD) + (size_t)layer * BATCH * NMOD + 2 * DM, NMOD, SEQ};
            pg8::gemm_phase<pg8::EpiRes, pg8::StaticOrder, true, true>(lds + RING_OFF, g, S, E, c.tid);
        }
        SEAM(pb + 5);
        if (IN(pb + 6)) {
            ArgsP a = get_args(); const Ctx c = fresh_ctx(wave_s); const float* modl = WSP(const float, WS_MOD) + (size_t)layer * BATCH * NMOD;
            norm_phase(a->out, a->norm_g + (size_t)(layer * 2 + 1) * DM, modl + 3 * DM, modl + 4 * DM, NMOD, WSP(bfu, WS_H), c.lane, c.gw, c.NGW);
        }
        SEAM(pb + 6);
        if (IN(pb + 7)) {
            ArgsP a = get_args(); const Ctx c = fresh_ctx(wave_s);
            pg8::Gemm g{WSP(const bfu, WS_H), WSP(const bfu, WS_W1) + (size_t)layer * DFF * DM, M, DFF, DM}; pg8::StaticOrder S; S.init(M, DFF, c.G, c.bx);
            pg8::EpiBf16<1> E{WSP(bfu, WS_QKV), DFF};
            pg8::gemm_phase<pg8::EpiBf16<1>, pg8::StaticOrder, true, true>(lds + RING_OFF, g, S, E, c.tid);
        }
        SEAM(pb + 7);
        if (IN(pb + 8)) {
            ArgsP a = get_args(); const Ctx c = fresh_ctx(wave_s);
            pg8::Gemm g{WSP(const bfu, WS_QKV), WSP(const bfu, WS_W2) + (size_t)layer * DM * DFF, M, DM, DFF}; pg8::StaticOrder S; S.init(M, DM, c.G, c.bx);
            pg8::EpiRes E{a->out, a->out, DM, WSP(const float, WS_MOD) + (size_t)layer * BATCH * NMOD + 5 * DM, NMOD, SEQ};
            pg8::gemm_phase<pg8::EpiRes, pg8::StaticOrder, true, true>(lds + RING_OFF, g, S, E, c.tid);
        }
        SEAM(pb + 8);
    }
#undef IN
#undef SEAM
#undef WSP
}

extern "C" void kernel_launch(void* const* d_in, const int* in_sizes, int n_in, void* d_out, int out_size, void* d_ws, size_t ws_size, hipStream_t stream) {
    static int grid = 0;
    if (grid == 0) {
        if (n_in != 23 || in_sizes[0] != M * DM || out_size != M * DM || ws_size < WS_END) { fprintf(stderr, "kernel_launch: unexpected shapes (n_in %d, in0 %d, out %d, ws %zu); nothing launched\n", n_in, n_in > 0 ? in_sizes[0] : -1, out_size, ws_size); grid = -1; return; }
        int dev = 0, cus = 0, per_cu = 0;
        if (hipGetDevice(&dev) != hipSuccess || hipDeviceGetAttribute(&cus, hipDeviceAttributeMultiprocessorCount, dev) != hipSuccess) { fprintf(stderr, "kernel_launch: hipGetDevice / hipDeviceGetAttribute failed\n"); grid = -1; return; }
        if (hipFuncSetAttribute((const void*)yoco_fwd, hipFuncAttributeMaxDynamicSharedMemorySize, LDS_BYTES) != hipSuccess) { fprintf(stderr, "kernel_launch: hipFuncSetAttribute failed\n"); grid = -1; return; }
        if (hipOccupancyMaxActiveBlocksPerMultiprocessor(&per_cu, (const void*)yoco_fwd, NWAVES * 64, LDS_BYTES) != hipSuccess || per_cu < 1)
            fprintf(stderr, "kernel_launch: note: occupancy query reports %d workgroups per CU\n", per_cu);
        (void)hipGetLastError();
        grid = cus;
    }
    if (grid < 0) return;
    if (hipMemsetAsync((char*)d_ws + WS_CTL, 0, CTL_ZERO_BYTES, stream) != hipSuccess) { fprintf(stderr, "kernel_launch: hipMemsetAsync failed\n"); return; }
    Args ha{};
    ha.x = (const float*)d_in[0]; ha.c = (const float*)d_in[1]; ha.pos = (const int*)d_in[2]; ha.ada_w = (const float*)d_in[3]; ha.ada_b = (const float*)d_in[4]; ha.norm_g = (const float*)d_in[5];
    ha.a_w_qkv = (const float*)d_in[6]; ha.a_q_gain = (const float*)d_in[7]; ha.a_k_gain = (const float*)d_in[8]; ha.a_w_o = (const float*)d_in[9];
    ha.kv_ada_w = (const float*)d_in[10]; ha.kv_ada_b = (const float*)d_in[11]; ha.kv_norm_g = (const float*)d_in[12]; ha.kv_w_k = (const float*)d_in[13]; ha.kv_w_v = (const float*)d_in[14]; ha.kv_k_gain = (const float*)d_in[15];
    ha.b_w_q = (const float*)d_in[16]; ha.b_q_gain = (const float*)d_in[17]; ha.b_lambda = (const float*)d_in[18]; ha.b_subln_g = (const float*)d_in[19]; ha.b_w_o = (const float*)d_in[20];
    ha.mlp_w1 = (const float*)d_in[21]; ha.mlp_w2 = (const float*)d_in[22];
    ha.out = (float*)d_out; ha.ws = (unsigned char*)d_ws;
    for (int j = 0; j < 16; ++j) ha.inv_freq[j] = (float)pow(500000.0, -(double)(2 * j) / 32.0);
    ha.lam_init[0] = (float)(0.8 - 0.6 * exp(-0.3 * 2.0)); ha.lam_init[1] = (float)(0.8 - 0.6 * exp(-0.3 * 3.0));
#if MK_ONE_LAUNCH
    ha.ph_lo = 0; ha.ph_hi = N_PHASE;
    hipLaunchKernelGGL(yoco_fwd, dim3(grid), dim3(NWAVES * 64), LDS_BYTES, stream, ha);
    { const hipError_t le = hipPeekAtLastError(); if (le != hipSuccess) fprintf(stderr, "kernel_launch: launch failed: %s\n", hipGetErrorName(le)); }
#else
    for (int p = 0; p < N_PHASE; ++p) {
        ha.ph_lo = p; ha.ph_hi = p + 1;
        hipLaunchKernelGGL(yoco_fwd, dim3(grid), dim3(NWAVES * 64), LDS_BYTES, stream, ha);
        const hipError_t le = hipPeekAtLastError(); if (le != hipSuccess) { fprintf(stderr, "kernel_launch: launch %d failed: %s\n", p, hipGetErrorName(le)); break; }
    }
#endif
}
```

```cpp
#include <hip/hip_runtime.h>
#include <hip/hip_bf16.h>
#include <cstdio>
#include <cstdint>
#include <cmath>
namespace pg8 {
#define PG8_LAS __attribute__((address_space(3)))
typedef unsigned short bf16_t;
typedef short bf16x8 __attribute__((ext_vector_type(8)));
typedef float f32x4 __attribute__((ext_vector_type(4)));
typedef unsigned u32x4 __attribute__((ext_vector_type(4)));
constexpr int BM = 256, BK = 64, HALF = 128, HTB = HALF * BK * 2  , STAGE_BYTES = 8 * HTB, NXCD = 8, WGM = 8;

__host__ __device__ __forceinline__ int lds_byte(int r, int c) { const int st = (r >> 4) * 2 + (c >> 5), rr = r & 15, cc = c & 31, ob = rr * 64 + cc * 2; return st * 1024 + (ob ^ (((ob >> 9) & 1) << 5)); }
__host__ __device__ __forceinline__ void stage_rc(int b, int& R, int& C) { const int st = b / 1024, sb = b % 1024, swz = sb ^ (((sb >> 9) & 1) << 5); R = (st >> 1) * 16 + swz / 64; C = (st & 1) * 32 + (swz % 64) / 2; }
__host__ __device__ __forceinline__ int perm32(int rho) { const int n = rho >> 4, i = rho & 15; return 8 * (i >> 2) + 4 * n + (i & 3); }

struct Unit { int pm, pn; };
struct Gemm { const bf16_t* A; const bf16_t* Bt; int M, N, K; };

struct StaticOrder {
    int nM, nN, nwg, G, c;
    __host__ __device__ void init(int M, int N, int G_, int c_) { nM = M / BM; nN = N / BM; nwg = nM * nN; G = G_; c = c_; }
    __host__ __device__ bool next(int i, Unit& u) const {
        const long L = (long)i * G + c; if (L >= nwg) return false;
        int wgid = (int)L; { const int q = nwg / NXCD, r = nwg % NXCD, xcd = wgid % NXCD, off = wgid / NXCD; wgid = (xcd < r ? xcd * (q + 1) : r * (q + 1) + (xcd - r) * q) + off; }
        const int nig = WGM * nN, gid = wgid / nig, fm = gid * WGM, gsz = (nM - fm) < WGM ? (nM - fm) : WGM;
        u.pm = fm + ((wgid % nig) % gsz); u.pn = (wgid % nig) / gsz; return true;
    }
    __device__ __forceinline__ void a_ready(const Unit&) const {}
    __device__ __forceinline__ void done(const Unit&) const {}
};


__device__ __forceinline__ unsigned cvt_pk_bf16(float lo, float hi) { unsigned r; asm volatile("v_cvt_pk_bf16_f32 %0, %1, %2" : "=v"(r) : "v"(lo), "v"(hi)); return r; }

template <int ACT  > struct EpiBf16 {
    static constexpr bool PERM = true, AFTER_DRAIN = false;
    bf16_t* O; int ldc;
    __device__ __forceinline__ void operator()(const f32x4 (&acc)[2][2][4][2], const Unit& u, int wr, int wc, int fr, int fq) const {
        const int row0 = u.pm * BM + wr * 64 + fr; const int col0 = u.pn * BM + wc * 32 + 8 * fq;
#pragma unroll
        for (int ai = 0; ai < 2; ++ai)
#pragma unroll
            for (int m = 0; m < 4; ++m) { bf16_t* rowp = O + (size_t)(row0 + ai * HALF + m * 16) * ldc + col0;
#pragma unroll
                for (int bj = 0; bj < 2; ++bj) { f32x4 v0 = acc[ai][bj][m][0], v1 = acc[ai][bj][m][1];
                    if (ACT == 1) {
#pragma unroll
                        for (int e = 0; e < 4; ++e) { const float a = fmaxf(v0[e], 0.f), b = fmaxf(v1[e], 0.f); v0[e] = a * a; v1[e] = b * b; } }
                    u32x4 w; w.x = cvt_pk_bf16(v0[0], v0[1]); w.y = cvt_pk_bf16(v0[2], v0[3]); w.z = cvt_pk_bf16(v1[0], v1[1]); w.w = cvt_pk_bf16(v1[2], v1[3]);
                    *(u32x4*)(rowp + bj * HALF) = w; } }
    }
};

struct EpiRes {
    static constexpr bool PERM = false, AFTER_DRAIN = false;
    const float* base; float* out; int ldc; const float* gate; int gate_bstride; int rows_per_batch;
    __device__ __forceinline__ void operator()(const f32x4 (&acc)[2][2][4][2], const Unit& u, int wr, int wc, int fr, int fq) const {
        const int row0 = u.pm * BM + wr * 64 + fr, col0 = u.pn * BM + wc * 32 + 4 * fq;
        const float* gp = gate + (size_t)((u.pm * BM) / rows_per_batch) * gate_bstride + col0;
        f32x4 gv[2][2];
#pragma unroll
        for (int bj = 0; bj < 2; ++bj)
#pragma unroll
            for (int n = 0; n < 2; ++n) gv[bj][n] = *(const f32x4*)(gp + bj * HALF + n * 16);
#pragma unroll
        for (int ai = 0; ai < 2; ++ai)
#pragma unroll
            for (int m = 0; m < 4; ++m) { const size_t off = (size_t)(row0 + ai * HALF + m * 16) * ldc + col0;
#pragma unroll
                for (int bj = 0; bj < 2; ++bj)
#pragma unroll
                    for (int n = 0; n < 2; ++n) { const f32x4 bs = *(const f32x4*)(base + off + bj * HALF + n * 16);
                        *(f32x4*)(out + off + bj * HALF + n * 16) = bs + gv[bj][n] * acc[ai][bj][m][n]; }
                if (m & 1) asm volatile("" ::: "memory"); }
    }
};

__device__ __forceinline__ float epi_shx(float v, int o, int lane) { return __int_as_float(__builtin_amdgcn_ds_bpermute((lane ^ o) << 2, __float_as_int(v))); }
struct EpiQK {
    static constexpr bool PERM = true, AFTER_DRAIN = false;
    bf16_t* O; int ldc; int kind; const float* gq; const float* gk; const float* cosT; const float* sinT; PG8_LAS float* xch; float eps;
    __device__ __forceinline__ void operator()(const f32x4 (&acc)[2][2][4][2], const Unit& u, int wr, int wc, int fr, int fq) const {
        const int row0 = u.pm * BM + wr * 64 + fr; const int col0 = u.pn * BM + wc * 32 + 8 * fq;
        bool norm; const float* g0; const float* g1;
        if (kind == 0) { const int cb = u.pn * BM, g = cb / 3072, typ = (cb - g * 3072) >> 10; norm = typ < 2; g0 = (typ ? gk : gq) + g * 128; g1 = g0; }
        else if (kind == 1) { norm = u.pn < 8; g0 = gq; g1 = gq + 128; }
        else { norm = true; g0 = gq; g1 = gq + 128; }
        if (!norm) {
#pragma unroll
            for (int ai = 0; ai < 2; ++ai)
#pragma unroll
                for (int m = 0; m < 4; ++m) { bf16_t* rowp = O + (size_t)(row0 + ai * HALF + m * 16) * ldc + col0;
#pragma unroll
                    for (int bj = 0; bj < 2; ++bj) { const f32x4 v0 = acc[ai][bj][m][0], v1 = acc[ai][bj][m][1];
                        u32x4 w; w.x = cvt_pk_bf16(v0[0], v0[1]); w.y = cvt_pk_bf16(v0[2], v0[3]); w.z = cvt_pk_bf16(v1[0], v1[1]); w.w = cvt_pk_bf16(v1[2], v1[3]);
                        *(u32x4*)(rowp + bj * HALF) = w; } }
            return;
        }
        const int lane = fq * 16 + fr;
        const f32x4 ga0 = *(const f32x4*)(g0 + wc * 32 + 8 * fq), ga1 = *(const f32x4*)(g0 + wc * 32 + 8 * fq + 4), gb0 = *(const f32x4*)(g1 + wc * 32 + 8 * fq), gb1 = *(const f32x4*)(g1 + wc * 32 + 8 * fq + 4);
#pragma unroll
        for (int ai = 0; ai < 2; ++ai)
#pragma unroll
            for (int m = 0; m < 4; ++m)
#pragma unroll
                for (int bj = 0; bj < 2; ++bj) { const f32x4 a = acc[ai][bj][m][0], b = acc[ai][bj][m][1];
                    float s = ((a[0] * a[0] + a[1] * a[1]) + (a[2] * a[2] + a[3] * a[3])) + ((b[0] * b[0] + b[1] * b[1]) + (b[2] * b[2] + b[3] * b[3]));
                    s += epi_shx(s, 16, lane); s += epi_shx(s, 32, lane);
                    if (fq == 0) xch[((ai * HALF + wr * 64 + m * 16 + fr) * 2 + bj) * 4 + wc] = s; }
        asm volatile("s_waitcnt lgkmcnt(0)" ::: "memory"); __builtin_amdgcn_s_barrier(); asm volatile("" ::: "memory");
#pragma unroll
        for (int ai = 0; ai < 2; ++ai)
#pragma unroll
            for (int m = 0; m < 4; ++m) { const int rl = ai * HALF + wr * 64 + m * 16 + fr; const size_t grow = (size_t)(u.pm * BM + rl);
                bf16_t* rowp = O + grow * ldc + col0;
                f32x4 c0 = {1.f, 1.f, 1.f, 1.f}, c1 = c0, s0 = {0.f, 0.f, 0.f, 0.f}, s1 = s0;
                if (wc == 0) { const float* cp = cosT + grow * 16 + (fq & 1) * 8; const float* sp = sinT + grow * 16 + (fq & 1) * 8;
                    c0 = *(const f32x4*)cp; c1 = *(const f32x4*)(cp + 4); s0 = *(const f32x4*)sp; s1 = *(const f32x4*)(sp + 4);
                    if (fq < 2) { s0 = -s0; s1 = -s1; } }
#pragma unroll
                for (int bj = 0; bj < 2; ++bj) { const f32x4 p4 = *(const PG8_LAS f32x4*)(xch + (rl * 2 + bj) * 4);
                    const float rstd = 1.0f / sqrtf(((p4[0] + p4[1]) + (p4[2] + p4[3])) * (1.0f / 128.0f) + eps);
                    f32x4 v0 = acc[ai][bj][m][0] * rstd * (bj ? gb0 : ga0), v1 = acc[ai][bj][m][1] * rstd * (bj ? gb1 : ga1);
                    if (wc == 0) { f32x4 q0, q1;
#pragma unroll
                        for (int e = 0; e < 4; ++e) { q0[e] = epi_shx(v0[e], 32, lane); q1[e] = epi_shx(v1[e], 32, lane); }
                        v0 = v0 * c0 + q0 * s0; v1 = v1 * c1 + q1 * s1; }
                    u32x4 w; w.x = cvt_pk_bf16(v0[0], v0[1]); w.y = cvt_pk_bf16(v0[2], v0[3]); w.z = cvt_pk_bf16(v1[0], v1[1]); w.w = cvt_pk_bf16(v1[2], v1[3]);
                    *(u32x4*)(rowp + bj * HALF) = w; }
                if (m & 1) asm volatile("" ::: "memory"); }
    }
};

template <class Epi, class Sched, bool ALIGN_EPI = false, bool SP2 = false>
__device__ __forceinline__ void gemm_phase(PG8_LAS unsigned char* lds, const Gemm g, const Sched& S, const Epi& E, const int tid  ) {
    const int wid = __builtin_amdgcn_readfirstlane(tid >> 6), lane = tid & 63, wr = wid >> 2, wc = wid & 3, fr = lane & 15, fq = lane >> 4;
    const int K = g.K, nt = K / BK;
    unsigned voffA[2], voffB[2];
#pragma unroll
    for (int i = 0; i < 2; ++i) { int R, C; stage_rc(tid * 16 + i * 8192, R, C); const int Rb = Epi::PERM ? ((R & ~31) + perm32(R & 31)) : R;
        voffA[i] = (unsigned)(R * K + C) * 2u; voffB[i] = (unsigned)(Rb * K + C) * 2u; }
    const size_t kstep = (size_t)(BK * 2);
    const size_t hstep = (size_t)HALF * K * 2;
    const size_t tstep = 2 * hstep;
    const unsigned ldsw = (unsigned)wid * 1024u;
    const int aoff = lds_byte(wr * 64 + fr, fq * 8), boff = lds_byte(wc * 32 + fr, fq * 8);
#define PG8_SA(b, h) (((b) * 2 + (h)) * HTB)
#define PG8_SB(b, h) ((4 + (b) * 2 + (h)) * HTB)
#define PG8_STAGE(bufoff, gbase, voff) do { _Pragma("unroll") for (int _i = 0; _i < 2; ++_i) \
        __builtin_amdgcn_global_load_lds((const unsigned*)((const char*)(gbase) + (voff)[_i]), (PG8_LAS unsigned*)(lds + (bufoff) + ldsw + _i * 8192), 16, 0, 0); } while (0)
#define PG8_LDA(dst, b, h) do { _Pragma("unroll") for (int m = 0; m < 4; ++m) _Pragma("unroll") for (int k = 0; k < 2; ++k) dst[m][k] = *(const PG8_LAS bf16x8*)(lds + PG8_SA(b, h) + aoff + m * 2048 + k * 1024); } while (0)
#define PG8_LDB(dst, b, h) do { _Pragma("unroll") for (int n = 0; n < 2; ++n) _Pragma("unroll") for (int k = 0; k < 2; ++k) dst[n][k] = *(const PG8_LAS bf16x8*)(lds + PG8_SB(b, h) + boff + n * 2048 + k * 1024); } while (0)
#define PG8_MMA(ai, bj, At, Bt) do { __builtin_amdgcn_s_setprio(1); _Pragma("unroll") for (int m = 0; m < 4; ++m) _Pragma("unroll") for (int n = 0; n < 2; ++n) _Pragma("unroll") for (int k = 0; k < 2; ++k) \
        acc[ai][bj][m][n] = __builtin_amdgcn_mfma_f32_16x16x32_bf16(Bt[n][k], At[m][k], acc[ai][bj][m][n], 0, 0, 0); __builtin_amdgcn_s_setprio(0); } while (0)
#define PG8_WAIT_V(n) asm volatile("s_waitcnt vmcnt(" #n ")" ::: "memory")
#define PG8_WAIT_L(n) asm volatile("s_waitcnt lgkmcnt(" #n ")" ::: "memory")
#define PG8_BAR __builtin_amdgcn_s_barrier()
#define PG8_SCHED __builtin_amdgcn_sched_barrier(0)
    Unit cur, nxt; int ui = 0;
    if (!S.next(0, cur)) return;
    f32x4 acc[2][2][4][2];
#pragma unroll
    for (int a = 0; a < 2; ++a)
#pragma unroll
        for (int b = 0; b < 2; ++b)
#pragma unroll
            for (int m = 0; m < 4; ++m)
#pragma unroll
                for (int n = 0; n < 2; ++n) acc[a][b][m][n] = (f32x4){0.f, 0.f, 0.f, 0.f};
    bf16x8 At[4][2], B0[2][2], B1[2][2];
    const char* cA = (const char*)g.A + (size_t)cur.pm * tstep; const char* cB = (const char*)g.Bt + (size_t)cur.pn * tstep;
    S.a_ready(cur);
    if constexpr (SP2) {
        PG8_STAGE(PG8_SB(0, 0), cB, voffB); PG8_STAGE(PG8_SB(0, 1), cB + hstep, voffB); PG8_STAGE(PG8_SA(0, 0), cA, voffA); PG8_STAGE(PG8_SA(0, 1), cA + hstep, voffA);
        if (wr == 1) PG8_BAR;
        PG8_WAIT_V(2); PG8_BAR;
        PG8_STAGE(PG8_SB(1, 0), cB + kstep, voffB); PG8_STAGE(PG8_SA(1, 0), cA + kstep, voffA); PG8_STAGE(PG8_SB(1, 1), cB + hstep + kstep, voffB);
        PG8_WAIT_V(6); PG8_BAR;
    } else {
        PG8_STAGE(PG8_SB(0, 0), cB, voffB); PG8_STAGE(PG8_SA(0, 0), cA, voffA); PG8_STAGE(PG8_SB(0, 1), cB + hstep, voffB); PG8_STAGE(PG8_SA(0, 1), cA + hstep, voffA);
        if (wr == 1) PG8_BAR;
        PG8_WAIT_V(4); PG8_BAR;
        PG8_STAGE(PG8_SB(1, 0), cB + kstep, voffB); PG8_STAGE(PG8_SA(1, 0), cA + kstep, voffA); PG8_STAGE(PG8_SB(1, 1), cB + hstep + kstep, voffB);
        PG8_WAIT_V(6); PG8_BAR;
    }
    for (;;) {
        const bool has_next = S.next(ui + 1, nxt);
        const char* nA = has_next ? (const char*)g.A + (size_t)nxt.pm * tstep : cA; const char* nB = has_next ? (const char*)g.Bt + (size_t)nxt.pn * tstep : cB;
        for (int t = 0; t < nt; t += 2) {
            const bool last = (t == nt - 2);
            const char* a1 = cA + (size_t)(t + 1) * kstep;
            const char* a2 = last ? nA : cA + (size_t)(t + 2) * kstep; const char* b2 = last ? nB : cB + (size_t)(t + 2) * kstep;
            const char* a3 = a2 + kstep; const char* b3 = b2 + kstep;
            if (last && has_next) S.a_ready(nxt);
            if constexpr (SP2) {
            PG8_LDB(B0, 0, 0); PG8_LDB(B1, 0, 1); PG8_SCHED; PG8_LDA(At, 0, 0); PG8_STAGE(PG8_SA(1, 1), a1 + hstep, voffA);
            PG8_WAIT_V(8); PG8_WAIT_L(0); PG8_BAR; PG8_MMA(0, 0, At, B0); PG8_MMA(0, 1, At, B1); PG8_BAR; PG8_SCHED;
            PG8_LDA(At, 0, 1); PG8_STAGE(PG8_SB(0, 0), b2, voffB); PG8_STAGE(PG8_SB(0, 1), b2 + hstep, voffB); PG8_STAGE(PG8_SA(0, 0), a2, voffA);
            PG8_WAIT_V(8); PG8_WAIT_L(0); PG8_BAR; PG8_MMA(1, 0, At, B0); PG8_MMA(1, 1, At, B1); PG8_BAR; PG8_SCHED;
            PG8_LDB(B0, 1, 0); PG8_LDB(B1, 1, 1); PG8_SCHED; PG8_LDA(At, 1, 0); PG8_STAGE(PG8_SA(0, 1), a2 + hstep, voffA);
            PG8_WAIT_V(8); PG8_WAIT_L(0); PG8_BAR; PG8_MMA(0, 0, At, B0); PG8_MMA(0, 1, At, B1); PG8_BAR; PG8_SCHED;
            PG8_LDA(At, 1, 1); PG8_STAGE(PG8_SB(1, 0), b3, voffB); PG8_STAGE(PG8_SB(1, 1), b3 + hstep, voffB); PG8_STAGE(PG8_SA(1, 0), a3, voffA);
            PG8_WAIT_V(8); PG8_WAIT_L(0); PG8_BAR; PG8_MMA(1, 0, At, B0); PG8_MMA(1, 1, At, B1); PG8_BAR; PG8_SCHED;
            } else {
            PG8_LDB(B0, 0, 0); PG8_SCHED; PG8_LDA(At, 0, 0); PG8_STAGE(PG8_SA(1, 1), a1 + hstep, voffA);
            PG8_WAIT_L(8); PG8_BAR; PG8_WAIT_L(0); PG8_MMA(0, 0, At, B0); PG8_BAR; PG8_SCHED;
            PG8_LDB(B1, 0, 1); PG8_STAGE(PG8_SB(0, 0), b2, voffB);
            PG8_BAR; PG8_WAIT_L(0); PG8_MMA(0, 1, At, B1); PG8_BAR;
            PG8_LDA(At, 0, 1); PG8_STAGE(PG8_SA(0, 0), a2, voffA);
            PG8_BAR; PG8_WAIT_L(0); PG8_MMA(1, 0, At, B0); PG8_BAR; PG8_SCHED;
            PG8_STAGE(PG8_SB(0, 1), b2 + hstep, voffB);
            PG8_WAIT_V(6); PG8_BAR; PG8_MMA(1, 1, At, B1); PG8_BAR;
            PG8_LDB(B0, 1, 0); PG8_SCHED; PG8_LDA(At, 1, 0); PG8_STAGE(PG8_SA(0, 1), a2 + hstep, voffA);
            PG8_WAIT_L(8); PG8_BAR; PG8_WAIT_L(0); PG8_MMA(0, 0, At, B0); PG8_BAR; PG8_SCHED;
            PG8_LDB(B1, 1, 1); PG8_STAGE(PG8_SB(1, 0), b3, voffB);
            PG8_BAR; PG8_WAIT_L(0); PG8_MMA(0, 1, At, B1); PG8_BAR;
            PG8_LDA(At, 1, 1); PG8_STAGE(PG8_SA(1, 0), a3, voffA);
            PG8_BAR; PG8_WAIT_L(0); PG8_MMA(1, 0, At, B0); PG8_BAR; PG8_SCHED;
            PG8_STAGE(PG8_SB(1, 1), b3 + hstep, voffB);
            PG8_WAIT_V(6); PG8_BAR; PG8_MMA(1, 1, At, B1); PG8_BAR;
            }
        }
        if constexpr (ALIGN_EPI) { if (wr == 0) PG8_BAR; }
        if constexpr (!Epi::AFTER_DRAIN) { E(acc, cur, wr, wc, fr, fq); S.done(cur); }
        if (!has_next) break;
#pragma unroll
        for (int a = 0; a < 2; ++a)
#pragma unroll
            for (int b = 0; b < 2; ++b)
#pragma unroll
                for (int m = 0; m < 4; ++m)
#pragma unroll
                    for (int n = 0; n < 2; ++n) acc[a][b][m][n] = (f32x4){0.f, 0.f, 0.f, 0.f};
        cur = nxt; cA = nA; cB = nB; ++ui;
        if constexpr (ALIGN_EPI) { if (wr == 1) PG8_BAR; }
    }
    PG8_WAIT_V(0);
    if constexpr (!ALIGN_EPI) { if (wr == 0) PG8_BAR; }
    PG8_BAR;
    if constexpr (Epi::AFTER_DRAIN) { E.fused(acc, cur, wr, wc, fr, fq, lds, wid, lane); S.done(cur); }
#undef PG8_SA
#undef PG8_SB
#undef PG8_STAGE
#undef PG8_LDA
#undef PG8_LDB
#undef PG8_MMA
#undef PG8_WAIT_V
#undef PG8_WAIT_L
#undef PG8_BAR
#undef PG8_SCHED
}
}
namespace swa {
using bf16 = __hip_bfloat16;
constexpr int D = 128;
constexpr float SCALE = 0.08838834764831845f;
constexpr float THR = 8.f;
constexpr int NW = 8, QBLK = 32, KVBLK = 64, QB = NW * QBLK;
constexpr int SHM_V = KVBLK * D * 2, SHM_K = KVBLK * D * 2;
constexpr int LDS_BYTES = 2 * SHM_V + 2 * SHM_K + NW * 64 * 4;

typedef short bf16x8 __attribute__((ext_vector_type(8)));
typedef short s16x4 __attribute__((ext_vector_type(4)));
typedef float f32x16 __attribute__((ext_vector_type(16)));
typedef float f32x4 __attribute__((ext_vector_type(4)));
typedef unsigned u32x4 __attribute__((ext_vector_type(4)));

#define KSWZ(row, colB) ((row) * 256 + ((colB) ^ (((row) & 7) << 4)))
#define SBAR() __builtin_amdgcn_sched_barrier(0)
__device__ __forceinline__ int v_st(int k, int c) { const int kk = (k & ~0xC) | ((k & 4) << 1) | ((k & 8) >> 1); return ((kk >> 3) * 4 + (c >> 5)) * 512 + ((kk & 7) * 32 + (c & 31)) * 2; }
__device__ __forceinline__ int v_rd_base(int lane) { return ((lane & 3) << 3) | (((lane >> 2) & 3) << 6) | (((lane >> 4) & 1) << 5) | (((lane >> 5) & 1) << 8); }
constexpr int v_rd_off(int d0, int ks, int half) { return d0 * 512 + ks * 4096 + half * 2048; }
__device__ __forceinline__ int crow(int r, int hi) { return (r & 3) + 8 * (r >> 2) + 4 * hi; }
__device__ __forceinline__ unsigned cvtpk(float lo, float hi) {
    unsigned r; asm volatile("v_cvt_pk_bf16_f32 %0, %1, %2" : "=v"(r) : "v"(lo), "v"(hi)); return r;
}
__device__ __forceinline__ bf16x8 load8(const bf16* p) { return *reinterpret_cast<const bf16x8*>(p); }
__device__ __forceinline__ void mask_tile(f32x16& p0, f32x16& p1, int dq, unsigned W) {
    const float NEG = -__builtin_inff();
#pragma unroll
    for (int r = 0; r < 16; ++r) {
        const int c = (r & 3) + 8 * (r >> 2);
        if ((unsigned)(dq - c) >= W) p0[r] = NEG;
        if ((unsigned)(dq - c - 32) >= W) p1[r] = NEG;
    }
}
__device__ __forceinline__ void partialSM(f32x16& p0, f32x16& p1, float& m_reg, float& mn, float& alpha) {
    float pmax = p0[0]; for (int r = 1; r < 16; ++r) pmax = fmaxf(pmax, p0[r]); for (int r = 0; r < 16; ++r) pmax = fmaxf(pmax, p1[r]);
    { auto rr = __builtin_amdgcn_permlane32_swap(__float_as_uint(pmax), __float_as_uint(pmax), false, false);
      pmax = fmaxf(__uint_as_float(rr[0]), __uint_as_float(rr[1])); }
    constexpr float C2 = 1.4426950408889634f * SCALE;
    if (__builtin_expect(__all((pmax - m_reg) * SCALE <= THR), 1)) { mn = m_reg; alpha = 1.f; }
    else { mn = fmaxf(m_reg, pmax); alpha = __builtin_amdgcn_exp2f((m_reg - mn) * C2); m_reg = mn; }
    const float mnL = -mn * C2;
    for (int r = 0; r < 16; ++r) p0[r] = fmaf(p0[r], C2, mnL); for (int r = 0; r < 16; ++r) p1[r] = fmaf(p1[r], C2, mnL);
    for (int r = 0; r < 16; ++r) p0[r] = __builtin_amdgcn_exp2f(p0[r]);
}
__device__ __forceinline__ void finishSM(f32x16& p0, f32x16& p1, float alpha, float& l_reg, bf16x8& pa0, bf16x8& pa1, bf16x8& pa2, bf16x8& pa3) {
    for (int r = 0; r < 16; ++r) p1[r] = __builtin_amdgcn_exp2f(p1[r]);
    float ps = 0; for (int r = 0; r < 16; ++r) ps += p0[r]; for (int r = 0; r < 16; ++r) ps += p1[r];
    { auto rr = __builtin_amdgcn_permlane32_swap(__float_as_uint(ps), __float_as_uint(ps), false, false);
      ps = __uint_as_float(rr[0]) + __uint_as_float(rr[1]); }
    l_reg = l_reg * alpha + ps;
#define PK4(P, B_, OUT) do { unsigned a0 = cvtpk(P[B_+0], P[B_+1]), a1 = cvtpk(P[B_+2], P[B_+3]);                          \
        unsigned b0 = cvtpk(P[B_+4], P[B_+5]), b1 = cvtpk(P[B_+6], P[B_+7]);                                             \
        auto r0 = __builtin_amdgcn_permlane32_swap(a0, b0, false, false); auto r1 = __builtin_amdgcn_permlane32_swap(a1, b1, false, false); \
        u32x4 w = {r0[0], r1[0], r0[1], r1[1]}; OUT = *reinterpret_cast<bf16x8*>(&w); } while (0)
    PK4(p0, 0, pa0); PK4(p0, 8, pa1); PK4(p1, 0, pa2); PK4(p1, 8, pa3);
#undef PK4
}
template <int KB, bool SK>
__device__ __forceinline__ void qkt(f32x16& p0, f32x16& p1, const char* K_lds, int r32, int hi, const bf16x8* qr, bool act) {
    if (SK && !act) { const float NEG = -__builtin_inff();
#pragma unroll
        for (int r = 0; r < 16; ++r) { p0[r] = NEG; p1[r] = NEG; } return; }
    p0 = f32x16{}; p1 = f32x16{};
    const char* kb[4];
#pragma unroll
    for (int dd = 0; dd < 4; ++dd) kb[dd] = K_lds + KB * SHM_K + KSWZ(r32, (dd * 16 + hi * 8) * 2);
#pragma unroll
    for (int d0 = 0; d0 < 8; ++d0) { const char* a = kb[d0 & 3] + (d0 >> 2) * 128;
        bf16x8 b0 = *reinterpret_cast<const bf16x8*>(a);
        bf16x8 b1 = *reinterpret_cast<const bf16x8*>(a + 32 * 256);
        p0 = __builtin_amdgcn_mfma_f32_32x32x16_bf16(b0, qr[d0], p0, 0, 0, 0);
        p1 = __builtin_amdgcn_mfma_f32_32x32x16_bf16(b1, qr[d0], p1, 0, 0, 0); }
}
template <int VB, bool SK>
__device__ __forceinline__ void pv_tile(f32x16* o, int vb0, bf16x8 pa0, bf16x8 pa1, bf16x8 pa2, bf16x8 pa3, bool act) {
    if (SK && !act) return;
#define TRRD(dst, off) asm volatile("ds_read_b64_tr_b16 %0, %1 offset:%2" : "=&v"(dst) : "v"(vb0), "i"(off) : "memory")
#define PV_D0(d0) do { s16x4 l0, l1, l2, l3, h0, h1, h2, h3; constexpr int b_ = VB * SHM_V + v_rd_off(d0, 0, 0);     \
        TRRD(l0, b_); TRRD(h0, b_ + 2048); TRRD(l1, b_ + 4096); TRRD(h1, b_ + 6144); TRRD(l2, b_ + 8192); TRRD(h2, b_ + 10240); TRRD(l3, b_ + 12288); TRRD(h3, b_ + 14336); \
        asm volatile("s_waitcnt lgkmcnt(0)" ::: "memory"); SBAR();                 \
        o[d0] = __builtin_amdgcn_mfma_f32_32x32x16_bf16(pa0, (bf16x8){l0[0], l0[1], l0[2], l0[3], h0[0], h0[1], h0[2], h0[3]}, o[d0], 0, 0, 0);   \
        o[d0] = __builtin_amdgcn_mfma_f32_32x32x16_bf16(pa1, (bf16x8){l1[0], l1[1], l1[2], l1[3], h1[0], h1[1], h1[2], h1[3]}, o[d0], 0, 0, 0);   \
        o[d0] = __builtin_amdgcn_mfma_f32_32x32x16_bf16(pa2, (bf16x8){l2[0], l2[1], l2[2], l2[3], h2[0], h2[1], h2[2], h2[3]}, o[d0], 0, 0, 0);   \
        o[d0] = __builtin_amdgcn_mfma_f32_32x32x16_bf16(pa3, (bf16x8){l3[0], l3[1], l3[2], l3[3], h3[0], h3[1], h3[2], h3[3]}, o[d0], 0, 0, 0); } while (0)
    PV_D0(0); PV_D0(1); PV_D0(2); PV_D0(3);
#undef PV_D0
#undef TRRD
}

struct BlockRef { const bf16* Q; const bf16* K; const bf16* V; float* O; float* L; int qs, kvs, os, ls, P0, skv; };
struct Seam {
    bf16x8 qr[8];
    bf16x8 st_v0, st_v1, st_k0, st_k1;
};
__device__ __forceinline__ int swa_jlo(int P0, int W) { const int lowk = P0 - W + 1; return lowk > 0 ? lowk / KVBLK : 0; }
#define ROWP(p, st, k0) ((p) + (size_t)(k0) * (size_t)(st))
#define VMW() asm volatile("s_waitcnt vmcnt(0)" ::: "memory")
#define VMWN(n) asm volatile("s_waitcnt vmcnt(%0)" :: "i"(n) : "memory")
#define SLOAD_H(Kp, Vp, st, k0) do { const bf16* kp_ = ROWP(Kp, st, k0); const bf16* vp_ = ROWP(Vp, st, k0); const unsigned o0_ = (unsigned)(sr * (st) + sc), o1_ = o0_ + 32u * (unsigned)(st); \
                         S.st_v0 = load8(vp_ + o0_); S.st_v1 = load8(vp_ + o1_); S.st_k0 = load8(kp_ + o0_); S.st_k1 = load8(kp_ + o1_); } while (0)
#define SWRITE_HK(bf) do { *(bf16x8*)(K_lds + (bf) * SHM_K + kws) = S.st_k0; *(bf16x8*)(K_lds + (bf) * SHM_K + kws + 32 * 256) = S.st_k1; } while (0)
#define SWRITE_HV(bf) do { *(bf16x8*)(V_lds + (bf) * SHM_V + vst0) = S.st_v0; *(bf16x8*)(V_lds + (bf) * SHM_V + vst1) = S.st_v1; } while (0)
#define SWRITE_H(bf) do { SWRITE_HV(bf); SWRITE_HK(bf); } while (0)
__device__ __forceinline__ void causal_swa_prime(const BlockRef& cur, int W, char* lds, Seam& S, int tid) {
    const int wid = __builtin_amdgcn_readfirstlane(tid >> 6), lane = tid & 63, r32 = lane & 31, hi = lane >> 5;
    const int sr = tid >> 4, sc = (tid & 15) * 8, kws = KSWZ(sr, sc * 2); char* K_lds = lds + 2 * SHM_V;
    const int kb0 = swa_jlo(cur.P0, W) * KVBLK;
    { const unsigned qo_ = (unsigned)((wid * QBLK + r32) * cur.qs + hi * 8);
    for (int d0 = 0; d0 < 8; ++d0) S.qr[d0] = load8(cur.Q + qo_ + d0 * 16); }
    SLOAD_H(cur.K, cur.V, cur.kvs, kb0); VMW(); SWRITE_HK(0);
    __syncthreads();
}
template <bool WSK>
__device__ __forceinline__ void causal_swa_block(const BlockRef& cur, const BlockRef& nxt, int W, char* lds, Seam& S, int tid) {
    const int wid = __builtin_amdgcn_readfirstlane(tid >> 6), lane = tid & 63, r32 = lane & 31, hi = lane >> 5;
    const int skv = cur.skv;
    const int j_lo = swa_jlo(cur.P0, W);
    int j_hi = (cur.P0 + QB - 1) / KVBLK + 1; if (j_hi > skv / KVBLK) j_hi = skv / KVBLK;
    const int NT = j_hi - j_lo;
    const int kbn = swa_jlo(nxt.P0, W) * KVBLK;
    const int qlo = cur.P0 + wid * QBLK, qm = qlo + r32 - 4 * hi;
    char* V_lds = lds; char* K_lds = lds + 2 * SHM_V;
    float* ws = (float*)(lds + 2 * SHM_V + 2 * SHM_K) + wid * 64; float* li_l = ws, * al_l = ws + 32;
    float m_reg = -1e30f, l_reg = 0; f32x16 o[4] = {};
    const int sr = tid >> 4, sc = (tid & 15) * 8, vst0 = v_st(sr, sc), vst1 = v_st(32 + sr, sc), kws = KSWZ(sr, sc * 2);
    const int vb0 = (int)(uintptr_t)V_lds + v_rd_base(lane);
    const bf16* Kh = cur.K; const bf16* Vh = cur.V; const int kvs = cur.kvs;
#define RESC(a) do { if (__any((a) < 1.f)) { if (hi == 0) al_l[r32] = (a); asm volatile("s_waitcnt lgkmcnt(0)" ::: "memory");              \
                     for (int d_ = 0; d_ < 4; ++d_) for (int r = 0; r < 16; ++r) o[d_][r] *= al_l[crow(r, hi)]; } } while (0)
#define KBASE(t) ((j_lo + (t)) * KVBLK)
#define ACT(t) (KBASE(t) <= qlo + QBLK - 1 && KBASE(t) + KVBLK - 1 >= qlo - W + 1)
#define MASKT(P0_, P1_, t) do { const int kb_ = KBASE(t); if ((!SK || ACT(t)) && (kb_ + KVBLK - 1 > qlo || kb_ <= qlo + QBLK - 1 - W)) mask_tile(P0_, P1_, qm - kb_, (unsigned)W); } while (0)
    constexpr int NQL = 8;
    constexpr bool SK = WSK;
#define SEAM_K0() do { VMWN(NQL); SWRITE_HK(0); SBAR(); } while (0)
    f32x16 pA0, pA1, pB0, pB1; float mnA, mnB, alA, alB; bf16x8 pa0, pa1, pa2, pa3;
    SWRITE_HV(0); SBAR();
    if (NT > 1) { SLOAD_H(Kh, Vh, kvs, KBASE(1)); }
    SBAR(); qkt<0, SK>(pA0, pA1, K_lds, r32, hi, S.qr, ACT(0));
    MASKT(pA0, pA1, 0); partialSM(pA0, pA1, m_reg, mnA, alA);
    if (NT > 1) { VMW(); SWRITE_H(1); }
    __syncthreads();
#define HALF_STEP(PX0, PX1, mnX, alX, PY0, PY1, alY, t, KB, VB, SB) do {                                                      \
        SBAR(); qkt<KB, SK>(PX0, PX1, K_lds, r32, hi, S.qr, ACT(t));                                             \
        finishSM(PY0, PY1, alY, l_reg, pa0, pa1, pa2, pa3); SBAR();                                                           \
        if ((t) + 1 < NT) { SLOAD_H(Kh, Vh, kvs, KBASE((t) + 1)); SBAR(); }                                               \
        pv_tile<VB, SK>(o, vb0, pa0, pa1, pa2, pa3, ACT((t) - 1)); MASKT(PX0, PX1, (t)); partialSM(PX0, PX1, m_reg, mnX, alX);                                        \
        __syncthreads();                                                                                                      \
        if ((t) + 1 < NT) { VMW(); SWRITE_H(SB); }                                                                          \
        RESC(alX); __syncthreads(); } while (0)
    for (int t = 1; t + 1 < NT; t += 2) {
        HALF_STEP(pB0, pB1, mnB, alB, pA0, pA1, alA, t, 1, 0, 0);
        HALF_STEP(pA0, pA1, mnA, alA, pB0, pB1, alB, t + 1, 0, 1, 1);
    }
    const bool even = (NT & 1) == 0;
    if (even) { SBAR(); qkt<1, SK>(pB0, pB1, K_lds, r32, hi, S.qr, ACT(NT - 1)); SBAR(); }
    { SLOAD_H(nxt.K, nxt.V, nxt.kvs, kbn); SBAR();
#pragma unroll
        for (int d0 = 0; d0 < 8; ++d0) S.qr[d0] = load8(nxt.Q + (unsigned)((wid * QBLK + r32) * nxt.qs + hi * 8) + d0 * 16); }
    SBAR();
    finishSM(pA0, pA1, alA, l_reg, pa0, pa1, pa2, pa3); SBAR();
    pv_tile<0, SK>(o, vb0, pa0, pa1, pa2, pa3, ACT(even ? NT - 2 : NT - 1));
    if (even) { MASKT(pB0, pB1, NT - 1); partialSM(pB0, pB1, m_reg, mnB, alB); __syncthreads(); RESC(alB);
        finishSM(pB0, pB1, alB, l_reg, pa0, pa1, pa2, pa3); SBAR(); pv_tile<1, SK>(o, vb0, pa0, pa1, pa2, pa3, ACT(NT - 1)); }
    SBAR(); SEAM_K0();
    if (hi == 0) li_l[r32] = l_reg; asm volatile("s_waitcnt lgkmcnt(0)" ::: "memory");
    if (cur.L != nullptr && hi == 0) cur.L[(unsigned)((wid * QBLK + r32) * cur.ls)] = m_reg * SCALE + __logf(l_reg);
    float rli[16];
#pragma unroll
    for (int r = 0; r < 16; ++r) rli[r] = __builtin_amdgcn_rcpf(li_l[crow(r, hi)]);
    float* Ow = cur.O + (size_t)(wid * QBLK) * (size_t)cur.os;
#pragma unroll
    for (int r = 0; r < 16; ++r) { const int orow = crow(r, hi);
#pragma unroll
        for (int d0 = 0; d0 < 4; ++d0) { const float v = o[d0][r] * rli[r];
            Ow[(unsigned)(orow * cur.os + d0 * 32 + r32)] = v; } }
    __syncthreads();
#undef RESC
#undef KBASE
#undef ACT
#undef MASKT
#undef SEAM_K0
#undef HALF_STEP
}
#undef ROWP
#undef VMW
#undef VMWN
#undef SLOAD_H
#undef SWRITE_HK
#undef SWRITE_HV
#undef SWRITE_H
#undef KSWZ
#undef SBAR
}
#define GAS __attribute__((address_space(1)))
#define LAS __attribute__((address_space(3)))
typedef unsigned short bf16;
typedef unsigned v4u __attribute__((ext_vector_type(4)));
typedef float f32x4 __attribute__((ext_vector_type(4)));
typedef short bf16x8 __attribute__((ext_vector_type(8)));
typedef GAS unsigned gu32;
typedef GAS unsigned long long gu64;
#define RLX_AGENT __ATOMIC_RELAXED, __HIP_MEMORY_SCOPE_AGENT
#define LDS_WAIT() asm volatile("s_waitcnt lgkmcnt(0)" ::: "memory")
#define VM_WAIT() asm volatile("s_waitcnt vmcnt(0)" ::: "memory")
__device__ __forceinline__ unsigned long long rt() { return __builtin_amdgcn_s_memrealtime(); }
__device__ __forceinline__ unsigned f2bf(float f) { unsigned u = __builtin_bit_cast(unsigned, f); return (u + 0x7fffu + ((u >> 16) & 1u)) >> 16; }
__device__ __forceinline__ unsigned pk2(float lo, float hi) { return f2bf(lo) | (f2bf(hi) << 16); }

#define XB_TMO      128
#define XB_XCNT(j)  (256  + 64 * (j))
#define XB_XSUB(j)  (1280 + 64 * (j))
#define XB_XGEN(j)  (2304 + 64 * (j))
#define XB_TOP      3328
#define XB_TOPGEN   3392
#define XCD_BAR_WORDS 3456
#define XB_SPIN_CAP (1u << 18)

__device__ __forceinline__ unsigned xb_ld(unsigned* p)              { return __hip_atomic_load(p, __ATOMIC_RELAXED, __HIP_MEMORY_SCOPE_AGENT); }
__device__ __forceinline__ unsigned xb_add(unsigned* p, unsigned v) { return __hip_atomic_fetch_add(p, v, __ATOMIC_RELAXED, __HIP_MEMORY_SCOPE_AGENT); }
__device__ __forceinline__ unsigned xb_xcc_id() { return (unsigned)__builtin_amdgcn_s_getreg((3 << 11) | 20) & 0xFu; }
#define XB_SPIN(cond, bar) do { unsigned _sp = 0; while (cond) { __builtin_amdgcn_s_sleep(1); \
    if ((++_sp & 255u) == 0u) { if (xb_ld(&(bar)[XB_TMO])) break; if (_sp > XB_SPIN_CAP) { atomicAdd(&(bar)[XB_TMO], 1u); break; } } } } while (0)

struct XcdBarrier {
    unsigned* bar; unsigned x;
    volatile LAS unsigned* st;
};

__device__ __forceinline__ XcdBarrier xcd_barrier_post(unsigned* bar, volatile LAS unsigned* st, bool leader  ) {
    XcdBarrier b; b.bar = bar; b.x = xb_xcc_id(); b.st = st;
    if (leader) (void)xb_add(&bar[XB_XCNT(b.x)], 1u);
    return b;
}
__device__ __forceinline__ void xcd_barrier_complete(unsigned* bar, unsigned x, unsigned& nloc, unsigned& nx) {
    const unsigned G = gridDim.x * gridDim.y * gridDim.z;
    unsigned sum, cnt, mine, sp = 0u;
    for (;;) {
        sum = 0u; cnt = 0u; mine = 0u;
#pragma unroll
        for (unsigned j = 0; j < 16; ++j) { const unsigned c = xb_ld(&bar[XB_XCNT(j)]); sum += c; cnt += (c > 0u) ? 1u : 0u; mine = (j == x) ? c : mine; }
        if (sum == G) break;
        __builtin_amdgcn_s_sleep(1);
        if ((++sp & 255u) == 0u) { if (xb_ld(&bar[XB_TMO])) break; if (sp > XB_SPIN_CAP) { atomicAdd(&bar[XB_TMO], 1u); break; } }
    }
    nloc = mine > 0u ? mine : 1u; nx = cnt > 0u ? cnt : 1u;
}

__device__ __forceinline__ void xcd_barrier(const XcdBarrier& b, bool leader  ) {
    asm volatile("s_waitcnt vmcnt(0)" ::: "memory");
    __syncthreads();
    if (leader) {
        unsigned* bar = b.bar;
        __builtin_amdgcn_s_waitcnt(0);
        unsigned nloc = b.st[0], nx = b.st[1];
        if (nloc == 0u) { xcd_barrier_complete(bar, b.x, nloc, nx); b.st[0] = nloc; b.st[1] = nx; }
        const unsigned old = xb_add(&bar[XB_XSUB(b.x)], 1u);
        const unsigned gen = old / nloc;
        if (old + 1u == (gen + 1u) * nloc) {
            __builtin_amdgcn_fence(__ATOMIC_RELEASE, "agent");
            asm volatile("s_waitcnt vmcnt(0)" ::: "memory");
            const unsigned og = xb_add(&bar[XB_TOP], 1u);
            const unsigned tg = og / nx;
            if (og + 1u == (tg + 1u) * nx) xb_add(&bar[XB_TOPGEN], 1u);
            else XB_SPIN(xb_ld(&bar[XB_TOPGEN]) == tg, bar);
            __builtin_amdgcn_fence(__ATOMIC_ACQUIRE, "agent");
            xb_add(&bar[XB_XGEN(b.x)], 1u);
            asm volatile("s_waitcnt vmcnt(0)" ::: "memory");
        } else {
            XB_SPIN(xb_ld(&bar[XB_XGEN(b.x)]) == gen, bar);
            __builtin_amdgcn_fence(__ATOMIC_ACQUIRE, "agent");
            asm volatile("s_waitcnt vmcnt(0)" ::: "memory");
        }
    }
    __syncthreads();
}

constexpr int NWAVES = 8;
#ifndef MK_ONE_LAUNCH
#define MK_ONE_LAUNCH 1
#endif

constexpr int BATCH = 4, SEQ = 4096, DM = 2048, M = BATCH * SEQ, HD = 128;
constexpr int NQKV_A = 9216, AGW = 1024, DFF = 8192, NMOD = 6 * DM, NKV = 2 * DM;
constexpr float NORM_EPS = 1e-6f;
constexpr int N_STAGE = 5;
constexpr int N_PHASE = 36;

constexpr size_t MiB = 1u << 20;
constexpr size_t WS_CTL = 0, CTL_ZERO_BYTES = 1 * MiB;
constexpr size_t WS_MOD = 1 * MiB;
constexpr size_t WS_COS = 2 * MiB, WS_SIN = 3 * MiB;
constexpr size_t WS_LA = 4 * MiB;
constexpr size_t WS_MODP = 8 * MiB;
constexpr size_t WS_WQKVA = 40 * MiB;
constexpr size_t WS_WOA = 112 * MiB;
constexpr size_t WS_WKV = 120 * MiB;
constexpr size_t WS_WQB = 136 * MiB;
constexpr size_t WS_WOB = 152 * MiB;
constexpr size_t WS_W1 = 168 * MiB;
constexpr size_t WS_W2 = 296 * MiB;
constexpr size_t WS_H = 424 * MiB;
constexpr size_t WS_AO = 488 * MiB;
constexpr size_t WS_KVB = 552 * MiB;
constexpr size_t WS_QKV = 680 * MiB;
constexpr size_t WS_OP = 968 * MiB;
constexpr size_t WS_END = 1224 * MiB;
constexpr int MOD_TOTAL = 4 * BATCH * NMOD + BATCH * NKV;
constexpr int MOD_KV_OFF = 4 * BATCH * NMOD;
constexpr int GEMV_KC = 32, GEMV_KLEN = DM / GEMV_KC;
constexpr int CW_BAR = 4096;

constexpr int RING_OFF = 0, RING_BYTES = 131072;
constexpr int LDSCTL_OFF = RING_BYTES, MISC_OFF = LDSCTL_OFF + 320;
constexpr int XCH_OFF = RING_BYTES + 1024;
constexpr int LDS_BYTES = 147456;


struct Args {
    const float* x; const float* c; const int* pos; const float* ada_w; const float* ada_b; const float* norm_g;
    const float* a_w_qkv; const float* a_q_gain; const float* a_k_gain; const float* a_w_o;
    const float* kv_ada_w; const float* kv_ada_b; const float* kv_norm_g; const float* kv_w_k; const float* kv_w_v; const float* kv_k_gain;
    const float* b_w_q; const float* b_q_gain; const float* b_lambda; const float* b_subln_g; const float* b_w_o;
    const float* mlp_w1; const float* mlp_w2;
    float* out; unsigned char* ws;
    float inv_freq[16]; float lam_init[2];
    int ph_lo, ph_hi;
};
static_assert(sizeof(Args) == 25 * 8 + 16 * 4 + 2 * 4 + 2 * 4, "Args has no padding bytes");
typedef __attribute__((address_space(4))) const Args* ArgsP;
__device__ __forceinline__ ArgsP get_args() { ArgsP p = (ArgsP)__builtin_amdgcn_kernarg_segment_ptr(); asm volatile("" : "+s"(p)); return p; }
struct Ctx { int tid, lane, wave, G, bx, vcu, gw, NGW; };
__device__ __forceinline__ Ctx fresh_ctx(int wave_s) {
    Ctx c; int ln; asm volatile("v_mbcnt_lo_u32_b32 %0, -1, 0\n\tv_mbcnt_hi_u32_b32 %0, -1, %0" : "=v"(ln));     const int t = wave_s * 64 + ln;
    int G = gridDim.x, bx = blockIdx.x; asm volatile("" : "+s"(G), "+s"(bx));
    c.tid = t; c.lane = t & 63; c.wave = __builtin_amdgcn_readfirstlane(t >> 6); c.G = G; c.bx = bx;
    c.vcu = (G % 8 == 0) ? (bx % 8) * (G / 8) + bx / 8 : bx;
    c.gw = c.vcu * 8 + c.wave; c.NGW = G * 8; return c;
}

typedef unsigned short bfu;
typedef unsigned u32x2 __attribute__((ext_vector_type(2)));

__device__ __forceinline__ float shx(float v, int o, int lane) { return __int_as_float(__builtin_amdgcn_ds_bpermute((lane ^ o) << 2, __float_as_int(v))); }
__device__ __forceinline__ float wave_sum(float v, int lane) {
#pragma unroll
    for (int o = 1; o < 64; o <<= 1) v += shx(v, o, lane);
    return v;
}
__device__ __forceinline__ float bf2f(unsigned bits16) { return __uint_as_float(bits16 << 16); }
__device__ __forceinline__ unsigned pkbf(float lo, float hi) { return pg8::cvt_pk_bf16(lo, hi); }

__device__ __forceinline__ void transpose_item(const float* __restrict__ W, int K, int N, bfu* __restrict__ WT, int item, int lane) {
    const int nb = N >> 6, kb = item / nb, nbi = item - kb * nb, k0 = kb << 6, n0 = nbi << 6;
    const float* src = W + (size_t)k0 * N + n0 + lane;
    float v[64];
#pragma unroll
    for (int i = 0; i < 64; ++i) v[i] = src[(size_t)i * N];
    bfu* dst = WT + (size_t)(n0 + lane) * K + k0;
#pragma unroll
    for (int kk = 0; kk < 8; ++kk) { v4u o; o.x = pkbf(v[8 * kk + 0], v[8 * kk + 1]); o.y = pkbf(v[8 * kk + 2], v[8 * kk + 3]); o.z = pkbf(v[8 * kk + 4], v[8 * kk + 5]); o.w = pkbf(v[8 * kk + 6], v[8 * kk + 7]);
        *(v4u*)(dst + 8 * kk) = o; }
}

__device__ __forceinline__ void p0_prologue(ArgsP a, LAS unsigned char* lds, int tid, int lane, int wave, int vcu, int G) {
    unsigned char* ws = a->ws;
    LAS float* cact = (LAS float*)lds;
    LAS float* ifr = (LAS float*)(lds + 32768);
    for (int i = tid; i < BATCH * DM; i += NWAVES * 64) { const int b = i / DM, k = i - b * DM; const float v = a->c[i]; cact[k * 4 + b] = v / (1.f + expf(-v)); }
    if (tid == 0) {
        ifr[0] = a->inv_freq[0]; ifr[1] = a->inv_freq[1]; ifr[2] = a->inv_freq[2]; ifr[3] = a->inv_freq[3]; ifr[4] = a->inv_freq[4]; ifr[5] = a->inv_freq[5]; ifr[6] = a->inv_freq[6]; ifr[7] = a->inv_freq[7];
        ifr[8] = a->inv_freq[8]; ifr[9] = a->inv_freq[9]; ifr[10] = a->inv_freq[10]; ifr[11] = a->inv_freq[11]; ifr[12] = a->inv_freq[12]; ifr[13] = a->inv_freq[13]; ifr[14] = a->inv_freq[14]; ifr[15] = a->inv_freq[15];
    }
    __syncthreads();
    const int gw = vcu * NWAVES + wave, NGW = G * NWAVES;
    {
        constexpr int ITEMS_L = (NMOD / 256) * GEMV_KC, ITEMS_KV = (NKV / 256) * GEMV_KC, NITEMS = 4 * ITEMS_L + ITEMS_KV;
        float* MODP = (float*)(ws + WS_MODP);
        for (int it = gw; it < NITEMS; it += NGW) {
            const float* W; int N, slab, kc, moff;
            if (it < 4 * ITEMS_L) { const int l = it / ITEMS_L, r = it - l * ITEMS_L; slab = r / GEMV_KC; kc = r - slab * GEMV_KC; W = a->ada_w + (size_t)l * DM * NMOD; N = NMOD; moff = l * BATCH * NMOD; }
            else { const int r = it - 4 * ITEMS_L; slab = r / GEMV_KC; kc = r - slab * GEMV_KC; W = a->kv_ada_w; N = NKV; moff = MOD_KV_OFF; }
            const int n0 = slab * 256 + lane * 4, k0 = kc * GEMV_KLEN;
            f32x4 acc0 = {0.f, 0.f, 0.f, 0.f}, acc1 = acc0, acc2 = acc0, acc3 = acc0;
            const float* wp = W + (size_t)k0 * N + n0;
#pragma unroll 16
            for (int k = 0; k < GEMV_KLEN; ++k) {
                const f32x4 w = *(const f32x4*)(wp + (size_t)k * N);
                const f32x4 cv = *(const LAS f32x4*)(cact + (k0 + k) * 4);
                acc0 += w * cv.x; acc1 += w * cv.y; acc2 += w * cv.z; acc3 += w * cv.w;
            }
            float* mp = MODP + (size_t)kc * MOD_TOTAL + moff + n0;
            *(f32x4*)(mp) = acc0; *(f32x4*)(mp + N) = acc1; *(f32x4*)(mp + 2 * N) = acc2; *(f32x4*)(mp + 3 * N) = acc3;
        }
    }
    {
        float* cosT = (float*)(ws + WS_COS); float* sinT = (float*)(ws + WS_SIN);
        for (int i = vcu * (NWAVES * 64) + tid; i < M * 16; i += G * NWAVES * 64) {
            const int row = i >> 4, j = i & 15; const float ang = (float)a->pos[row] * ifr[j];
            cosT[i] = cosf(ang); sinT[i] = sinf(ang); }
    }
    {
        bfu* WQKVA = (bfu*)(ws + WS_WQKVA); bfu* WOA = (bfu*)(ws + WS_WOA); bfu* WKV = (bfu*)(ws + WS_WKV); bfu* WQB = (bfu*)(ws + WS_WQB); bfu* WOB = (bfu*)(ws + WS_WOB);
        bfu* W1 = (bfu*)(ws + WS_W1); bfu* W2 = (bfu*)(ws + WS_W2);
        constexpr int NT_ITEMS = 49152;
        for (int it = gw; it < NT_ITEMS; it += NGW) {
            int r = it; const float* W; bfu* WT; int K, N, item;
            if (r < 9216) { const int l = r / 4608; W = a->a_w_qkv + (size_t)l * DM * NQKV_A; K = DM; N = NQKV_A; WT = WQKVA + (size_t)l * NQKV_A * DM; item = r - l * 4608; }
            else if ((r -= 9216) < 1024) { const int l = r / 512; W = a->a_w_o + (size_t)l * AGW * DM; K = AGW; N = DM; WT = WOA + (size_t)l * DM * AGW; item = r - l * 512; }
            else if ((r -= 1024) < 1024) { W = a->kv_w_k; K = DM; N = DM; WT = WKV; item = r; }
            else if ((r -= 1024) < 1024) { W = a->kv_w_v; K = DM; N = DM; WT = WKV + (size_t)DM * DM; item = r; }
            else if ((r -= 1024) < 2048) { const int j = r / 1024; W = a->b_w_q + (size_t)j * DM * DM; K = DM; N = DM; WT = WQB + (size_t)j * DM * DM; item = r - j * 1024; }
            else if ((r -= 2048) < 2048) { const int j = r / 1024; W = a->b_w_o + (size_t)j * DM * DM; K = DM; N = DM; WT = WOB + (size_t)j * DM * DM; item = r - j * 1024; }
            else if ((r -= 2048) < 16384) { const int l = r / 4096; W = a->mlp_w1 + (size_t)l * DM * DFF; K = DM; N = DFF; WT = W1 + (size_t)l * DFF * DM; item = r - l * 4096; }
            else { r -= 16384; const int l = r / 4096; W = a->mlp_w2 + (size_t)l * DFF * DM; K = DFF; N = DM; WT = W2 + (size_t)l * DM * DFF; item = r - l * 4096; }
            transpose_item(W, K, N, WT, item, lane);
        }
    }
}

__device__ __forceinline__ void p0b_modreduce(ArgsP a, int tid, int vcu, int G) {
    const float* MODP = (const float*)(a->ws + WS_MODP); float* MOD = (float*)(a->ws + WS_MOD);
    for (int i4 = vcu * (NWAVES * 64) + tid; i4 < MOD_TOTAL / 4; i4 += G * NWAVES * 64) {
        const int i = i4 * 4; f32x4 s;
        if (i < MOD_KV_OFF) { const int l = i / (BATCH * NMOD), n = i % NMOD; s = *(const f32x4*)(a->ada_b + (size_t)l * NMOD + n); }
        else { const int n = (i - MOD_KV_OFF) % NKV; s = *(const f32x4*)(a->kv_ada_b + n); }
#pragma unroll 8
        for (int kc = 0; kc < GEMV_KC; ++kc) s += *(const f32x4*)(MODP + (size_t)kc * MOD_TOTAL + i);
        *(f32x4*)(MOD + i) = s;
    }
}

__device__ __forceinline__ void norm_phase(const float* X, const float* g, const float* shift, const float* scale, int bstride, bfu* H, int lane, int gw, int NGW) {
    for (int rb = gw; rb < M / 8; rb += NGW) {
        const int row0 = rb * 8, b = row0 / SEQ;
        f32x4 gs[8], sh[8];
#pragma unroll
        for (int j = 0; j < 8; ++j) { const int col = 4 * lane + 256 * j;
            const f32x4 gv = *(const f32x4*)(g + col), sc = *(const f32x4*)(scale + (size_t)b * bstride + col);
            gs[j] = gv * (sc + 1.0f); sh[j] = *(const f32x4*)(shift + (size_t)b * bstride + col); }
        for (int r = 0; r < 8; ++r) {
            const float* xr = X + (size_t)(row0 + r) * DM + 4 * lane; f32x4 v[8]; float ss = 0.f;
#pragma unroll
            for (int j = 0; j < 8; ++j) { v[j] = *(const f32x4*)(xr + 256 * j); ss += (v[j].x * v[j].x + v[j].y * v[j].y) + (v[j].z * v[j].z + v[j].w * v[j].w); }
            ss = wave_sum(ss, lane);
            const float rstd = 1.0f / sqrtf(ss * (1.0f / DM) + NORM_EPS);
            bfu* hr = H + (size_t)(row0 + r) * DM + 4 * lane;
#pragma unroll
            for (int j = 0; j < 8; ++j) { const f32x4 o = v[j] * rstd * gs[j] + sh[j]; u32x2 w; w.x = pkbf(o.x, o.y); w.y = pkbf(o.z, o.w); *(u32x2*)(hr + 256 * j) = w; }
        }
    }
}

template <int KIND>
__device__ __forceinline__ void qknorm_phase(bfu* buf, const float* gq, const float* gk, const float* cosT, const float* sinT, int lane, int gw, int NGW) {
    constexpr int NQUAD = KIND == 0 ? 12 : 4; constexpr int LD = KIND == 0 ? NQKV_A : (KIND == 1 ? NKV : DM);
    const int sub = lane & 15, ql = lane >> 4;
    for (int it = gw; it < M * NQUAD; it += NGW) {
        const int row = it / NQUAD, q = it - row * NQUAD; const int j = q * 4 + ql;
        int col; const float* gain;
        if (KIND == 0) { const int g = j >> 4, typ = (j >> 3) & 1, h = j & 7; col = g * 3072 + typ * 1024 + h * 128; gain = (typ ? gk : gq) + g * 128; }
        else { col = j * 128; gain = gq + (j & 1) * 128; }
        bfu* p = buf + (size_t)row * LD + col + sub * 8;
        const v4u raw = *(const v4u*)p;
        float v[8];
        v[0] = bf2f(raw.x & 0xffffu); v[1] = bf2f(raw.x >> 16); v[2] = bf2f(raw.y & 0xffffu); v[3] = bf2f(raw.y >> 16);
        v[4] = bf2f(raw.z & 0xffffu); v[5] = bf2f(raw.z >> 16); v[6] = bf2f(raw.w & 0xffffu); v[7] = bf2f(raw.w >> 16);
        float ss = 0.f;
#pragma unroll
        for (int i = 0; i < 8; ++i) ss += v[i] * v[i];
        ss += shx(ss, 1, lane); ss += shx(ss, 2, lane); ss += shx(ss, 4, lane); ss += shx(ss, 8, lane);
        const float rstd = 1.0f / sqrtf(ss * (1.0f / HD) + NORM_EPS);
        const f32x4 g0 = *(const f32x4*)(gain + sub * 8), g1 = *(const f32x4*)(gain + sub * 8 + 4);
        v[0] *= rstd * g0.x; v[1] *= rstd * g0.y; v[2] *= rstd * g0.z; v[3] *= rstd * g0.w; v[4] *= rstd * g1.x; v[5] *= rstd * g1.y; v[6] *= rstd * g1.z; v[7] *= rstd * g1.w;
        float pv[8];
#pragma unroll
        for (int i = 0; i < 8; ++i) pv[i] = shx(v[i], 2, lane);
        if (sub < 4) {
            const float* cp = cosT + (size_t)row * 16 + (sub & 1) * 8; const float* sp = sinT + (size_t)row * 16 + (sub & 1) * 8;
            const f32x4 c0 = *(const f32x4*)cp, c1 = *(const f32x4*)(cp + 4), s0 = *(const f32x4*)sp, s1 = *(const f32x4*)(sp + 4);
            const float cs[8] = {c0.x, c0.y, c0.z, c0.w, c1.x, c1.y, c1.z, c1.w}; const float sn[8] = {s0.x, s0.y, s0.z, s0.w, s1.x, s1.y, s1.z, s1.w};
            const float sgn = (sub < 2) ? -1.0f : 1.0f;
#pragma unroll
            for (int i = 0; i < 8; ++i) v[i] = v[i] * cs[i] + sgn * pv[i] * sn[i];
        }
        v4u o; o.x = pkbf(v[0], v[1]); o.y = pkbf(v[2], v[3]); o.z = pkbf(v[4], v[5]); o.w = pkbf(v[6], v[7]);
        *(v4u*)p = o;
    }
}

__device__ __forceinline__ void combineA_phase(const float* OP, const float* LA, bfu* AO, int lane, int gw, int NGW) {
    for (int row = gw; row < M; row += NGW) {
#pragma unroll
        for (int j = 0; j < 4; ++j) { const int col = 4 * lane + 256 * j, h = col >> 7;
            const float l0 = LA[(size_t)row * 8 + h], l1 = LA[(size_t)M * 8 + (size_t)row * 8 + h], l2 = LA[(size_t)2 * M * 8 + (size_t)row * 8 + h];
            const float mx = fmaxf(l0, fmaxf(l1, l2)); const float e0 = expf(l0 - mx), e1 = expf(l1 - mx), e2 = expf(l2 - mx); const float inv = 1.0f / (e0 + e1 + e2);
            const f32x4 o0 = *(const f32x4*)(OP + (size_t)row * AGW + col), o1 = *(const f32x4*)(OP + (size_t)M * AGW + (size_t)row * AGW + col), o2 = *(const f32x4*)(OP + (size_t)2 * M * AGW + (size_t)row * AGW + col);
            const f32x4 o = (o0 * e0 + o1 * e1 + o2 * e2) * inv;
            u32x2 w; w.x = pkbf(o.x, o.y); w.y = pkbf(o.z, o.w); *(u32x2*)(AO + (size_t)row * AGW + col) = w; }
    }
}
__device__ __forceinline__ void combineB_phase(const float* OP, const float* lp, const float* subg, float lam_init, bfu* AO, int lane, int gw, int NGW) {
    float s1 = lp[lane] * lp[128 + lane] + lp[64 + lane] * lp[192 + lane], s2 = lp[256 + lane] * lp[384 + lane] + lp[320 + lane] * lp[448 + lane];
    s1 = wave_sum(s1, lane); s2 = wave_sum(s2, lane);
    const float lam = expf(s1) - expf(s2) + lam_init;
    const f32x4 sg = *(const f32x4*)(subg + 4 * lane) * (1.0f - lam_init);
    for (int row = gw; row < M; row += NGW) {
        const float* p0 = OP + (size_t)row * DM + 4 * lane; const float* p1 = p0 + (size_t)M * DM;
        bfu* ao = AO + (size_t)row * DM + 4 * lane;
#pragma unroll
        for (int j = 0; j < 8; ++j) {
            const f32x4 o = *(const f32x4*)(p0 + 256 * j) - *(const f32x4*)(p1 + 256 * j) * lam;
            float ss = (o.x * o.x + o.y * o.y) + (o.z * o.z + o.w * o.w); ss = wave_sum(ss, lane);
            const float rstd = 1.0f / sqrtf(ss * (1.0f / 256.0f) + NORM_EPS);
            const f32x4 r = o * rstd * sg; u32x2 w; w.x = pkbf(r.x, r.y); w.y = pkbf(r.z, r.w); *(u32x2*)(ao + 256 * j) = w; }
    }
}

__device__ __forceinline__ swa::BlockRef attnA_ref(int L, const bfu* QKV, float* OP, float* LA) {
    const int g = L >> 9, rem = L & 511, bh = rem >> 4, sub = rem & 15, dsh = 2 * g, d = 1 << dsh;
    const int r = sub >> (4 - dsh), qb = sub & ((16 >> dsh) - 1), b = bh >> 3, h = bh & 7;
    const size_t tok0 = (size_t)b * SEQ + r, tq = tok0 + (size_t)d * 256 * qb;
    swa::BlockRef R;
    R.Q = (const swa::bf16*)(QKV + tq * NQKV_A + g * 3072 + h * 128);
    R.K = (const swa::bf16*)(QKV + tok0 * NQKV_A + g * 3072 + 1024 + h * 128);
    R.V = (const swa::bf16*)(QKV + tok0 * NQKV_A + g * 3072 + 2048 + h * 128);
    R.O = OP + (size_t)g * M * AGW + tq * AGW + h * 128; R.L = LA + (size_t)g * M * 8 + tq * 8 + h;
    R.qs = d * NQKV_A; R.kvs = d * NQKV_A; R.os = d * AGW; R.ls = d * 8; R.P0 = 256 * qb; R.skv = SEQ >> dsh;
    return R;
}
__device__ __forceinline__ swa::BlockRef attnB_ref(int I, int pass, const bfu* Qb, const bfu* KVB, float* OP) {
    const int bh = I >> 5, slot = I & 31, c = slot >> 4, vh = (slot >> 3) & 1, x = slot & 7, qb = pass ? 15 - x : x, b = bh >> 3, h = bh & 7;
    const size_t tq = (size_t)b * SEQ + 256 * qb;
    swa::BlockRef R;
    R.Q = (const swa::bf16*)(Qb + tq * DM + h * 256 + c * 128);
    R.K = (const swa::bf16*)(KVB + (size_t)b * SEQ * NKV + h * 256 + c * 128);
    R.V = (const swa::bf16*)(KVB + (size_t)b * SEQ * NKV + DM + h * 256 + vh * 128);
    R.O = OP + (size_t)c * M * DM + tq * DM + h * 256 + vh * 128; R.L = nullptr;
    R.qs = DM; R.kvs = NKV; R.os = DM; R.ls = 0; R.P0 = 256 * qb; R.skv = SEQ;
    return R;
}

__global__ void __launch_bounds__(NWAVES * 64, 2) yoco_fwd(Args args_unused) {
    (void)args_unused;
    extern __shared__ __attribute__((aligned(16))) unsigned char lds_raw[];
    LAS unsigned char* lds = (LAS unsigned char*)lds_raw;
    volatile LAS unsigned* MISC = (volatile LAS unsigned*)(lds + MISC_OFF);
    const int wave_s = __builtin_amdgcn_readfirstlane((int)threadIdx.x >> 6);
    for (int u = threadIdx.x; u < (LDS_BYTES - LDSCTL_OFF) / 4; u += NWAVES * 64) ((LAS unsigned*)(lds + LDSCTL_OFF))[u] = 0u;
    __syncthreads();
    int lo, hi; XcdBarrier bar;
    { ArgsP a = get_args(); const Ctx c = fresh_ctx(wave_s); lo = a->ph_lo; hi = a->ph_hi; unsigned* bw = (unsigned*)(a->ws + WS_CTL) + CW_BAR;
      bar.bar = bw; bar.x = 0; bar.st = nullptr;
      if (hi - lo > 1) bar = xcd_barrier_post(bw, MISC + 8, threadIdx.x == 0); }
#define IN(k) (lo <= (k) && (k) < hi)
#define SEAM(k) do { if (IN(k) && IN((k) + 1)) { XcdBarrier bb_ = bar; { GAS unsigned* gb_ = (GAS unsigned*)bar.bar; asm volatile("" : "+s"(gb_), "+s"(bb_.x)); bb_.bar = (unsigned*)gb_; } const Ctx cb_ = fresh_ctx(wave_s); xcd_barrier(bb_, cb_.tid == 0); } } while (0)
#define WSP(T, off) ((T*)(a->ws + (off)))
#ifndef DUP_MASK
#define DUP_MASK 0
#endif
#define NREP(k) (1 + ((DUP_MASK >> (k)) & 1))
#define REPBAR() do { if (rep_ && hi - lo > 1) { XcdBarrier bb_ = bar; { GAS unsigned* gb_ = (GAS unsigned*)bar.bar; asm volatile("" : "+s"(gb_), "+s"(bb_.x)); bb_.bar = (unsigned*)gb_; } const Ctx cb_ = fresh_ctx(wave_s); xcd_barrier(bb_, cb_.tid == 0); } } while (0)

    if (IN(0)) for (int rep_ = 0; rep_ < NREP(9); ++rep_) { REPBAR(); const Ctx c = fresh_ctx(wave_s); p0_prologue(get_args(), lds, c.tid, c.lane, c.wave, c.vcu, c.G); }
    SEAM(0);
    if (IN(1)) { const Ctx c = fresh_ctx(wave_s); p0b_modreduce(get_args(), c.tid, c.vcu, c.G); }
    SEAM(1);

    for (int s = 0; s < N_STAGE; ++s) {
        const int kind = (s < 2) ? 0 : (s == 2 ? 1 : 2);
        const int layer = (s < 2) ? s : s - 1;
        const int jb = s - 3;
        const int pb = (s == 0) ? 2 : (s == 1) ? 10 : (s == 2) ? 18 : (s == 3) ? 20 : 28;

        if (IN(pb + 0)) for (int rep_ = 0; rep_ < NREP(0); ++rep_) { REPBAR();
            ArgsP a = get_args(); const Ctx c = fresh_ctx(wave_s); const float* MOD = WSP(const float, WS_MOD); bfu* Hb = WSP(bfu, WS_H);
            if (kind == 1) norm_phase(a->out, a->kv_norm_g, MOD + MOD_KV_OFF, MOD + MOD_KV_OFF + DM, NKV, Hb, c.lane, c.gw, c.NGW);
            else { const float* modl = MOD + (size_t)layer * BATCH * NMOD; norm_phase((s == 0) ? a->x : (const float*)a->out, a->norm_g + (size_t)(layer * 2) * DM, modl, modl + DM, NMOD, Hb, c.lane, c.gw, c.NGW); }
        }
        SEAM(pb + 0);
        if (IN(pb + 1)) for (int rep_ = 0; rep_ < NREP(kind == 0 ? 1 : (kind == 1 ? 12 : 13)); ++rep_) { REPBAR();
            ArgsP a = get_args(); const Ctx c = fresh_ctx(wave_s);
            const bfu* Wt; int N; bfu* O; const float* gq; const float* gk;
            if (kind == 0) { Wt = WSP(const bfu, WS_WQKVA) + (size_t)layer * NQKV_A * DM; N = NQKV_A; O = WSP(bfu, WS_QKV); gq = a->a_q_gain + (size_t)layer * 3 * HD; gk = a->a_k_gain + (size_t)layer * 3 * HD; }
            else if (kind == 1) { Wt = WSP(const bfu, WS_WKV); N = NKV; O = WSP(bfu, WS_KVB); gq = a->kv_k_gain; gk = gq; }
            else { Wt = WSP(const bfu, WS_WQB) + (size_t)jb * DM * DM; N = DM; O = WSP(bfu, WS_QKV); gq = a->b_q_gain + (size_t)jb * 2 * HD; gk = gq; }
            pg8::Gemm g{WSP(const bfu, WS_H), Wt, M, N, DM}; pg8::StaticOrder S; S.init(M, N, c.G, c.bx);
            pg8::EpiQK E{O, N, kind, gq, gk, WSP(const float, WS_COS), WSP(const float, WS_SIN), (LAS float*)(lds + XCH_OFF), NORM_EPS};
            pg8::gemm_phase<pg8::EpiQK, pg8::StaticOrder, true, true>(lds + RING_OFF, g, S, E, c.tid);
        }
        SEAM(pb + 1);
        if (kind == 1) continue;
        if (IN(pb + 2)) for (int rep_ = 0; rep_ < NREP(kind == 0 ? 2 : 10); ++rep_) { REPBAR();
            ArgsP a = get_args(); const Ctx c = fresh_ctx(wave_s);
            const bfu* QKV = WSP(const bfu, WS_QKV); float* OP = WSP(float, WS_OP);
            if (kind == 0) {
                float* LA = WSP(float, WS_LA);
                const int total = 1536; const int G = c.G; int L = c.bx;
                if (L < total) {
                    swa::BlockRef cur = attnA_ref(L, QKV, OP, LA); swa::Seam SS;
                    swa::causal_swa_prime(cur, 129, (char*)lds_raw, SS, c.tid);
                    for (;;) {
                        const bool more = L + G < total;
                        const swa::BlockRef nxt = more ? attnA_ref(L + G, QKV, OP, LA) : cur;
                        swa::causal_swa_block<true>(cur, nxt, 129, (char*)lds_raw, SS, c.tid);
                        if (!more) break;
                        cur = nxt; L += G;
                    }
                }
            } else {
                const bfu* KVB = WSP(const bfu, WS_KVB); const int G = c.G, vcu = c.vcu;
                const int nit = (G == 256) ? 4 : (vcu < 1024 ? (1024 - vcu + G - 1) / G : 0);
                int n = 0; const int nblk = 2 * nit;
#define ITEM_OF(i) ((G == 256) ? ((vcu >> 5) * 128 + (i) * 32 + (vcu & 31)) : (vcu + (i) * G))
                if (nblk > 0) {
                    swa::BlockRef cur = attnB_ref(ITEM_OF(0), 0, QKV, KVB, OP); swa::Seam SS;
                    swa::causal_swa_prime(cur, SEQ, (char*)lds_raw, SS, c.tid);
                    for (;;) {
                        const bool more = n + 1 < nblk;
                        const swa::BlockRef nxt = more ? attnB_ref(ITEM_OF((n + 1) >> 1), (n + 1) & 1, QKV, KVB, OP) : cur;
                        swa::causal_swa_block<false>(cur, nxt, SEQ, (char*)lds_raw, SS, c.tid);
                        if (!more) break;
                        cur = nxt; ++n;
                    }
                }
#undef ITEM_OF
            }
        }
        SEAM(pb + 2);
        if (IN(pb + 3)) for (int rep_ = 0; rep_ < NREP(kind == 0 ? 3 : 11); ++rep_) { REPBAR();
            ArgsP a = get_args(); const Ctx c = fresh_ctx(wave_s);
            if (kind == 0) combineA_phase(WSP(const float, WS_OP), WSP(const float, WS_LA), WSP(bfu, WS_AO), c.lane, c.gw, c.NGW);
            else combineB_phase(WSP(const float, WS_OP), a->b_lambda + (size_t)jb * 4 * HD, a->b_subln_g + (size_t)jb * 256, jb == 0 ? a->lam_init[0] : a->lam_init[1], WSP(bfu, WS_AO), c.lane, c.gw, c.NGW);
        }
        SEAM(pb + 3);
        if (IN(pb + 4)) for (int rep_ = 0; rep_ < NREP(4); ++rep_) { REPBAR();
            ArgsP a = get_args(); const Ctx c = fresh_ctx(wave_s);
            const bfu* Wt; int K;
            if (kind == 0) { Wt = WSP(const bfu, WS_WOA) + (size_t)layer * DM * AGW; K = AGW; }
            else { Wt = WSP(const bfu, WS_WOB) + (size_t)jb * DM * DM; K = DM; }
            pg8::Gemm g{WSP(const bfu, WS_AO), Wt, M, DM, K}; pg8::StaticOrder S; S.init(M, DM, c.G, c.bx);
            pg8::EpiRes E{(s == 0) ? a->x : (const float*)a->out, rep_ ? WSP(float, WS_OP) : a->out, DM, WSP(const float, WS_MOD) + (size_t)layer * BATCH * NMOD + 2 * DM, NMOD, SEQ};
            pg8::gemm_phase<pg8::EpiRes, pg8::StaticOrder, true, true>(lds + RING_OFF, g, S, E, c.tid);
        }
        SEAM(pb + 4);
        if (IN(pb + 5)) for (int rep_ = 0; rep_ < NREP(5); ++rep_) { REPBAR();
            ArgsP a = get_args(); const Ctx c = fresh_ctx(wave_s); const float* modl = WSP(const float, WS_MOD) + (size_t)layer * BATCH * NMOD;
            norm_phase(a->out, a->norm_g + (size_t)(layer * 2 + 1) * DM, modl + 3 * DM, modl + 4 * DM, NMOD, WSP(bfu, WS_H), c.lane, c.gw, c.NGW);
        }
        SEAM(pb + 5);
        if (IN(pb + 6)) for (int rep_ = 0; rep_ < NREP(6); ++rep_) { REPBAR();
            ArgsP a = get_args(); const Ctx c = fresh_ctx(wave_s);
            pg8::Gemm g{WSP(const bfu, WS_H), WSP(const bfu, WS_W1) + (size_t)layer * DFF * DM, M, DFF, DM}; pg8::StaticOrder S; S.init(M, DFF, c.G, c.bx);
            pg8::EpiBf16<1> E{WSP(bfu, WS_QKV), DFF};
            pg8::gemm_phase<pg8::EpiBf16<1>, pg8::StaticOrder, true, true>(lds + RING_OFF, g, S, E, c.tid);
        }
        SEAM(pb + 6);
        if (IN(pb + 7)) for (int rep_ = 0; rep_ < NREP(7); ++rep_) { REPBAR();
            ArgsP a = get_args(); const Ctx c = fresh_ctx(wave_s);
            pg8::Gemm g{WSP(const bfu, WS_QKV), WSP(const bfu, WS_W2) + (size_t)layer * DM * DFF, M, DM, DFF}; pg8::StaticOrder S; S.init(M, DM, c.G, c.bx);
            pg8::EpiRes E{a->out, rep_ ? WSP(float, WS_OP) : a->out, DM, WSP(const float, WS_MOD) + (size_t)layer * BATCH * NMOD + 5 * DM, NMOD, SEQ};
            pg8::gemm_phase<pg8::EpiRes, pg8::StaticOrder, true, true>(lds + RING_OFF, g, S, E, c.tid);
        }
        SEAM(pb + 7);
    }
#undef IN
#undef SEAM
#undef WSP
#undef REPBAR
}

extern "C" void kernel_launch(void* const* d_in, const int* in_sizes, int n_in, void* d_out, int out_size, void* d_ws, size_t ws_size, hipStream_t stream) {
    static int grid = 0;
    if (grid == 0) {
        if (n_in != 23 || in_sizes[0] != M * DM || out_size != M * DM || ws_size < WS_END) { fprintf(stderr, "kernel_launch: unexpected shapes (n_in %d, in0 %d, out %d, ws %zu); nothing launched\n", n_in, n_in > 0 ? in_sizes[0] : -1, out_size, ws_size); grid = -1; return; }
        int dev = 0, cus = 0, per_cu = 0;
        if (hipGetDevice(&dev) != hipSuccess || hipDeviceGetAttribute(&cus, hipDeviceAttributeMultiprocessorCount, dev) != hipSuccess) { fprintf(stderr, "kernel_launch: hipGetDevice / hipDeviceGetAttribute failed\n"); grid = -1; return; }
        if (hipFuncSetAttribute((const void*)yoco_fwd, hipFuncAttributeMaxDynamicSharedMemorySize, LDS_BYTES) != hipSuccess) { fprintf(stderr, "kernel_launch: hipFuncSetAttribute failed\n"); grid = -1; return; }
        if (hipOccupancyMaxActiveBlocksPerMultiprocessor(&per_cu, (const void*)yoco_fwd, NWAVES * 64, LDS_BYTES) != hipSuccess || per_cu < 1)
            fprintf(stderr, "kernel_launch: note: occupancy query reports %d workgroups per CU\n", per_cu);
        (void)hipGetLastError();
        grid = cus;
    }
    if (grid < 0) return;
    if (hipMemsetAsync((char*)d_ws + WS_CTL, 0, CTL_ZERO_BYTES, stream) != hipSuccess) { fprintf(stderr, "kernel_launch: hipMemsetAsync failed\n"); return; }
    Args ha{};
    ha.x = (const float*)d_in[0]; ha.c = (const float*)d_in[1]; ha.pos = (const int*)d_in[2]; ha.ada_w = (const float*)d_in[3]; ha.ada_b = (const float*)d_in[4]; ha.norm_g = (const float*)d_in[5];
    ha.a_w_qkv = (const float*)d_in[6]; ha.a_q_gain = (const float*)d_in[7]; ha.a_k_gain = (const float*)d_in[8]; ha.a_w_o = (const float*)d_in[9];
    ha.kv_ada_w = (const float*)d_in[10]; ha.kv_ada_b = (const float*)d_in[11]; ha.kv_norm_g = (const float*)d_in[12]; ha.kv_w_k = (const float*)d_in[13]; ha.kv_w_v = (const float*)d_in[14]; ha.kv_k_gain = (const float*)d_in[15];
    ha.b_w_q = (const float*)d_in[16]; ha.b_q_gain = (const float*)d_in[17]; ha.b_lambda = (const float*)d_in[18]; ha.b_subln_g = (const float*)d_in[19]; ha.b_w_o = (const float*)d_in[20];
    ha.mlp_w1 = (const float*)d_in[21]; ha.mlp_w2 = (const float*)d_in[22];
    ha.out = (float*)d_out; ha.ws = (unsigned char*)d_ws;
    for (int j = 0; j < 16; ++j) ha.inv_freq[j] = (float)pow(500000.0, -(double)(2 * j) / 32.0);
    ha.lam_init[0] = (float)(0.8 - 0.6 * exp(-0.3 * 2.0)); ha.lam_init[1] = (float)(0.8 - 0.6 * exp(-0.3 * 3.0));
#if MK_ONE_LAUNCH
    ha.ph_lo = 0; ha.ph_hi = N_PHASE;
    hipLaunchKernelGGL(yoco_fwd, dim3(grid), dim3(NWAVES * 64), LDS_BYTES, stream, ha);
    { const hipError_t le = hipPeekAtLastError(); if (le != hipSuccess) fprintf(stderr, "kernel_launch: launch failed: %s\n", hipGetErrorName(le)); }
#else
    for (int p = 0; p < N_PHASE; ++p) {
        ha.ph_lo = p; ha.ph_hi = p + 1;
        hipLaunchKernelGGL(yoco_fwd, dim3(grid), dim3(NWAVES * 64), LDS_BYTES, stream, ha);
        const hipError_t le = hipPeekAtLastError(); if (le != hipSuccess) { fprintf(stderr, "kernel_launch: launch %d failed: %s\n", p, hipGetErrorName(le)); break; }
    }
#endif
}
```

```cpp
#include <hip/hip_runtime.h>
#include <hip/hip_bf16.h>
#include <cstdio>
#include <cstdint>
#include <cmath>
namespace pg8 {
#define PG8_LAS __attribute__((address_space(3)))
typedef unsigned short bf16_t;
typedef short bf16x8 __attribute__((ext_vector_type(8)));
typedef float f32x4 __attribute__((ext_vector_type(4)));
typedef unsigned u32x4 __attribute__((ext_vector_type(4)));
constexpr int BM = 256, BK = 64, HALF = 128, HTB = HALF * BK * 2  , STAGE_BYTES = 8 * HTB, NXCD = 8, WGM = 8;

__host__ __device__ __forceinline__ int lds_byte(int r, int c) { const int st = (r >> 4) * 2 + (c >> 5), rr = r & 15, cc = c & 31, ob = rr * 64 + cc * 2; return st * 1024 + (ob ^ (((ob >> 9) & 1) << 5)); }
__host__ __device__ __forceinline__ void stage_rc(int b, int& R, int& C) { const int st = b / 1024, sb = b % 1024, swz = sb ^ (((sb >> 9) & 1) << 5); R = (st >> 1) * 16 + swz / 64; C = (st & 1) * 32 + (swz % 64) / 2; }
__host__ __device__ __forceinline__ int perm32(int rho) { const int n = rho >> 4, i = rho & 15; return 8 * (i >> 2) + 4 * n + (i & 3); }

struct Unit { int pm, pn; };
struct Gemm { const bf16_t* A; const bf16_t* Bt; int M, N, K; };

struct StaticOrder {
    int nM, nN, nwg, G, c;
    __host__ __device__ void init(int M, int N, int G_, int c_) { nM = M / BM; nN = N / BM; nwg = nM * nN; G = G_; c = c_; }
    __host__ __device__ bool next(int i, Unit& u) const {
        const long L = (long)i * G + c; if (L >= nwg) return false;
        int wgid = (int)L; { const int q = nwg / NXCD, r = nwg % NXCD, xcd = wgid % NXCD, off = wgid / NXCD; wgid = (xcd < r ? xcd * (q + 1) : r * (q + 1) + (xcd - r) * q) + off; }
        const int nig = WGM * nN, gid = wgid / nig, fm = gid * WGM, gsz = (nM - fm) < WGM ? (nM - fm) : WGM;
        u.pm = fm + ((wgid % nig) % gsz); u.pn = (wgid % nig) / gsz; return true;
    }
    __device__ __forceinline__ void a_ready(const Unit&) const {}
    __device__ __forceinline__ void done(const Unit&) const {}
};


__device__ __forceinline__ unsigned cvt_pk_bf16(float lo, float hi) { unsigned r; asm volatile("v_cvt_pk_bf16_f32 %0, %1, %2" : "=v"(r) : "v"(lo), "v"(hi)); return r; }

template <int ACT  > struct EpiBf16 {
    static constexpr bool PERM = true, AFTER_DRAIN = false;
    bf16_t* O; int ldc;
    __device__ __forceinline__ void operator()(const f32x4 (&acc)[2][2][4][2], const Unit& u, int wr, int wc, int fr, int fq) const {
        const int row0 = u.pm * BM + wr * 64 + fr; const int col0 = u.pn * BM + wc * 32 + 8 * fq;
#pragma unroll
        for (int ai = 0; ai < 2; ++ai)
#pragma unroll
            for (int m = 0; m < 4; ++m) { bf16_t* rowp = O + (size_t)(row0 + ai * HALF + m * 16) * ldc + col0;
#pragma unroll
                for (int bj = 0; bj < 2; ++bj) { f32x4 v0 = acc[ai][bj][m][0], v1 = acc[ai][bj][m][1];
                    if (ACT == 1) {
#pragma unroll
                        for (int e = 0; e < 4; ++e) { const float a = fmaxf(v0[e], 0.f), b = fmaxf(v1[e], 0.f); v0[e] = a * a; v1[e] = b * b; } }
                    u32x4 w; w.x = cvt_pk_bf16(v0[0], v0[1]); w.y = cvt_pk_bf16(v0[2], v0[3]); w.z = cvt_pk_bf16(v1[0], v1[1]); w.w = cvt_pk_bf16(v1[2], v1[3]);
                    *(u32x4*)(rowp + bj * HALF) = w; } }
    }
};

struct EpiRes {
    static constexpr bool PERM = false, AFTER_DRAIN = false;
    const float* base; float* out; int ldc; const float* gate; int gate_bstride; int rows_per_batch;
    __device__ __forceinline__ void operator()(const f32x4 (&acc)[2][2][4][2], const Unit& u, int wr, int wc, int fr, int fq) const {
        const int row0 = u.pm * BM + wr * 64 + fr, col0 = u.pn * BM + wc * 32 + 4 * fq;
        const float* gp = gate + (size_t)((u.pm * BM) / rows_per_batch) * gate_bstride + col0;
        f32x4 gv[2][2];
#pragma unroll
        for (int bj = 0; bj < 2; ++bj)
#pragma unroll
            for (int n = 0; n < 2; ++n) gv[bj][n] = *(const f32x4*)(gp + bj * HALF + n * 16);
#pragma unroll
        for (int ai = 0; ai < 2; ++ai)
#pragma unroll
            for (int m = 0; m < 4; ++m) { const size_t off = (size_t)(row0 + ai * HALF + m * 16) * ldc + col0;
#pragma unroll
                for (int bj = 0; bj < 2; ++bj)
#pragma unroll
                    for (int n = 0; n < 2; ++n) { const f32x4 bs = *(const f32x4*)(base + off + bj * HALF + n * 16);
                        *(f32x4*)(out + off + bj * HALF + n * 16) = bs + gv[bj][n] * acc[ai][bj][m][n]; }
                if (m & 1) asm volatile("" ::: "memory"); }
    }
};

__device__ __forceinline__ float epi_shx(float v, int o, int lane) { return __int_as_float(__builtin_amdgcn_ds_bpermute((lane ^ o) << 2, __float_as_int(v))); }
struct EpiQK {
    static constexpr bool PERM = true, AFTER_DRAIN = false;
    bf16_t* O; int ldc; int kind; const float* gq; const float* gk; const float* cosT; const float* sinT; PG8_LAS float* xch; float eps;
    __device__ __forceinline__ void operator()(const f32x4 (&acc)[2][2][4][2], const Unit& u, int wr, int wc, int fr, int fq) const {
        const int row0 = u.pm * BM + wr * 64 + fr; const int col0 = u.pn * BM + wc * 32 + 8 * fq;
        bool norm; const float* g0; const float* g1;
        if (kind == 0) { const int cb = u.pn * BM, g = cb / 3072, typ = (cb - g * 3072) >> 10; norm = typ < 2; g0 = (typ ? gk : gq) + g * 128; g1 = g0; }
        else if (kind == 1) { norm = u.pn < 8; g0 = gq; g1 = gq + 128; }
        else { norm = true; g0 = gq; g1 = gq + 128; }
        if (!norm) {
#pragma unroll
            for (int ai = 0; ai < 2; ++ai)
#pragma unroll
                for (int m = 0; m < 4; ++m) { bf16_t* rowp = O + (size_t)(row0 + ai * HALF + m * 16) * ldc + col0;
#pragma unroll
                    for (int bj = 0; bj < 2; ++bj) { const f32x4 v0 = acc[ai][bj][m][0], v1 = acc[ai][bj][m][1];
                        u32x4 w; w.x = cvt_pk_bf16(v0[0], v0[1]); w.y = cvt_pk_bf16(v0[2], v0[3]); w.z = cvt_pk_bf16(v1[0], v1[1]); w.w = cvt_pk_bf16(v1[2], v1[3]);
                        *(u32x4*)(rowp + bj * HALF) = w; } }
            return;
        }
        const int lane = fq * 16 + fr;
        const f32x4 ga0 = *(const f32x4*)(g0 + wc * 32 + 8 * fq), ga1 = *(const f32x4*)(g0 + wc * 32 + 8 * fq + 4), gb0 = *(const f32x4*)(g1 + wc * 32 + 8 * fq), gb1 = *(const f32x4*)(g1 + wc * 32 + 8 * fq + 4);
#pragma unroll
        for (int ai = 0; ai < 2; ++ai)
#pragma unroll
            for (int m = 0; m < 4; ++m)
#pragma unroll
                for (int bj = 0; bj < 2; ++bj) { const f32x4 a = acc[ai][bj][m][0], b = acc[ai][bj][m][1];
                    float s = ((a[0] * a[0] + a[1] * a[1]) + (a[2] * a[2] + a[3] * a[3])) + ((b[0] * b[0] + b[1] * b[1]) + (b[2] * b[2] + b[3] * b[3]));
                    s += epi_shx(s, 16, lane); s += epi_shx(s, 32, lane);
                    if (fq == 0) xch[((ai * HALF + wr * 64 + m * 16 + fr) * 2 + bj) * 4 + wc] = s; }
        asm volatile("s_waitcnt lgkmcnt(0)" ::: "memory"); __builtin_amdgcn_s_barrier(); asm volatile("" ::: "memory");
#pragma unroll
        for (int ai = 0; ai < 2; ++ai)
#pragma unroll
            for (int m = 0; m < 4; ++m) { const int rl = ai * HALF + wr * 64 + m * 16 + fr; const size_t grow = (size_t)(u.pm * BM + rl);
                bf16_t* rowp = O + grow * ldc + col0;
                f32x4 c0 = {1.f, 1.f, 1.f, 1.f}, c1 = c0, s0 = {0.f, 0.f, 0.f, 0.f}, s1 = s0;
                if (wc == 0) { const float* cp = cosT + grow * 16 + (fq & 1) * 8; const float* sp = sinT + grow * 16 + (fq & 1) * 8;
                    c0 = *(const f32x4*)cp; c1 = *(const f32x4*)(cp + 4); s0 = *(const f32x4*)sp; s1 = *(const f32x4*)(sp + 4);
                    if (fq < 2) { s0 = -s0; s1 = -s1; } }
#pragma unroll
                for (int bj = 0; bj < 2; ++bj) { const f32x4 p4 = *(const PG8_LAS f32x4*)(xch + (rl * 2 + bj) * 4);
                    const float rstd = 1.0f / sqrtf(((p4[0] + p4[1]) + (p4[2] + p4[3])) * (1.0f / 128.0f) + eps);
                    f32x4 v0 = acc[ai][bj][m][0] * rstd * (bj ? gb0 : ga0), v1 = acc[ai][bj][m][1] * rstd * (bj ? gb1 : ga1);
                    if (wc == 0) { f32x4 q0, q1;
#pragma unroll
                        for (int e = 0; e < 4; ++e) { q0[e] = epi_shx(v0[e], 32, lane); q1[e] = epi_shx(v1[e], 32, lane); }
                        v0 = v0 * c0 + q0 * s0; v1 = v1 * c1 + q1 * s1; }
                    u32x4 w; w.x = cvt_pk_bf16(v0[0], v0[1]); w.y = cvt_pk_bf16(v0[2], v0[3]); w.z = cvt_pk_bf16(v1[0], v1[1]); w.w = cvt_pk_bf16(v1[2], v1[3]);
                    *(u32x4*)(rowp + bj * HALF) = w; }
                if (m & 1) asm volatile("" ::: "memory"); }
    }
};

template <class Epi, class Sched, bool ALIGN_EPI = false, bool SP2 = false>
__device__ __forceinline__ void gemm_phase(PG8_LAS unsigned char* lds, const Gemm g, const Sched& S, const Epi& E, const int tid  ) {
    const int wid = __builtin_amdgcn_readfirstlane(tid >> 6), lane = tid & 63, wr = wid >> 2, wc = wid & 3, fr = lane & 15, fq = lane >> 4;
    const int K = g.K, nt = K / BK;
    unsigned voffA[2], voffB[2];
#pragma unroll
    for (int i = 0; i < 2; ++i) { int R, C; stage_rc(tid * 16 + i * 8192, R, C); const int Rb = Epi::PERM ? ((R & ~31) + perm32(R & 31)) : R;
        voffA[i] = (unsigned)(R * K + C) * 2u; voffB[i] = (unsigned)(Rb * K + C) * 2u; }
    const size_t kstep = (size_t)(BK * 2);
    const size_t hstep = (size_t)HALF * K * 2;
    const size_t tstep = 2 * hstep;
    const unsigned ldsw = (unsigned)wid * 1024u;
    const int aoff = lds_byte(wr * 64 + fr, fq * 8), boff = lds_byte(wc * 32 + fr, fq * 8);
#define PG8_SA(b, h) (((b) * 2 + (h)) * HTB)
#define PG8_SB(b, h) ((4 + (b) * 2 + (h)) * HTB)
#define PG8_STAGE(bufoff, gbase, voff) do { _Pragma("unroll") for (int _i = 0; _i < 2; ++_i) \
        __builtin_amdgcn_global_load_lds((const unsigned*)((const char*)(gbase) + (voff)[_i]), (PG8_LAS unsigned*)(lds + (bufoff) + ldsw + _i * 8192), 16, 0, 0); } while (0)
#define PG8_LDA(dst, b, h) do { _Pragma("unroll") for (int m = 0; m < 4; ++m) _Pragma("unroll") for (int k = 0; k < 2; ++k) dst[m][k] = *(const PG8_LAS bf16x8*)(lds + PG8_SA(b, h) + aoff + m * 2048 + k * 1024); } while (0)
#define PG8_LDB(dst, b, h) do { _Pragma("unroll") for (int n = 0; n < 2; ++n) _Pragma("unroll") for (int k = 0; k < 2; ++k) dst[n][k] = *(const PG8_LAS bf16x8*)(lds + PG8_SB(b, h) + boff + n * 2048 + k * 1024); } while (0)
#define PG8_MMA(ai, bj, At, Bt) do { __builtin_amdgcn_s_setprio(1); _Pragma("unroll") for (int m = 0; m < 4; ++m) _Pragma("unroll") for (int n = 0; n < 2; ++n) _Pragma("unroll") for (int k = 0; k < 2; ++k) \
        acc[ai][bj][m][n] = __builtin_amdgcn_mfma_f32_16x16x32_bf16(Bt[n][k], At[m][k], acc[ai][bj][m][n], 0, 0, 0); __builtin_amdgcn_s_setprio(0); } while (0)
#define PG8_WAIT_V(n) asm volatile("s_waitcnt vmcnt(" #n ")" ::: "memory")
#define PG8_WAIT_L(n) asm volatile("s_waitcnt lgkmcnt(" #n ")" ::: "memory")
#define PG8_BAR __builtin_amdgcn_s_barrier()
#define PG8_SCHED __builtin_amdgcn_sched_barrier(0)
    Unit cur, nxt; int ui = 0;
    if (!S.next(0, cur)) return;
    f32x4 acc[2][2][4][2];
#pragma unroll
    for (int a = 0; a < 2; ++a)
#pragma unroll
        for (int b = 0; b < 2; ++b)
#pragma unroll
            for (int m = 0; m < 4; ++m)
#pragma unroll
                for (int n = 0; n < 2; ++n) acc[a][b][m][n] = (f32x4){0.f, 0.f, 0.f, 0.f};
    bf16x8 At[4][2], B0[2][2], B1[2][2];
    const char* cA = (const char*)g.A + (size_t)cur.pm * tstep; const char* cB = (const char*)g.Bt + (size_t)cur.pn * tstep;
    S.a_ready(cur);
    if constexpr (SP2) {
        PG8_STAGE(PG8_SB(0, 0), cB, voffB); PG8_STAGE(PG8_SB(0, 1), cB + hstep, voffB); PG8_STAGE(PG8_SA(0, 0), cA, voffA); PG8_STAGE(PG8_SA(0, 1), cA + hstep, voffA);
        if (wr == 1) PG8_BAR;
        PG8_WAIT_V(2); PG8_BAR;
        PG8_STAGE(PG8_SB(1, 0), cB + kstep, voffB); PG8_STAGE(PG8_SA(1, 0), cA + kstep, voffA); PG8_STAGE(PG8_SB(1, 1), cB + hstep + kstep, voffB);
        PG8_WAIT_V(6); PG8_BAR;
    } else {
        PG8_STAGE(PG8_SB(0, 0), cB, voffB); PG8_STAGE(PG8_SA(0, 0), cA, voffA); PG8_STAGE(PG8_SB(0, 1), cB + hstep, voffB); PG8_STAGE(PG8_SA(0, 1), cA + hstep, voffA);
        if (wr == 1) PG8_BAR;
        PG8_WAIT_V(4); PG8_BAR;
        PG8_STAGE(PG8_SB(1, 0), cB + kstep, voffB); PG8_STAGE(PG8_SA(1, 0), cA + kstep, voffA); PG8_STAGE(PG8_SB(1, 1), cB + hstep + kstep, voffB);
        PG8_WAIT_V(6); PG8_BAR;
    }
    for (;;) {
        const bool has_next = S.next(ui + 1, nxt);
        const char* nA = has_next ? (const char*)g.A + (size_t)nxt.pm * tstep : cA; const char* nB = has_next ? (const char*)g.Bt + (size_t)nxt.pn * tstep : cB;
        for (int t = 0; t < nt; t += 2) {
            const bool last = (t == nt - 2);
            const char* a1 = cA + (size_t)(t + 1) * kstep;
            const char* a2 = last ? nA : cA + (size_t)(t + 2) * kstep; const char* b2 = last ? nB : cB + (size_t)(t + 2) * kstep;
            const char* a3 = a2 + kstep; const char* b3 = b2 + kstep;
            if (last && has_next) S.a_ready(nxt);
            if constexpr (SP2) {
            PG8_LDB(B0, 0, 0); PG8_LDB(B1, 0, 1); PG8_SCHED; PG8_LDA(At, 0, 0); PG8_STAGE(PG8_SA(1, 1), a1 + hstep, voffA);
            PG8_WAIT_V(8); PG8_WAIT_L(0); PG8_BAR; PG8_MMA(0, 0, At, B0); PG8_MMA(0, 1, At, B1); PG8_BAR; PG8_SCHED;
            PG8_LDA(At, 0, 1); PG8_STAGE(PG8_SB(0, 0), b2, voffB); PG8_STAGE(PG8_SB(0, 1), b2 + hstep, voffB); PG8_STAGE(PG8_SA(0, 0), a2, voffA);
            PG8_WAIT_V(8); PG8_WAIT_L(0); PG8_BAR; PG8_MMA(1, 0, At, B0); PG8_MMA(1, 1, At, B1); PG8_BAR; PG8_SCHED;
            PG8_LDB(B0, 1, 0); PG8_LDB(B1, 1, 1); PG8_SCHED; PG8_LDA(At, 1, 0); PG8_STAGE(PG8_SA(0, 1), a2 + hstep, voffA);
            PG8_WAIT_V(8); PG8_WAIT_L(0); PG8_BAR; PG8_MMA(0, 0, At, B0); PG8_MMA(0, 1, At, B1); PG8_BAR; PG8_SCHED;
            PG8_LDA(At, 1, 1); PG8_STAGE(PG8_SB(1, 0), b3, voffB); PG8_STAGE(PG8_SB(1, 1), b3 + hstep, voffB); PG8_STAGE(PG8_SA(1, 0), a3, voffA);
            PG8_WAIT_V(8); PG8_WAIT_L(0); PG8_BAR; PG8_MMA(1, 0, At, B0); PG8_MMA(1, 1, At, B1); PG8_BAR; PG8_SCHED;
            } else {
            PG8_LDB(B0, 0, 0); PG8_SCHED; PG8_LDA(At, 0, 0); PG8_STAGE(PG8_SA(1, 1), a1 + hstep, voffA);
            PG8_WAIT_L(8); PG8_BAR; PG8_WAIT_L(0); PG8_MMA(0, 0, At, B0); PG8_BAR; PG8_SCHED;
            PG8_LDB(B1, 0, 1); PG8_STAGE(PG8_SB(0, 0), b2, voffB);
            PG8_BAR; PG8_WAIT_L(0); PG8_MMA(0, 1, At, B1); PG8_BAR;
            PG8_LDA(At, 0, 1); PG8_STAGE(PG8_SA(0, 0), a2, voffA);
            PG8_BAR; PG8_WAIT_L(0); PG8_MMA(1, 0, At, B0); PG8_BAR; PG8_SCHED;
            PG8_STAGE(PG8_SB(0, 1), b2 + hstep, voffB);
            PG8_WAIT_V(6); PG8_BAR; PG8_MMA(1, 1, At, B1); PG8_BAR;
            PG8_LDB(B0, 1, 0); PG8_SCHED; PG8_LDA(At, 1, 0); PG8_STAGE(PG8_SA(0, 1), a2 + hstep, voffA);
            PG8_WAIT_L(8); PG8_BAR; PG8_WAIT_L(0); PG8_MMA(0, 0, At, B0); PG8_BAR; PG8_SCHED;
            PG8_LDB(B1, 1, 1); PG8_STAGE(PG8_SB(1, 0), b3, voffB);
            PG8_BAR; PG8_WAIT_L(0); PG8_MMA(0, 1, At, B1); PG8_BAR;
            PG8_LDA(At, 1, 1); PG8_STAGE(PG8_SA(1, 0), a3, voffA);
            PG8_BAR; PG8_WAIT_L(0); PG8_MMA(1, 0, At, B0); PG8_BAR; PG8_SCHED;
            PG8_STAGE(PG8_SB(1, 1), b3 + hstep, voffB);
            PG8_WAIT_V(6); PG8_BAR; PG8_MMA(1, 1, At, B1); PG8_BAR;
            }
        }
        if constexpr (ALIGN_EPI) { if (wr == 0) PG8_BAR; }
        if constexpr (!Epi::AFTER_DRAIN) { E(acc, cur, wr, wc, fr, fq); S.done(cur); }
        if (!has_next) break;
#pragma unroll
        for (int a = 0; a < 2; ++a)
#pragma unroll
            for (int b = 0; b < 2; ++b)
#pragma unroll
                for (int m = 0; m < 4; ++m)
#pragma unroll
                    for (int n = 0; n < 2; ++n) acc[a][b][m][n] = (f32x4){0.f, 0.f, 0.f, 0.f};
        cur = nxt; cA = nA; cB = nB; ++ui;
        if constexpr (ALIGN_EPI) { if (wr == 1) PG8_BAR; }
    }
    PG8_WAIT_V(0);
    if constexpr (!ALIGN_EPI) { if (wr == 0) PG8_BAR; }
    PG8_BAR;
    if constexpr (Epi::AFTER_DRAIN) { E.fused(acc, cur, wr, wc, fr, fq, lds, wid, lane); S.done(cur); }
#undef PG8_SA
#undef PG8_SB
#undef PG8_STAGE
#undef PG8_LDA
#undef PG8_LDB
#undef PG8_MMA
#undef PG8_WAIT_V
#undef PG8_WAIT_L
#undef PG8_BAR
#undef PG8_SCHED
}
}
namespace swa {
using bf16 = __hip_bfloat16;
constexpr int D = 128;
constexpr float SCALE = 0.08838834764831845f;
constexpr float THR = 8.f;
constexpr int NW = 8, QBLK = 32, KVBLK = 64, QB = NW * QBLK;
constexpr int SHM_V = KVBLK * D * 2, SHM_K = KVBLK * D * 2;
constexpr int LDS_BYTES = 2 * SHM_V + 2 * SHM_K + NW * 64 * 4;

typedef short bf16x8 __attribute__((ext_vector_type(8)));
typedef short s16x4 __attribute__((ext_vector_type(4)));
typedef float f32x16 __attribute__((ext_vector_type(16)));
typedef float f32x4 __attribute__((ext_vector_type(4)));
typedef unsigned u32x4 __attribute__((ext_vector_type(4)));

#define KSWZ(row, colB) ((row) * 256 + ((colB) ^ (((row) & 7) << 4)))
#define SBAR() __builtin_amdgcn_sched_barrier(0)
__device__ __forceinline__ int v_st(int k, int c) { const int kk = (k & ~0xC) | ((k & 4) << 1) | ((k & 8) >> 1); return ((kk >> 3) * 4 + (c >> 5)) * 512 + ((kk & 7) * 32 + (c & 31)) * 2; }
__device__ __forceinline__ int v_rd_base(int lane) { return ((lane & 3) << 3) | (((lane >> 2) & 3) << 6) | (((lane >> 4) & 1) << 5) | (((lane >> 5) & 1) << 8); }
constexpr int v_rd_off(int d0, int ks, int half) { return d0 * 512 + ks * 4096 + half * 2048; }
__device__ __forceinline__ int crow(int r, int hi) { return (r & 3) + 8 * (r >> 2) + 4 * hi; }
__device__ __forceinline__ unsigned cvtpk(float lo, float hi) {
    unsigned r; asm volatile("v_cvt_pk_bf16_f32 %0, %1, %2" : "=v"(r) : "v"(lo), "v"(hi)); return r;
}
__device__ __forceinline__ bf16x8 load8(const bf16* p) { return *reinterpret_cast<const bf16x8*>(p); }
__device__ __forceinline__ void mask_tile(f32x16& p0, f32x16& p1, int dq, unsigned W) {
    const float NEG = -__builtin_inff();
    asm volatile("" : "+v"(dq));
#pragma unroll
    for (int r = 0; r < 16; ++r) {
        const int c = (r & 3) + 8 * (r >> 2);
        if ((unsigned)(dq - c) >= W) p0[r] = NEG;
        if ((unsigned)(dq - c - 32) >= W) p1[r] = NEG;
    }
}
__device__ __forceinline__ void partialSM(f32x16& p0, f32x16& p1, float& m_reg, float& mn, float& alpha) {
    float pmax = p0[0]; for (int r = 1; r < 16; ++r) pmax = fmaxf(pmax, p0[r]); for (int r = 0; r < 16; ++r) pmax = fmaxf(pmax, p1[r]);
    { auto rr = __builtin_amdgcn_permlane32_swap(__float_as_uint(pmax), __float_as_uint(pmax), false, false);
      pmax = fmaxf(__uint_as_float(rr[0]), __uint_as_float(rr[1])); }
    constexpr float C2 = 1.4426950408889634f * SCALE;
    if (__builtin_expect(__all((pmax - m_reg) * SCALE <= THR), 1)) { mn = m_reg; alpha = 1.f; }
    else { mn = fmaxf(m_reg, pmax); alpha = __builtin_amdgcn_exp2f((m_reg - mn) * C2); m_reg = mn; }
    const float mnL = -mn * C2;
    for (int r = 0; r < 16; ++r) p0[r] = fmaf(p0[r], C2, mnL); for (int r = 0; r < 16; ++r) p1[r] = fmaf(p1[r], C2, mnL);
    for (int r = 0; r < 16; ++r) p0[r] = __builtin_amdgcn_exp2f(p0[r]);
}
__device__ __forceinline__ void finishSM(f32x16& p0, f32x16& p1, float alpha, float& l_reg, bf16x8& pa0, bf16x8& pa1, bf16x8& pa2, bf16x8& pa3) {
    for (int r = 0; r < 16; ++r) p1[r] = __builtin_amdgcn_exp2f(p1[r]);
    float ps = 0; for (int r = 0; r < 16; ++r) ps += p0[r]; for (int r = 0; r < 16; ++r) ps += p1[r];
    { auto rr = __builtin_amdgcn_permlane32_swap(__float_as_uint(ps), __float_as_uint(ps), false, false);
      ps = __uint_as_float(rr[0]) + __uint_as_float(rr[1]); }
    l_reg = l_reg * alpha + ps;
#define PK4(P, B_, OUT) do { unsigned a0 = cvtpk(P[B_+0], P[B_+1]), a1 = cvtpk(P[B_+2], P[B_+3]);                          \
        unsigned b0 = cvtpk(P[B_+4], P[B_+5]), b1 = cvtpk(P[B_+6], P[B_+7]);                                             \
        auto r0 = __builtin_amdgcn_permlane32_swap(a0, b0, false, false); auto r1 = __builtin_amdgcn_permlane32_swap(a1, b1, false, false); \
        u32x4 w = {r0[0], r1[0], r0[1], r1[1]}; OUT = *reinterpret_cast<bf16x8*>(&w); } while (0)
    PK4(p0, 0, pa0); PK4(p0, 8, pa1); PK4(p1, 0, pa2); PK4(p1, 8, pa3);
#undef PK4
}
template <int KB, bool SK>
__device__ __forceinline__ void qkt(f32x16& p0, f32x16& p1, const char* K_lds, int r32, int hi, const bf16x8* qr, bool act) {
    if (SK && !act) { const float NEG = -__builtin_inff();
#pragma unroll
        for (int r = 0; r < 16; ++r) { p0[r] = NEG; p1[r] = NEG; } return; }
    p0 = f32x16{}; p1 = f32x16{};
    const char* kb[4];
#pragma unroll
    for (int dd = 0; dd < 4; ++dd) kb[dd] = K_lds + KB * SHM_K + KSWZ(r32, (dd * 16 + hi * 8) * 2);
#pragma unroll
    for (int d0 = 0; d0 < 8; ++d0) { const char* a = kb[d0 & 3] + (d0 >> 2) * 128;
        bf16x8 b0 = *reinterpret_cast<const bf16x8*>(a);
        bf16x8 b1 = *reinterpret_cast<const bf16x8*>(a + 32 * 256);
        p0 = __builtin_amdgcn_mfma_f32_32x32x16_bf16(b0, qr[d0], p0, 0, 0, 0);
        p1 = __builtin_amdgcn_mfma_f32_32x32x16_bf16(b1, qr[d0], p1, 0, 0, 0); }
}
template <int VB, bool SK>
__device__ __forceinline__ void pv_tile(f32x16* o, int vb0, bf16x8 pa0, bf16x8 pa1, bf16x8 pa2, bf16x8 pa3, bool act) {
    if (SK && !act) return;
#define TRRD(dst, off) asm volatile("ds_read_b64_tr_b16 %0, %1 offset:%2" : "=&v"(dst) : "v"(vb0), "i"(off) : "memory")
#define PV_D0(d0) do { s16x4 l0, l1, l2, l3, h0, h1, h2, h3; constexpr int b_ = VB * SHM_V + v_rd_off(d0, 0, 0);     \
        TRRD(l0, b_); TRRD(h0, b_ + 2048); TRRD(l1, b_ + 4096); TRRD(h1, b_ + 6144); TRRD(l2, b_ + 8192); TRRD(h2, b_ + 10240); TRRD(l3, b_ + 12288); TRRD(h3, b_ + 14336); \
        asm volatile("s_waitcnt lgkmcnt(0)" ::: "memory"); SBAR();                 \
        o[d0] = __builtin_amdgcn_mfma_f32_32x32x16_bf16(pa0, (bf16x8){l0[0], l0[1], l0[2], l0[3], h0[0], h0[1], h0[2], h0[3]}, o[d0], 0, 0, 0);   \
        o[d0] = __builtin_amdgcn_mfma_f32_32x32x16_bf16(pa1, (bf16x8){l1[0], l1[1], l1[2], l1[3], h1[0], h1[1], h1[2], h1[3]}, o[d0], 0, 0, 0);   \
        o[d0] = __builtin_amdgcn_mfma_f32_32x32x16_bf16(pa2, (bf16x8){l2[0], l2[1], l2[2], l2[3], h2[0], h2[1], h2[2], h2[3]}, o[d0], 0, 0, 0);   \
        o[d0] = __builtin_amdgcn_mfma_f32_32x32x16_bf16(pa3, (bf16x8){l3[0], l3[1], l3[2], l3[3], h3[0], h3[1], h3[2], h3[3]}, o[d0], 0, 0, 0); } while (0)
    PV_D0(0); PV_D0(1); PV_D0(2); PV_D0(3);
#undef PV_D0
#undef TRRD
}

struct BlockRef { const bf16* Q; const bf16* K; const bf16* V; bf16* O; float* L; int qs, kvs, os, ls, P0, skv; };
struct Seam {
    bf16x8 qr[8];
    bf16x8 st_v0, st_v1, st_k0, st_k1;
};
__device__ __forceinline__ int swa_jlo(int P0, int W) { const int lowk = P0 - W + 1; return lowk > 0 ? lowk / KVBLK : 0; }
#define ROWP(p, st, k0) ((p) + (size_t)(k0) * (size_t)(st))
#define VMW() asm volatile("s_waitcnt vmcnt(0)" ::: "memory")
#define VMWN(n) asm volatile("s_waitcnt vmcnt(%0)" :: "i"(n) : "memory")
#define SLOAD_H(Kp, Vp, st, k0) do { const bf16* kp_ = ROWP(Kp, st, k0); const bf16* vp_ = ROWP(Vp, st, k0); const unsigned o0_ = (unsigned)(sr * (st) + sc), o1_ = o0_ + 32u * (unsigned)(st); \
                         S.st_v0 = load8(vp_ + o0_); S.st_v1 = load8(vp_ + o1_); S.st_k0 = load8(kp_ + o0_); S.st_k1 = load8(kp_ + o1_); } while (0)
#define SWRITE_HK(bf) do { *(bf16x8*)(K_lds + (bf) * SHM_K + kws) = S.st_k0; *(bf16x8*)(K_lds + (bf) * SHM_K + kws + 32 * 256) = S.st_k1; } while (0)
#define SWRITE_HV(bf) do { *(bf16x8*)(V_lds + (bf) * SHM_V + vst0) = S.st_v0; *(bf16x8*)(V_lds + (bf) * SHM_V + vst1) = S.st_v1; } while (0)
#define SWRITE_H(bf) do { SWRITE_HV(bf); SWRITE_HK(bf); } while (0)
__device__ __forceinline__ void causal_swa_prime(const BlockRef& cur, int W, char* lds, Seam& S, int tid) {
    const int wid = __builtin_amdgcn_readfirstlane(tid >> 6), lane = tid & 63, r32 = lane & 31, hi = lane >> 5;
    const int sr = tid >> 4, sc = (tid & 15) * 8, kws = KSWZ(sr, sc * 2); char* K_lds = lds + 2 * SHM_V;
    const int kb0 = swa_jlo(cur.P0, W) * KVBLK;
    { const unsigned qo_ = (unsigned)((wid * QBLK + r32) * cur.qs + hi * 8);
    for (int d0 = 0; d0 < 8; ++d0) S.qr[d0] = load8(cur.Q + qo_ + d0 * 16); }
    SLOAD_H(cur.K, cur.V, cur.kvs, kb0); VMW(); SWRITE_HK(0);
    __syncthreads();
}
template <bool WSK>
__device__ __forceinline__ void causal_swa_block(const BlockRef& cur, const BlockRef& nxt, int W, char* lds, Seam& S, int tid) {
    const int wid = __builtin_amdgcn_readfirstlane(tid >> 6), lane = tid & 63, r32 = lane & 31, hi = lane >> 5;
    const int skv = cur.skv;
    const int j_lo = swa_jlo(cur.P0, W);
    int j_hi = (cur.P0 + QB - 1) / KVBLK + 1; if (j_hi > skv / KVBLK) j_hi = skv / KVBLK;
    const int NT = j_hi - j_lo;
    const int kbn = swa_jlo(nxt.P0, W) * KVBLK;
    const int qlo = cur.P0 + wid * QBLK, qm = qlo + r32 - 4 * hi;
    char* V_lds = lds; char* K_lds = lds + 2 * SHM_V;
    float* ws = (float*)(lds + 2 * SHM_V + 2 * SHM_K) + wid * 64; float* li_l = ws, * al_l = ws + 32;
    float m_reg = -1e30f, l_reg = 0; f32x16 o[4] = {};
    const int sr = tid >> 4, sc = (tid & 15) * 8, vst0 = v_st(sr, sc), vst1 = v_st(32 + sr, sc), kws = KSWZ(sr, sc * 2);
    const int vb0 = (int)(uintptr_t)V_lds + v_rd_base(lane);
    const bf16* Kh = cur.K; const bf16* Vh = cur.V; const int kvs = cur.kvs;
#define RESC(a) do { if (__any((a) < 1.f)) { if (hi == 0) al_l[r32] = (a); asm volatile("s_waitcnt lgkmcnt(0)" ::: "memory");              \
                     int h4_ = 4 * hi; asm volatile("" : "+v"(h4_));     \
                     for (int d_ = 0; d_ < 4; ++d_) for (int r = 0; r < 16; ++r) o[d_][r] *= al_l[(r & 3) + 8 * (r >> 2) + h4_]; } } while (0)
#define KBASE(t) ((j_lo + (t)) * KVBLK)
#define ACT(t) (KBASE(t) <= qlo + QBLK - 1 && KBASE(t) + KVBLK - 1 >= qlo - W + 1)
#define MASKT(P0_, P1_, t) do { const int kb_ = KBASE(t); if ((!SK || ACT(t)) && (kb_ + KVBLK - 1 > qlo || kb_ <= qlo + QBLK - 1 - W)) mask_tile(P0_, P1_, qm - kb_, (unsigned)W); } while (0)
    constexpr int NQL = 8;
    constexpr bool SK = WSK;
#define SEAM_K0() do { VMWN(NQL); SWRITE_HK(0); SBAR(); } while (0)
    f32x16 pA0, pA1, pB0, pB1; float mnA, mnB, alA, alB; bf16x8 pa0, pa1, pa2, pa3;
    SWRITE_HV(0); SBAR();
    if (NT > 1) { SLOAD_H(Kh, Vh, kvs, KBASE(1)); }
    SBAR(); qkt<0, SK>(pA0, pA1, K_lds, r32, hi, S.qr, ACT(0));
    MASKT(pA0, pA1, 0); partialSM(pA0, pA1, m_reg, mnA, alA);
    if (NT > 1) { VMW(); SWRITE_H(1); }
    __syncthreads();
#define HALF_STEP(PX0, PX1, mnX, alX, PY0, PY1, alY, t, KB, VB, SB) do {                                                      \
        SBAR(); qkt<KB, SK>(PX0, PX1, K_lds, r32, hi, S.qr, ACT(t));                                             \
        finishSM(PY0, PY1, alY, l_reg, pa0, pa1, pa2, pa3); SBAR();                                                           \
        if ((t) + 1 < NT) { SLOAD_H(Kh, Vh, kvs, KBASE((t) + 1)); SBAR(); }                                               \
        pv_tile<VB, SK>(o, vb0, pa0, pa1, pa2, pa3, ACT((t) - 1)); MASKT(PX0, PX1, (t)); partialSM(PX0, PX1, m_reg, mnX, alX);                                        \
        __syncthreads();                                                                                                      \
        if ((t) + 1 < NT) { VMW(); SWRITE_H(SB); }                                                                          \
        RESC(alX); __syncthreads(); } while (0)
    for (int t = 1; t + 1 < NT; t += 2) {
        HALF_STEP(pB0, pB1, mnB, alB, pA0, pA1, alA, t, 1, 0, 0);
        HALF_STEP(pA0, pA1, mnA, alA, pB0, pB1, alB, t + 1, 0, 1, 1);
    }
    const bool even = (NT & 1) == 0;
    if (even) { SBAR(); qkt<1, SK>(pB0, pB1, K_lds, r32, hi, S.qr, ACT(NT - 1)); SBAR(); }
    { int nkvs_ = nxt.kvs, nqs_ = nxt.qs; asm volatile("" : "+s"(nkvs_), "+s"(nqs_));
      SLOAD_H(nxt.K, nxt.V, nkvs_, kbn); SBAR();
#pragma unroll
        for (int d0 = 0; d0 < 8; ++d0) S.qr[d0] = load8(nxt.Q + (unsigned)((wid * QBLK + r32) * nqs_ + hi * 8) + d0 * 16); }
    SBAR();
    finishSM(pA0, pA1, alA, l_reg, pa0, pa1, pa2, pa3); SBAR();
    pv_tile<0, SK>(o, vb0, pa0, pa1, pa2, pa3, ACT(even ? NT - 2 : NT - 1));
    if (even) { MASKT(pB0, pB1, NT - 1); partialSM(pB0, pB1, m_reg, mnB, alB); __syncthreads(); RESC(alB);
        finishSM(pB0, pB1, alB, l_reg, pa0, pa1, pa2, pa3); SBAR(); pv_tile<1, SK>(o, vb0, pa0, pa1, pa2, pa3, ACT(NT - 1)); }
    SBAR(); SEAM_K0();
    if (hi == 0) li_l[r32] = l_reg; asm volatile("s_waitcnt lgkmcnt(0)" ::: "memory");
    if (cur.L != nullptr && hi == 0) cur.L[(unsigned)((wid * QBLK + r32) * cur.ls)] = m_reg * SCALE + __logf(l_reg);
    float rli[16];
    { int h4_ = 4 * hi; asm volatile("" : "+v"(h4_));
#pragma unroll
    for (int r = 0; r < 16; ++r) rli[r] = __builtin_amdgcn_rcpf(li_l[(r & 3) + 8 * (r >> 2) + h4_]); }
    int os_ = cur.os, hie_ = hi, r32e_ = r32; asm volatile("" : "+s"(os_), "+v"(hie_), "+v"(r32e_));
    bf16* Ow = cur.O + (size_t)(wid * QBLK) * (size_t)os_;
#pragma unroll
    for (int r = 0; r < 16; ++r) { const int orow = crow(r, hie_);
#pragma unroll
        for (int d0 = 0; d0 < 4; ++d0) { const float v = o[d0][r] * rli[r];
            const float vn = __int_as_float(__builtin_amdgcn_mov_dpp(__float_as_int(v), 0xB1, 0xF, 0xF, true));
            if ((r32e_ & 1) == 0) *(unsigned*)(Ow + (unsigned)(orow * os_ + d0 * 32 + r32e_)) = cvtpk(v, vn); } }
    __syncthreads();
#undef RESC
#undef KBASE
#undef ACT
#undef MASKT
#undef SEAM_K0
#undef HALF_STEP
}
#undef ROWP
#undef VMW
#undef VMWN
#undef SLOAD_H
#undef SWRITE_HK
#undef SWRITE_HV
#undef SWRITE_H
#undef KSWZ
#undef SBAR
}
#define GAS __attribute__((address_space(1)))
#define LAS __attribute__((address_space(3)))
typedef unsigned short bf16;
typedef unsigned v4u __attribute__((ext_vector_type(4)));
typedef float f32x4 __attribute__((ext_vector_type(4)));
typedef short bf16x8 __attribute__((ext_vector_type(8)));
typedef GAS unsigned gu32;
typedef GAS unsigned long long gu64;
#define RLX_AGENT __ATOMIC_RELAXED, __HIP_MEMORY_SCOPE_AGENT
#define LDS_WAIT() asm volatile("s_waitcnt lgkmcnt(0)" ::: "memory")
#define VM_WAIT() asm volatile("s_waitcnt vmcnt(0)" ::: "memory")
__device__ __forceinline__ unsigned long long rt() { return __builtin_amdgcn_s_memrealtime(); }
__device__ __forceinline__ unsigned f2bf(float f) { unsigned u = __builtin_bit_cast(unsigned, f); return (u + 0x7fffu + ((u >> 16) & 1u)) >> 16; }
__device__ __forceinline__ unsigned pk2(float lo, float hi) { return f2bf(lo) | (f2bf(hi) << 16); }

#define XB_TMO      128
#define XB_XCNT(j)  (256  + 64 * (j))
#define XB_XSUB(j)  (1280 + 64 * (j))
#define XB_XGEN(j)  (2304 + 64 * (j))
#define XB_TOP      3328
#define XB_TOPGEN   3392
#define XCD_BAR_WORDS 3456
#define XB_SPIN_CAP (1u << 18)

__device__ __forceinline__ unsigned xb_ld(unsigned* p)              { return __hip_atomic_load(p, __ATOMIC_RELAXED, __HIP_MEMORY_SCOPE_AGENT); }
__device__ __forceinline__ unsigned xb_add(unsigned* p, unsigned v) { return __hip_atomic_fetch_add(p, v, __ATOMIC_RELAXED, __HIP_MEMORY_SCOPE_AGENT); }
__device__ __forceinline__ unsigned xb_xcc_id() { return (unsigned)__builtin_amdgcn_s_getreg((3 << 11) | 20) & 0xFu; }
#define XB_SPIN(cond, bar) do { unsigned _sp = 0; while (cond) { __builtin_amdgcn_s_sleep(1); \
    if ((++_sp & 255u) == 0u) { if (xb_ld(&(bar)[XB_TMO])) break; if (_sp > XB_SPIN_CAP) { atomicAdd(&(bar)[XB_TMO], 1u); break; } } } } while (0)

struct XcdBarrier {
    unsigned* bar; unsigned x;
    volatile LAS unsigned* st;
};

__device__ __forceinline__ XcdBarrier xcd_barrier_post(unsigned* bar, volatile LAS unsigned* st, bool leader  ) {
    XcdBarrier b; b.bar = bar; b.x = xb_xcc_id(); b.st = st;
    if (leader) (void)xb_add(&bar[XB_XCNT(b.x)], 1u);
    return b;
}
__device__ __forceinline__ void xcd_barrier_complete(unsigned* bar, unsigned x, unsigned& nloc, unsigned& nx) {
    const unsigned G = gridDim.x * gridDim.y * gridDim.z;
    unsigned sum, cnt, mine, sp = 0u;
    for (;;) {
        sum = 0u; cnt = 0u; mine = 0u;
#pragma unroll
        for (unsigned j = 0; j < 16; ++j) { const unsigned c = xb_ld(&bar[XB_XCNT(j)]); sum += c; cnt += (c > 0u) ? 1u : 0u; mine = (j == x) ? c : mine; }
        if (sum == G) break;
        __builtin_amdgcn_s_sleep(1);
        if ((++sp & 255u) == 0u) { if (xb_ld(&bar[XB_TMO])) break; if (sp > XB_SPIN_CAP) { atomicAdd(&bar[XB_TMO], 1u); break; } }
    }
    nloc = mine > 0u ? mine : 1u; nx = cnt > 0u ? cnt : 1u;
}

__device__ __forceinline__ void xcd_barrier(const XcdBarrier& b, bool leader  ) {
    asm volatile("s_waitcnt vmcnt(0)" ::: "memory");
    __syncthreads();
    if (leader) {
        unsigned* bar = b.bar;
        __builtin_amdgcn_s_waitcnt(0);
        unsigned nloc = b.st[0], nx = b.st[1];
        if (nloc == 0u) { xcd_barrier_complete(bar, b.x, nloc, nx); b.st[0] = nloc; b.st[1] = nx; }
        const unsigned old = xb_add(&bar[XB_XSUB(b.x)], 1u);
        const unsigned gen = old / nloc;
        if (old + 1u == (gen + 1u) * nloc) {
            __builtin_amdgcn_fence(__ATOMIC_RELEASE, "agent");
            asm volatile("s_waitcnt vmcnt(0)" ::: "memory");
            const unsigned og = xb_add(&bar[XB_TOP], 1u);
            const unsigned tg = og / nx;
            if (og + 1u == (tg + 1u) * nx) xb_add(&bar[XB_TOPGEN], 1u);
            else XB_SPIN(xb_ld(&bar[XB_TOPGEN]) == tg, bar);
            __builtin_amdgcn_fence(__ATOMIC_ACQUIRE, "agent");
            xb_add(&bar[XB_XGEN(b.x)], 1u);
            asm volatile("s_waitcnt vmcnt(0)" ::: "memory");
        } else {
            XB_SPIN(xb_ld(&bar[XB_XGEN(b.x)]) == gen, bar);
            __builtin_amdgcn_fence(__ATOMIC_ACQUIRE, "agent");
            asm volatile("s_waitcnt vmcnt(0)" ::: "memory");
        }
    }
    __syncthreads();
}

constexpr int NWAVES = 8;
#ifndef MK_ONE_LAUNCH
#define MK_ONE_LAUNCH 1
#endif

constexpr int BATCH = 4, SEQ = 4096, DM = 2048, M = BATCH * SEQ, HD = 128;
constexpr int NQKV_A = 9216, AGW = 1024, DFF = 8192, NMOD = 6 * DM, NKV = 2 * DM;
constexpr float NORM_EPS = 1e-6f;
constexpr int N_STAGE = 5;
constexpr int N_PHASE = 36;

constexpr size_t MiB = 1u << 20;
constexpr size_t WS_CTL = 0, CTL_ZERO_BYTES = 1 * MiB;
constexpr size_t WS_MOD = 1 * MiB;
constexpr size_t WS_COS = 2 * MiB, WS_SIN = 3 * MiB;
constexpr size_t WS_LA = 4 * MiB;
constexpr size_t WS_MODP = 8 * MiB;
constexpr size_t WS_WQKVA = 40 * MiB;
constexpr size_t WS_WOA = 112 * MiB;
constexpr size_t WS_WKV = 120 * MiB;
constexpr size_t WS_WQB = 136 * MiB;
constexpr size_t WS_WOB = 152 * MiB;
constexpr size_t WS_W1 = 168 * MiB;
constexpr size_t WS_W2 = 296 * MiB;
constexpr size_t WS_H = 424 * MiB;
constexpr size_t WS_AO = 488 * MiB;
constexpr size_t WS_KVB = 552 * MiB;
constexpr size_t WS_QKV = 680 * MiB;
constexpr size_t WS_OP = 968 * MiB;
constexpr size_t WS_END = 1224 * MiB;
constexpr int MOD_TOTAL = 4 * BATCH * NMOD + BATCH * NKV;
constexpr int MOD_KV_OFF = 4 * BATCH * NMOD;
constexpr int GEMV_KC = 32, GEMV_KLEN = DM / GEMV_KC;
constexpr int CW_BAR = 4096;

constexpr int RING_OFF = 0, RING_BYTES = 131072;
constexpr int LDSCTL_OFF = RING_BYTES, MISC_OFF = LDSCTL_OFF + 320;
constexpr int XCH_OFF = RING_BYTES + 1024;
constexpr int LDS_BYTES = 147456;


struct Args {
    const float* x; const float* c; const int* pos; const float* ada_w; const float* ada_b; const float* norm_g;
    const float* a_w_qkv; const float* a_q_gain; const float* a_k_gain; const float* a_w_o;
    const float* kv_ada_w; const float* kv_ada_b; const float* kv_norm_g; const float* kv_w_k; const float* kv_w_v; const float* kv_k_gain;
    const float* b_w_q; const float* b_q_gain; const float* b_lambda; const float* b_subln_g; const float* b_w_o;
    const float* mlp_w1; const float* mlp_w2;
    float* out; unsigned char* ws;
    float inv_freq[16]; float lam_init[2];
    int ph_lo, ph_hi;
};
static_assert(sizeof(Args) == 25 * 8 + 16 * 4 + 2 * 4 + 2 * 4, "Args has no padding bytes");
typedef __attribute__((address_space(4))) const Args* ArgsP;
__device__ __forceinline__ ArgsP get_args() { ArgsP p = (ArgsP)__builtin_amdgcn_kernarg_segment_ptr(); asm volatile("" : "+s"(p)); return p; }
struct Ctx { int tid, lane, wave, G, bx, vcu, gw, NGW; };
__device__ __forceinline__ Ctx fresh_ctx(int wave_s) {
    Ctx c; int ln; asm volatile("v_mbcnt_lo_u32_b32 %0, -1, 0\n\tv_mbcnt_hi_u32_b32 %0, -1, %0" : "=v"(ln));     const int t = wave_s * 64 + ln;
    int G = gridDim.x, bx = blockIdx.x; asm volatile("" : "+s"(G), "+s"(bx));
    c.tid = t; c.lane = t & 63; c.wave = __builtin_amdgcn_readfirstlane(t >> 6); c.G = G; c.bx = bx;
    c.vcu = (G % 8 == 0) ? (bx % 8) * (G / 8) + bx / 8 : bx;
    c.gw = c.vcu * 8 + c.wave; c.NGW = G * 8; return c;
}

typedef unsigned short bfu;
typedef unsigned u32x2 __attribute__((ext_vector_type(2)));

__device__ __forceinline__ float shx(float v, int o, int lane) { return __int_as_float(__builtin_amdgcn_ds_bpermute((lane ^ o) << 2, __float_as_int(v))); }
__device__ __forceinline__ float wave_sum(float v, int lane) {
#pragma unroll
    for (int o = 1; o < 64; o <<= 1) v += shx(v, o, lane);
    return v;
}
__device__ __forceinline__ float bf2f(unsigned bits16) { return __uint_as_float(bits16 << 16); }
__device__ __forceinline__ unsigned pkbf(float lo, float hi) { return pg8::cvt_pk_bf16(lo, hi); }

__device__ __forceinline__ void transpose_item(const float* __restrict__ W, int K, int N, bfu* __restrict__ WT, int item, int lane) {
    const int nb = N >> 6, kb = item / nb, nbi = item - kb * nb, k0 = kb << 6, n0 = nbi << 6;
    const float* src = W + (size_t)k0 * N + n0 + lane;
    float v[64];
#pragma unroll
    for (int i = 0; i < 64; ++i) v[i] = src[(size_t)i * N];
    bfu* dst = WT + (size_t)(n0 + lane) * K + k0;
#pragma unroll
    for (int kk = 0; kk < 8; ++kk) { v4u o; o.x = pkbf(v[8 * kk + 0], v[8 * kk + 1]); o.y = pkbf(v[8 * kk + 2], v[8 * kk + 3]); o.z = pkbf(v[8 * kk + 4], v[8 * kk + 5]); o.w = pkbf(v[8 * kk + 6], v[8 * kk + 7]);
        *(v4u*)(dst + 8 * kk) = o; }
}

__device__ __forceinline__ void p0_prologue(ArgsP a, LAS unsigned char* lds, int tid, int lane, int wave, int vcu, int G) {
    unsigned char* ws = a->ws;
    LAS float* cact = (LAS float*)lds;
    LAS float* ifr = (LAS float*)(lds + 32768);
    for (int i = tid; i < BATCH * DM; i += NWAVES * 64) { const int b = i / DM, k = i - b * DM; const float v = a->c[i]; cact[k * 4 + b] = v / (1.f + expf(-v)); }
    if (tid == 0) {
        ifr[0] = a->inv_freq[0]; ifr[1] = a->inv_freq[1]; ifr[2] = a->inv_freq[2]; ifr[3] = a->inv_freq[3]; ifr[4] = a->inv_freq[4]; ifr[5] = a->inv_freq[5]; ifr[6] = a->inv_freq[6]; ifr[7] = a->inv_freq[7];
        ifr[8] = a->inv_freq[8]; ifr[9] = a->inv_freq[9]; ifr[10] = a->inv_freq[10]; ifr[11] = a->inv_freq[11]; ifr[12] = a->inv_freq[12]; ifr[13] = a->inv_freq[13]; ifr[14] = a->inv_freq[14]; ifr[15] = a->inv_freq[15];
    }
    __syncthreads();
    const int gw = vcu * NWAVES + wave, NGW = G * NWAVES;
    {
        constexpr int ITEMS_L = (NMOD / 256) * GEMV_KC, ITEMS_KV = (NKV / 256) * GEMV_KC, NITEMS = 4 * ITEMS_L + ITEMS_KV;
        float* MODP = (float*)(ws + WS_MODP);
        for (int it = gw; it < NITEMS; it += NGW) {
            const float* W; int N, slab, kc, moff;
            if (it < 4 * ITEMS_L) { const int l = it / ITEMS_L, r = it - l * ITEMS_L; slab = r / GEMV_KC; kc = r - slab * GEMV_KC; W = a->ada_w + (size_t)l * DM * NMOD; N = NMOD; moff = l * BATCH * NMOD; }
            else { const int r = it - 4 * ITEMS_L; slab = r / GEMV_KC; kc = r - slab * GEMV_KC; W = a->kv_ada_w; N = NKV; moff = MOD_KV_OFF; }
            const int n0 = slab * 256 + lane * 4, k0 = kc * GEMV_KLEN;
            f32x4 acc0 = {0.f, 0.f, 0.f, 0.f}, acc1 = acc0, acc2 = acc0, acc3 = acc0;
            const float* wp = W + (size_t)k0 * N + n0;
#pragma unroll 16
            for (int k = 0; k < GEMV_KLEN; ++k) {
                const f32x4 w = *(const f32x4*)(wp + (size_t)k * N);
                const f32x4 cv = *(const LAS f32x4*)(cact + (k0 + k) * 4);
                acc0 += w * cv.x; acc1 += w * cv.y; acc2 += w * cv.z; acc3 += w * cv.w;
            }
            float* mp = MODP + (size_t)kc * MOD_TOTAL + moff + n0;
            *(f32x4*)(mp) = acc0; *(f32x4*)(mp + N) = acc1; *(f32x4*)(mp + 2 * N) = acc2; *(f32x4*)(mp + 3 * N) = acc3;
        }
    }
    {
        float* cosT = (float*)(ws + WS_COS); float* sinT = (float*)(ws + WS_SIN);
        for (int i = vcu * (NWAVES * 64) + tid; i < M * 16; i += G * NWAVES * 64) {
            const int row = i >> 4, j = i & 15; const float ang = (float)a->pos[row] * ifr[j];
            cosT[i] = cosf(ang); sinT[i] = sinf(ang); }
    }
    {
        bfu* WQKVA = (bfu*)(ws + WS_WQKVA); bfu* WOA = (bfu*)(ws + WS_WOA); bfu* WKV = (bfu*)(ws + WS_WKV); bfu* WQB = (bfu*)(ws + WS_WQB); bfu* WOB = (bfu*)(ws + WS_WOB);
        bfu* W1 = (bfu*)(ws + WS_W1); bfu* W2 = (bfu*)(ws + WS_W2);
        constexpr int NT_ITEMS = 49152;
        for (int it = gw; it < NT_ITEMS; it += NGW) {
            int r = it; const float* W; bfu* WT; int K, N, item;
            if (r < 9216) { const int l = r / 4608; W = a->a_w_qkv + (size_t)l * DM * NQKV_A; K = DM; N = NQKV_A; WT = WQKVA + (size_t)l * NQKV_A * DM; item = r - l * 4608; }
            else if ((r -= 9216) < 1024) { const int l = r / 512; W = a->a_w_o + (size_t)l * AGW * DM; K = AGW; N = DM; WT = WOA + (size_t)l * DM * AGW; item = r - l * 512; }
            else if ((r -= 1024) < 1024) { W = a->kv_w_k; K = DM; N = DM; WT = WKV; item = r; }
            else if ((r -= 1024) < 1024) { W = a->kv_w_v; K = DM; N = DM; WT = WKV + (size_t)DM * DM; item = r; }
            else if ((r -= 1024) < 2048) { const int j = r / 1024; W = a->b_w_q + (size_t)j * DM * DM; K = DM; N = DM; WT = WQB + (size_t)j * DM * DM; item = r - j * 1024; }
            else if ((r -= 2048) < 2048) { const int j = r / 1024; W = a->b_w_o + (size_t)j * DM * DM; K = DM; N = DM; WT = WOB + (size_t)j * DM * DM; item = r - j * 1024; }
            else if ((r -= 2048) < 16384) { const int l = r / 4096; W = a->mlp_w1 + (size_t)l * DM * DFF; K = DM; N = DFF; WT = W1 + (size_t)l * DFF * DM; item = r - l * 4096; }
            else { r -= 16384; const int l = r / 4096; W = a->mlp_w2 + (size_t)l * DFF * DM; K = DFF; N = DM; WT = W2 + (size_t)l * DM * DFF; item = r - l * 4096; }
            transpose_item(W, K, N, WT, item, lane);
        }
    }
}

__device__ __forceinline__ void p0b_modreduce(ArgsP a, int tid, int vcu, int G) {
    const float* MODP = (const float*)(a->ws + WS_MODP); float* MOD = (float*)(a->ws + WS_MOD);
    for (int i4 = vcu * (NWAVES * 64) + tid; i4 < MOD_TOTAL / 4; i4 += G * NWAVES * 64) {
        const int i = i4 * 4; f32x4 s;
        if (i < MOD_KV_OFF) { const int l = i / (BATCH * NMOD), n = i % NMOD; s = *(const f32x4*)(a->ada_b + (size_t)l * NMOD + n); }
        else { const int n = (i - MOD_KV_OFF) % NKV; s = *(const f32x4*)(a->kv_ada_b + n); }
#pragma unroll 8
        for (int kc = 0; kc < GEMV_KC; ++kc) s += *(const f32x4*)(MODP + (size_t)kc * MOD_TOTAL + i);
        *(f32x4*)(MOD + i) = s;
    }
}

__device__ __forceinline__ void norm_phase(const float* X, const float* g, const float* shift, const float* scale, int bstride, bfu* H, int lane, int gw, int NGW) {
    for (int rb = gw; rb < M / 8; rb += NGW) {
        const int row0 = rb * 8, b = row0 / SEQ;
        f32x4 gs[8], sh[8];
#pragma unroll
        for (int j = 0; j < 8; ++j) { const int col = 4 * lane + 256 * j;
            const f32x4 gv = *(const f32x4*)(g + col), sc = *(const f32x4*)(scale + (size_t)b * bstride + col);
            gs[j] = gv * (sc + 1.0f); sh[j] = *(const f32x4*)(shift + (size_t)b * bstride + col); }
        for (int r = 0; r < 8; ++r) {
            const float* xr = X + (size_t)(row0 + r) * DM + 4 * lane; f32x4 v[8]; float ss = 0.f;
#pragma unroll
            for (int j = 0; j < 8; ++j) { v[j] = *(const f32x4*)(xr + 256 * j); ss += (v[j].x * v[j].x + v[j].y * v[j].y) + (v[j].z * v[j].z + v[j].w * v[j].w); }
            ss = wave_sum(ss, lane);
            const float rstd = 1.0f / sqrtf(ss * (1.0f / DM) + NORM_EPS);
            bfu* hr = H + (size_t)(row0 + r) * DM + 4 * lane;
#pragma unroll
            for (int j = 0; j < 8; ++j) { const f32x4 o = v[j] * rstd * gs[j] + sh[j]; u32x2 w; w.x = pkbf(o.x, o.y); w.y = pkbf(o.z, o.w); *(u32x2*)(hr + 256 * j) = w; }
        }
    }
}

template <int KIND>
__device__ __forceinline__ void qknorm_phase(bfu* buf, const float* gq, const float* gk, const float* cosT, const float* sinT, int lane, int gw, int NGW) {
    constexpr int NQUAD = KIND == 0 ? 12 : 4; constexpr int LD = KIND == 0 ? NQKV_A : (KIND == 1 ? NKV : DM);
    const int sub = lane & 15, ql = lane >> 4;
    for (int it = gw; it < M * NQUAD; it += NGW) {
        const int row = it / NQUAD, q = it - row * NQUAD; const int j = q * 4 + ql;
        int col; const float* gain;
        if (KIND == 0) { const int g = j >> 4, typ = (j >> 3) & 1, h = j & 7; col = g * 3072 + typ * 1024 + h * 128; gain = (typ ? gk : gq) + g * 128; }
        else { col = j * 128; gain = gq + (j & 1) * 128; }
        bfu* p = buf + (size_t)row * LD + col + sub * 8;
        const v4u raw = *(const v4u*)p;
        float v[8];
        v[0] = bf2f(raw.x & 0xffffu); v[1] = bf2f(raw.x >> 16); v[2] = bf2f(raw.y & 0xffffu); v[3] = bf2f(raw.y >> 16);
        v[4] = bf2f(raw.z & 0xffffu); v[5] = bf2f(raw.z >> 16); v[6] = bf2f(raw.w & 0xffffu); v[7] = bf2f(raw.w >> 16);
        float ss = 0.f;
#pragma unroll
        for (int i = 0; i < 8; ++i) ss += v[i] * v[i];
        ss += shx(ss, 1, lane); ss += shx(ss, 2, lane); ss += shx(ss, 4, lane); ss += shx(ss, 8, lane);
        const float rstd = 1.0f / sqrtf(ss * (1.0f / HD) + NORM_EPS);
        const f32x4 g0 = *(const f32x4*)(gain + sub * 8), g1 = *(const f32x4*)(gain + sub * 8 + 4);
        v[0] *= rstd * g0.x; v[1] *= rstd * g0.y; v[2] *= rstd * g0.z; v[3] *= rstd * g0.w; v[4] *= rstd * g1.x; v[5] *= rstd * g1.y; v[6] *= rstd * g1.z; v[7] *= rstd * g1.w;
        float pv[8];
#pragma unroll
        for (int i = 0; i < 8; ++i) pv[i] = shx(v[i], 2, lane);
        if (sub < 4) {
            const float* cp = cosT + (size_t)row * 16 + (sub & 1) * 8; const float* sp = sinT + (size_t)row * 16 + (sub & 1) * 8;
            const f32x4 c0 = *(const f32x4*)cp, c1 = *(const f32x4*)(cp + 4), s0 = *(const f32x4*)sp, s1 = *(const f32x4*)(sp + 4);
            const float cs[8] = {c0.x, c0.y, c0.z, c0.w, c1.x, c1.y, c1.z, c1.w}; const float sn[8] = {s0.x, s0.y, s0.z, s0.w, s1.x, s1.y, s1.z, s1.w};
            const float sgn = (sub < 2) ? -1.0f : 1.0f;
#pragma unroll
            for (int i = 0; i < 8; ++i) v[i] = v[i] * cs[i] + sgn * pv[i] * sn[i];
        }
        v4u o; o.x = pkbf(v[0], v[1]); o.y = pkbf(v[2], v[3]); o.z = pkbf(v[4], v[5]); o.w = pkbf(v[6], v[7]);
        *(v4u*)p = o;
    }
}

__device__ __forceinline__ f32x4 ld_bf4(const bfu* p) { const u32x2 w = *(const u32x2*)p; return (f32x4){bf2f(w.x & 0xffffu), bf2f(w.x >> 16), bf2f(w.y & 0xffffu), bf2f(w.y >> 16)}; }
__device__ __forceinline__ void combineA_phase(const bfu* OP, const float* LA, bfu* AO, int lane, int gw, int NGW) {
    for (int row = gw; row < M; row += NGW) {
#pragma unroll
        for (int j = 0; j < 4; ++j) { const int col = 4 * lane + 256 * j, h = col >> 7;
            const float l0 = LA[(size_t)row * 8 + h], l1 = LA[(size_t)M * 8 + (size_t)row * 8 + h], l2 = LA[(size_t)2 * M * 8 + (size_t)row * 8 + h];
            const float mx = fmaxf(l0, fmaxf(l1, l2)); const float e0 = expf(l0 - mx), e1 = expf(l1 - mx), e2 = expf(l2 - mx); const float inv = 1.0f / (e0 + e1 + e2);
            const f32x4 o0 = ld_bf4(OP + (size_t)row * AGW + col), o1 = ld_bf4(OP + (size_t)M * AGW + (size_t)row * AGW + col), o2 = ld_bf4(OP + (size_t)2 * M * AGW + (size_t)row * AGW + col);
            const f32x4 o = (o0 * e0 + o1 * e1 + o2 * e2) * inv;
            u32x2 w; w.x = pkbf(o.x, o.y); w.y = pkbf(o.z, o.w); *(u32x2*)(AO + (size_t)row * AGW + col) = w; }
    }
}
__device__ __forceinline__ void combineB_phase(const bfu* OP, const float* lp, const float* subg, float lam_init, bfu* AO, int lane, int gw, int NGW) {
    float s1 = lp[lane] * lp[128 + lane] + lp[64 + lane] * lp[192 + lane], s2 = lp[256 + lane] * lp[384 + lane] + lp[320 + lane] * lp[448 + lane];
    s1 = wave_sum(s1, lane); s2 = wave_sum(s2, lane);
    const float lam = expf(s1) - expf(s2) + lam_init;
    const f32x4 sg = *(const f32x4*)(subg + 4 * lane) * (1.0f - lam_init);
    for (int row = gw; row < M; row += NGW) {
        const bfu* p0 = OP + (size_t)row * DM + 4 * lane; const bfu* p1 = p0 + (size_t)M * DM;
        bfu* ao = AO + (size_t)row * DM + 4 * lane;
#pragma unroll
        for (int j = 0; j < 8; ++j) {
            const f32x4 o = ld_bf4(p0 + 256 * j) - ld_bf4(p1 + 256 * j) * lam;
            float ss = (o.x * o.x + o.y * o.y) + (o.z * o.z + o.w * o.w); ss = wave_sum(ss, lane);
            const float rstd = 1.0f / sqrtf(ss * (1.0f / 256.0f) + NORM_EPS);
            const f32x4 r = o * rstd * sg; u32x2 w; w.x = pkbf(r.x, r.y); w.y = pkbf(r.z, r.w); *(u32x2*)(ao + 256 * j) = w; }
    }
}

__device__ __forceinline__ swa::BlockRef attnA_ref(int L, const bfu* QKV, bfu* OP, float* LA) {
    const int g = L >> 9, rem = L & 511, bh = rem >> 4, sub = rem & 15, dsh = 2 * g, d = 1 << dsh;
    const int r = sub >> (4 - dsh), qb = sub & ((16 >> dsh) - 1), b = bh >> 3, h = bh & 7;
    const size_t tok0 = (size_t)b * SEQ + r, tq = tok0 + (size_t)d * 256 * qb;
    swa::BlockRef R;
    R.Q = (const swa::bf16*)(QKV + tq * NQKV_A + g * 3072 + h * 128);
    R.K = (const swa::bf16*)(QKV + tok0 * NQKV_A + g * 3072 + 1024 + h * 128);
    R.V = (const swa::bf16*)(QKV + tok0 * NQKV_A + g * 3072 + 2048 + h * 128);
    R.O = (swa::bf16*)(OP + (size_t)g * M * AGW + tq * AGW + h * 128); R.L = LA + (size_t)g * M * 8 + tq * 8 + h;
    R.qs = d * NQKV_A; R.kvs = d * NQKV_A; R.os = d * AGW; R.ls = d * 8; R.P0 = 256 * qb; R.skv = SEQ >> dsh;
    return R;
}
__device__ __forceinline__ swa::BlockRef attnB_ref(int I, int pass, const bfu* Qb, const bfu* KVB, bfu* OP) {
    const int bh = I >> 5, slot = I & 31, c = slot >> 4, vh = (slot >> 3) & 1, x = slot & 7, qb = pass ? 15 - x : x, b = bh >> 3, h = bh & 7;
    const size_t tq = (size_t)b * SEQ + 256 * qb;
    swa::BlockRef R;
    R.Q = (const swa::bf16*)(Qb + tq * DM + h * 256 + c * 128);
    R.K = (const swa::bf16*)(KVB + (size_t)b * SEQ * NKV + h * 256 + c * 128);
    R.V = (const swa::bf16*)(KVB + (size_t)b * SEQ * NKV + DM + h * 256 + vh * 128);
    R.O = (swa::bf16*)(OP + (size_t)c * M * DM + tq * DM + h * 256 + vh * 128); R.L = nullptr;
    R.qs = DM; R.kvs = NKV; R.os = DM; R.ls = 0; R.P0 = 256 * qb; R.skv = SEQ;
    return R;
}

__global__ void __launch_bounds__(NWAVES * 64, 2) yoco_fwd(Args args_unused) {
    (void)args_unused;
    extern __shared__ __attribute__((aligned(16))) unsigned char lds_raw[];
    LAS unsigned char* lds = (LAS unsigned char*)lds_raw;
    volatile LAS unsigned* MISC = (volatile LAS unsigned*)(lds + MISC_OFF);
    const int wave_s = __builtin_amdgcn_readfirstlane((int)threadIdx.x >> 6);
    for (int u = threadIdx.x; u < (LDS_BYTES - LDSCTL_OFF) / 4; u += NWAVES * 64) ((LAS unsigned*)(lds + LDSCTL_OFF))[u] = 0u;
    __syncthreads();
    int lo, hi; XcdBarrier bar;
    { ArgsP a = get_args(); const Ctx c = fresh_ctx(wave_s); lo = a->ph_lo; hi = a->ph_hi; unsigned* bw = (unsigned*)(a->ws + WS_CTL) + CW_BAR;
      bar.bar = bw; bar.x = 0; bar.st = nullptr;
      if (hi - lo > 1) bar = xcd_barrier_post(bw, MISC + 8, threadIdx.x == 0); }
#define IN(k) (lo <= (k) && (k) < hi)
#define SEAM(k) do { if (IN(k) && IN((k) + 1)) { XcdBarrier bb_ = bar; { GAS unsigned* gb_ = (GAS unsigned*)bar.bar; asm volatile("" : "+s"(gb_), "+s"(bb_.x)); bb_.bar = (unsigned*)gb_; } const Ctx cb_ = fresh_ctx(wave_s); xcd_barrier(bb_, cb_.tid == 0); } } while (0)
#define WSP(T, off) ((T*)(a->ws + (off)))
#ifndef DUP_MASK
#define DUP_MASK 0
#endif
#define NREP(k) (1 + ((DUP_MASK >> (k)) & 1))
#define REPBAR() do { if (rep_ && hi - lo > 1) { XcdBarrier bb_ = bar; { GAS unsigned* gb_ = (GAS unsigned*)bar.bar; asm volatile("" : "+s"(gb_), "+s"(bb_.x)); bb_.bar = (unsigned*)gb_; } const Ctx cb_ = fresh_ctx(wave_s); xcd_barrier(bb_, cb_.tid == 0); } } while (0)

    if (IN(0)) for (int rep_ = 0; rep_ < NREP(9); ++rep_) { REPBAR(); const Ctx c = fresh_ctx(wave_s); p0_prologue(get_args(), lds, c.tid, c.lane, c.wave, c.vcu, c.G); }
    SEAM(0);
    if (IN(1)) { const Ctx c = fresh_ctx(wave_s); p0b_modreduce(get_args(), c.tid, c.vcu, c.G); }
    SEAM(1);
    if ((DUP_MASK >> 14) & 1) { for (int xb_ = 0; xb_ < 20; ++xb_) { const int rep_ = 1; REPBAR(); } }

    for (int s = 0; s < N_STAGE; ++s) {
        const int kind = (s < 2) ? 0 : (s == 2 ? 1 : 2);
        const int layer = (s < 2) ? s : s - 1;
        const int jb = s - 3;
        const int pb = (s == 0) ? 2 : (s == 1) ? 10 : (s == 2) ? 18 : (s == 3) ? 20 : 28;

        if (IN(pb + 0)) for (int rep_ = 0; rep_ < NREP(0); ++rep_) { REPBAR();
            ArgsP a = get_args(); const Ctx c = fresh_ctx(wave_s); const float* MOD = WSP(const float, WS_MOD); bfu* Hb = WSP(bfu, WS_H);
            if (kind == 1) norm_phase(a->out, a->kv_norm_g, MOD + MOD_KV_OFF, MOD + MOD_KV_OFF + DM, NKV, Hb, c.lane, c.gw, c.NGW);
            else { const float* modl = MOD + (size_t)layer * BATCH * NMOD; norm_phase((s == 0) ? a->x : (const float*)a->out, a->norm_g + (size_t)(layer * 2) * DM, modl, modl + DM, NMOD, Hb, c.lane, c.gw, c.NGW); }
        }
        SEAM(pb + 0);
        if (IN(pb + 1)) for (int rep_ = 0; rep_ < NREP(kind == 0 ? 1 : (kind == 1 ? 12 : 13)); ++rep_) { REPBAR();
            ArgsP a = get_args(); const Ctx c = fresh_ctx(wave_s);
            const bfu* Wt; int N; bfu* O; const float* gq; const float* gk;
            if (kind == 0) { Wt = WSP(const bfu, WS_WQKVA) + (size_t)layer * NQKV_A * DM; N = NQKV_A; O = WSP(bfu, WS_QKV); gq = a->a_q_gain + (size_t)layer * 3 * HD; gk = a->a_k_gain + (size_t)layer * 3 * HD; }
            else if (kind == 1) { Wt = WSP(const bfu, WS_WKV); N = NKV; O = WSP(bfu, WS_KVB); gq = a->kv_k_gain; gk = gq; }
            else { Wt = WSP(const bfu, WS_WQB) + (size_t)jb * DM * DM; N = DM; O = WSP(bfu, WS_QKV); gq = a->b_q_gain + (size_t)jb * 2 * HD; gk = gq; }
            pg8::Gemm g{WSP(const bfu, WS_H), Wt, M, N, DM}; pg8::StaticOrder S; S.init(M, N, c.G, c.bx);
            pg8::EpiQK E{O, N, kind, gq, gk, WSP(const float, WS_COS), WSP(const float, WS_SIN), (LAS float*)(lds + XCH_OFF), NORM_EPS};
            pg8::gemm_phase<pg8::EpiQK, pg8::StaticOrder, true, true>(lds + RING_OFF, g, S, E, c.tid);
        }
        SEAM(pb + 1);
        if (kind == 1) continue;
        if (IN(pb + 2)) for (int rep_ = 0; rep_ < NREP(kind == 0 ? 2 : 10); ++rep_) { REPBAR();
            if (kind == 0) {
                ArgsP a = get_args(); const Ctx c = fresh_ctx(wave_s);
                const bfu* QKV = WSP(const bfu, WS_QKV); bfu* OP = WSP(bfu, WS_OP);
                float* LA = WSP(float, WS_LA);
                const int total = 1536; const int G = c.G; int L = c.bx;
                if (L < total) {
                    swa::BlockRef cur = attnA_ref(L, QKV, OP, LA); swa::Seam SS;
                    swa::causal_swa_prime(cur, 129, (char*)lds_raw, SS, c.tid);
                    for (;;) {
                        const bool more = L + G < total;
                        const swa::BlockRef nxt = more ? attnA_ref(L + G, QKV, OP, LA) : cur;
                        swa::causal_swa_block<true>(cur, nxt, 129, (char*)lds_raw, SS, c.tid);
                        if (!more) break;
                        cur = nxt; L += G;
                    }
                }
            } else {
                ArgsP a = get_args(); const Ctx c = fresh_ctx(wave_s);
                const bfu* QKV = WSP(const bfu, WS_QKV); bfu* OP = WSP(bfu, WS_OP);
                const bfu* KVB = WSP(const bfu, WS_KVB); const int G = c.G, vcu = c.vcu;
                const int nit = (G == 256) ? 4 : (vcu < 1024 ? (1024 - vcu + G - 1) / G : 0);
                int n = 0; const int nblk = 2 * nit;
#define ITEM_OF(i) ((G == 256) ? ((vcu >> 5) * 128 + (i) * 32 + (vcu & 31)) : (vcu + (i) * G))
                if (nblk > 0) {
                    swa::BlockRef cur = attnB_ref(ITEM_OF(0), 0, QKV, KVB, OP); swa::Seam SS;
                    swa::causal_swa_prime(cur, SEQ, (char*)lds_raw, SS, c.tid);
                    for (;;) {
                        const bool more = n + 1 < nblk;
                        const swa::BlockRef nxt = more ? attnB_ref(ITEM_OF((n + 1) >> 1), (n + 1) & 1, QKV, KVB, OP) : cur;
                        swa::causal_swa_block<false>(cur, nxt, SEQ, (char*)lds_raw, SS, c.tid);
                        if (!more) break;
                        cur = nxt; ++n;
                    }
                }
#undef ITEM_OF
            }
        }
        SEAM(pb + 2);
        if (IN(pb + 3)) for (int rep_ = 0; rep_ < NREP(kind == 0 ? 3 : 11); ++rep_) { REPBAR();
            ArgsP a = get_args(); const Ctx c = fresh_ctx(wave_s);
            if (kind == 0) combineA_phase(WSP(const bfu, WS_OP), WSP(const float, WS_LA), WSP(bfu, WS_AO), c.lane, c.gw, c.NGW);
            else combineB_phase(WSP(const bfu, WS_OP), a->b_lambda + (size_t)jb * 4 * HD, a->b_subln_g + (size_t)jb * 256, jb == 0 ? a->lam_init[0] : a->lam_init[1], WSP(bfu, WS_AO), c.lane, c.gw, c.NGW);
        }
        SEAM(pb + 3);
        if (IN(pb + 4)) for (int rep_ = 0; rep_ < NREP(4); ++rep_) { REPBAR();
            ArgsP a = get_args(); const Ctx c = fresh_ctx(wave_s);
            const bfu* Wt; int K;
            if (kind == 0) { Wt = WSP(const bfu, WS_WOA) + (size_t)layer * DM * AGW; K = AGW; }
            else { Wt = WSP(const bfu, WS_WOB) + (size_t)jb * DM * DM; K = DM; }
            pg8::Gemm g{WSP(const bfu, WS_AO), Wt, M, DM, K}; pg8::StaticOrder S; S.init(M, DM, c.G, c.bx);
            pg8::EpiRes E{(s == 0) ? a->x : (const float*)a->out, rep_ ? WSP(float, WS_OP) : a->out, DM, WSP(const float, WS_MOD) + (size_t)layer * BATCH * NMOD + 2 * DM, NMOD, SEQ};
            pg8::gemm_phase<pg8::EpiRes, pg8::StaticOrder, true, true>(lds + RING_OFF, g, S, E, c.tid);
        }
        SEAM(pb + 4);
        if (IN(pb + 5)) for (int rep_ = 0; rep_ < NREP(5); ++rep_) { REPBAR();
            ArgsP a = get_args(); const Ctx c = fresh_ctx(wave_s); const float* modl = WSP(const float, WS_MOD) + (size_t)layer * BATCH * NMOD;
            norm_phase(a->out, a->norm_g + (size_t)(layer * 2 + 1) * DM, modl + 3 * DM, modl + 4 * DM, NMOD, WSP(bfu, WS_H), c.lane, c.gw, c.NGW);
        }
        SEAM(pb + 5);
        if (IN(pb + 6)) for (int rep_ = 0; rep_ < NREP(6); ++rep_) { REPBAR();
            ArgsP a = get_args(); const Ctx c = fresh_ctx(wave_s);
            pg8::Gemm g{WSP(const bfu, WS_H), WSP(const bfu, WS_W1) + (size_t)layer * DFF * DM, M, DFF, DM}; pg8::StaticOrder S; S.init(M, DFF, c.G, c.bx);
            pg8::EpiBf16<1> E{WSP(bfu, WS_QKV), DFF};
            pg8::gemm_phase<pg8::EpiBf16<1>, pg8::StaticOrder, true, true>(lds + RING_OFF, g, S, E, c.tid);
        }
        SEAM(pb + 6);
        if (IN(pb + 7)) for (int rep_ = 0; rep_ < NREP(7); ++rep_) { REPBAR();
            ArgsP a = get_args(); const Ctx c = fresh_ctx(wave_s);
            pg8::Gemm g{WSP(const bfu, WS_QKV), WSP(const bfu, WS_W2) + (size_t)layer * DM * DFF, M, DM, DFF}; pg8::StaticOrder S; S.init(M, DM, c.G, c.bx);
            pg8::EpiRes E{a->out, rep_ ? WSP(float, WS_OP) : a->out, DM, WSP(const float, WS_MOD) + (size_t)layer * BATCH * NMOD + 5 * DM, NMOD, SEQ};
            pg8::gemm_phase<pg8::EpiRes, pg8::StaticOrder, true, true>(lds + RING_OFF, g, S, E, c.tid);
        }
        SEAM(pb + 7);
    }
#undef IN
#undef SEAM
#undef WSP
#undef REPBAR
}

extern "C" void kernel_launch(void* const* d_in, const int* in_sizes, int n_in, void* d_out, int out_size, void* d_ws, size_t ws_size, hipStream_t stream) {
    static int grid = 0;
    if (grid == 0) {
        if (n_in != 23 || in_sizes[0] != M * DM || out_size != M * DM || ws_size < WS_END) { fprintf(stderr, "kernel_launch: unexpected shapes (n_in %d, in0 %d, out %d, ws %zu); nothing launched\n", n_in, n_in > 0 ? in_sizes[0] : -1, out_size, ws_size); grid = -1; return; }
        int dev = 0, cus = 0, per_cu = 0;
        if (hipGetDevice(&dev) != hipSuccess || hipDeviceGetAttribute(&cus, hipDeviceAttributeMultiprocessorCount, dev) != hipSuccess) { fprintf(stderr, "kernel_launch: hipGetDevice / hipDeviceGetAttribute failed\n"); grid = -1; return; }
        if (hipFuncSetAttribute((const void*)yoco_fwd, hipFuncAttributeMaxDynamicSharedMemorySize, LDS_BYTES) != hipSuccess) { fprintf(stderr, "kernel_launch: hipFuncSetAttribute failed\n"); grid = -1; return; }
        if (hipOccupancyMaxActiveBlocksPerMultiprocessor(&per_cu, (const void*)yoco_fwd, NWAVES * 64, LDS_BYTES) != hipSuccess || per_cu < 1)
            fprintf(stderr, "kernel_launch: note: occupancy query reports %d workgroups per CU\n", per_cu);
        (void)hipGetLastError();
        grid = cus;
    }
    if (grid < 0) return;
    if (hipMemsetAsync((char*)d_ws + WS_CTL, 0, CTL_ZERO_BYTES, stream) != hipSuccess) { fprintf(stderr, "kernel_launch: hipMemsetAsync failed\n"); return; }
    Args ha{};
    ha.x = (const float*)d_in[0]; ha.c = (const float*)d_in[1]; ha.pos = (const int*)d_in[2]; ha.ada_w = (const float*)d_in[3]; ha.ada_b = (const float*)d_in[4]; ha.norm_g = (const float*)d_in[5];
    ha.a_w_qkv = (const float*)d_in[6]; ha.a_q_gain = (const float*)d_in[7]; ha.a_k_gain = (const float*)d_in[8]; ha.a_w_o = (const float*)d_in[9];
    ha.kv_ada_w = (const float*)d_in[10]; ha.kv_ada_b = (const float*)d_in[11]; ha.kv_norm_g = (const float*)d_in[12]; ha.kv_w_k = (const float*)d_in[13]; ha.kv_w_v = (const float*)d_in[14]; ha.kv_k_gain = (const float*)d_in[15];
    ha.b_w_q = (const float*)d_in[16]; ha.b_q_gain = (const float*)d_in[17]; ha.b_lambda = (const float*)d_in[18]; ha.b_subln_g = (const float*)d_in[19]; ha.b_w_o = (const float*)d_in[20];
    ha.mlp_w1 = (const float*)d_in[21]; ha.mlp_w2 = (const float*)d_in[22];
    ha.out = (float*)d_out; ha.ws = (unsigned char*)d_ws;
    for (int j = 0; j < 16; ++j) ha.inv_freq[j] = (float)pow(500000.0, -(double)(2 * j) / 32.0);
    ha.lam_init[0] = (float)(0.8 - 0.6 * exp(-0.3 * 2.0)); ha.lam_init[1] = (float)(0.8 - 0.6 * exp(-0.3 * 3.0));
#if MK_ONE_LAUNCH
    ha.ph_lo = 0; ha.ph_hi = N_PHASE;
    hipLaunchKernelGGL(yoco_fwd, dim3(grid), dim3(NWAVES * 64), LDS_BYTES, stream, ha);
    { const hipError_t le = hipPeekAtLastError(); if (le != hipSuccess) fprintf(stderr, "kernel_launch: launch failed: %s\n", hipGetErrorName(le)); }
#else
    for (int p = 0; p < N_PHASE; ++p) {
        ha.ph_lo = p; ha.ph_hi = p + 1;
        hipLaunchKernelGGL(yoco_fwd, dim3(grid), dim3(NWAVES * 64), LDS_BYTES, stream, ha);
        const hipError_t le = hipPeekAtLastError(); if (le != hipSuccess) { fprintf(stderr, "kernel_launch: launch %d failed: %s\n", p, hipGetErrorName(le)); break; }
    }
#endif
}
```

```cpp
#include <hip/hip_runtime.h>
#include <hip/hip_bf16.h>
#include <cstdio>
#include <cstdint>
#include <cmath>
namespace pg8 {
#define PG8_LAS __attribute__((address_space(3)))
typedef unsigned short bf16_t;
typedef short bf16x8 __attribute__((ext_vector_type(8)));
typedef float f32x4 __attribute__((ext_vector_type(4)));
typedef unsigned u32x4 __attribute__((ext_vector_type(4)));
constexpr int BM = 256, BK = 64, HALF = 128, HTB = HALF * BK * 2  , STAGE_BYTES = 8 * HTB, NXCD = 8, WGM = 8;

__host__ __device__ __forceinline__ int lds_byte(int r, int c) { const int st = (r >> 4) * 2 + (c >> 5), rr = r & 15, cc = c & 31, ob = rr * 64 + cc * 2; return st * 1024 + (ob ^ (((ob >> 9) & 1) << 5)); }
__host__ __device__ __forceinline__ void stage_rc(int b, int& R, int& C) { const int st = b / 1024, sb = b % 1024, swz = sb ^ (((sb >> 9) & 1) << 5); R = (st >> 1) * 16 + swz / 64; C = (st & 1) * 32 + (swz % 64) / 2; }
__host__ __device__ __forceinline__ int perm32(int rho) { const int n = rho >> 4, i = rho & 15; return 8 * (i >> 2) + 4 * n + (i & 3); }

struct Unit { int pm, pn; };
struct Gemm { const bf16_t* A; const bf16_t* Bt; int M, N, K; };

struct StaticOrder {
    int nM, nN, nwg, G, c;
    __host__ __device__ void init(int M, int N, int G_, int c_) { nM = M / BM; nN = N / BM; nwg = nM * nN; G = G_; c = c_; }
    __host__ __device__ bool next(int i, Unit& u) const {
        const long L = (long)i * G + c; if (L >= nwg) return false;
        int wgid = (int)L; { const int q = nwg / NXCD, r = nwg % NXCD, xcd = wgid % NXCD, off = wgid / NXCD; wgid = (xcd < r ? xcd * (q + 1) : r * (q + 1) + (xcd - r) * q) + off; }
        const int nig = WGM * nN, gid = wgid / nig, fm = gid * WGM, gsz = (nM - fm) < WGM ? (nM - fm) : WGM;
        u.pm = fm + ((wgid % nig) % gsz); u.pn = (wgid % nig) / gsz; return true;
    }
    __device__ __forceinline__ void a_ready(const Unit&) const {}
    __device__ __forceinline__ void done(const Unit&) const {}
};


__device__ __forceinline__ unsigned cvt_pk_bf16(float lo, float hi) { unsigned r; asm volatile("v_cvt_pk_bf16_f32 %0, %1, %2" : "=v"(r) : "v"(lo), "v"(hi)); return r; }

template <int ACT  > struct EpiBf16 {
    static constexpr bool PERM = true, AFTER_DRAIN = false;
    bf16_t* O; int ldc;
    __device__ __forceinline__ void operator()(const f32x4 (&acc)[2][2][4][2], const Unit& u, int wr, int wc, int fr, int fq) const {
        const int row0 = u.pm * BM + wr * 64 + fr; const int col0 = u.pn * BM + wc * 32 + 8 * fq;
#pragma unroll
        for (int ai = 0; ai < 2; ++ai)
#pragma unroll
            for (int m = 0; m < 4; ++m) { bf16_t* rowp = O + (size_t)(row0 + ai * HALF + m * 16) * ldc + col0;
#pragma unroll
                for (int bj = 0; bj < 2; ++bj) { f32x4 v0 = acc[ai][bj][m][0], v1 = acc[ai][bj][m][1];
                    if (ACT == 1) {
#pragma unroll
                        for (int e = 0; e < 4; ++e) { const float a = fmaxf(v0[e], 0.f), b = fmaxf(v1[e], 0.f); v0[e] = a * a; v1[e] = b * b; } }
                    u32x4 w; w.x = cvt_pk_bf16(v0[0], v0[1]); w.y = cvt_pk_bf16(v0[2], v0[3]); w.z = cvt_pk_bf16(v1[0], v1[1]); w.w = cvt_pk_bf16(v1[2], v1[3]);
                    *(u32x4*)(rowp + bj * HALF) = w; } }
    }
};

struct EpiRes {
    static constexpr bool PERM = false, AFTER_DRAIN = false;
    const float* base; float* out; int ldc; const float* gate; int gate_bstride; int rows_per_batch;
    __device__ __forceinline__ void operator()(const f32x4 (&acc)[2][2][4][2], const Unit& u, int wr, int wc, int fr, int fq) const {
        const int row0 = u.pm * BM + wr * 64 + fr, col0 = u.pn * BM + wc * 32 + 4 * fq;
        const float* gp = gate + (size_t)((u.pm * BM) / rows_per_batch) * gate_bstride + col0;
        f32x4 gv[2][2];
#pragma unroll
        for (int bj = 0; bj < 2; ++bj)
#pragma unroll
            for (int n = 0; n < 2; ++n) gv[bj][n] = *(const f32x4*)(gp + bj * HALF + n * 16);
#pragma unroll
        for (int ai = 0; ai < 2; ++ai)
#pragma unroll
            for (int m = 0; m < 4; ++m) { const size_t off = (size_t)(row0 + ai * HALF + m * 16) * ldc + col0;
#pragma unroll
                for (int bj = 0; bj < 2; ++bj)
#pragma unroll
                    for (int n = 0; n < 2; ++n) { const f32x4 bs = *(const f32x4*)(base + off + bj * HALF + n * 16);
                        *(f32x4*)(out + off + bj * HALF + n * 16) = bs + gv[bj][n] * acc[ai][bj][m][n]; }
                if (m & 1) asm volatile("" ::: "memory"); }
    }
};

__device__ __forceinline__ float epi_shx(float v, int o, int lane) { return __int_as_float(__builtin_amdgcn_ds_bpermute((lane ^ o) << 2, __float_as_int(v))); }
struct EpiQK {
    static constexpr bool PERM = true, AFTER_DRAIN = false;
    bf16_t* O; int ldc; int kind; const float* gq; const float* gk; const float* cosT; const float* sinT; PG8_LAS float* xch; float eps;
    __device__ __forceinline__ void operator()(const f32x4 (&acc)[2][2][4][2], const Unit& u, int wr, int wc, int fr, int fq) const {
        const int row0 = u.pm * BM + wr * 64 + fr; const int col0 = u.pn * BM + wc * 32 + 8 * fq;
        bool norm; const float* g0; const float* g1;
        if (kind == 0) { const int cb = u.pn * BM, g = cb / 3072, typ = (cb - g * 3072) >> 10; norm = typ < 2; g0 = (typ ? gk : gq) + g * 128; g1 = g0; }
        else if (kind == 1) { norm = u.pn < 8; g0 = gq; g1 = gq + 128; }
        else { norm = true; g0 = gq; g1 = gq + 128; }
        if (!norm) {
#pragma unroll
            for (int ai = 0; ai < 2; ++ai)
#pragma unroll
                for (int m = 0; m < 4; ++m) { bf16_t* rowp = O + (size_t)(row0 + ai * HALF + m * 16) * ldc + col0;
#pragma unroll
                    for (int bj = 0; bj < 2; ++bj) { const f32x4 v0 = acc[ai][bj][m][0], v1 = acc[ai][bj][m][1];
                        u32x4 w; w.x = cvt_pk_bf16(v0[0], v0[1]); w.y = cvt_pk_bf16(v0[2], v0[3]); w.z = cvt_pk_bf16(v1[0], v1[1]); w.w = cvt_pk_bf16(v1[2], v1[3]);
                        *(u32x4*)(rowp + bj * HALF) = w; } }
            return;
        }
        const int lane = fq * 16 + fr;
        const f32x4 ga0 = *(const f32x4*)(g0 + wc * 32 + 8 * fq), ga1 = *(const f32x4*)(g0 + wc * 32 + 8 * fq + 4), gb0 = *(const f32x4*)(g1 + wc * 32 + 8 * fq), gb1 = *(const f32x4*)(g1 + wc * 32 + 8 * fq + 4);
#pragma unroll
        for (int ai = 0; ai < 2; ++ai)
#pragma unroll
            for (int m = 0; m < 4; ++m)
#pragma unroll
                for (int bj = 0; bj < 2; ++bj) { const f32x4 a = acc[ai][bj][m][0], b = acc[ai][bj][m][1];
                    float s = ((a[0] * a[0] + a[1] * a[1]) + (a[2] * a[2] + a[3] * a[3])) + ((b[0] * b[0] + b[1] * b[1]) + (b[2] * b[2] + b[3] * b[3]));
                    s += epi_shx(s, 16, lane); s += epi_shx(s, 32, lane);
                    if (fq == 0) xch[((ai * HALF + wr * 64 + m * 16 + fr) * 2 + bj) * 4 + wc] = s; }
        asm volatile("s_waitcnt lgkmcnt(0)" ::: "memory"); __builtin_amdgcn_s_barrier(); asm volatile("" ::: "memory");
#pragma unroll
        for (int ai = 0; ai < 2; ++ai)
#pragma unroll
            for (int m = 0; m < 4; ++m) { const int rl = ai * HALF + wr * 64 + m * 16 + fr; const size_t grow = (size_t)(u.pm * BM + rl);
                bf16_t* rowp = O + grow * ldc + col0;
                f32x4 c0 = {1.f, 1.f, 1.f, 1.f}, c1 = c0, s0 = {0.f, 0.f, 0.f, 0.f}, s1 = s0;
                if (wc == 0) { const float* cp = cosT + grow * 16 + (fq & 1) * 8; const float* sp = sinT + grow * 16 + (fq & 1) * 8;
                    c0 = *(const f32x4*)cp; c1 = *(const f32x4*)(cp + 4); s0 = *(const f32x4*)sp; s1 = *(const f32x4*)(sp + 4);
                    if (fq < 2) { s0 = -s0; s1 = -s1; } }
#pragma unroll
                for (int bj = 0; bj < 2; ++bj) { const f32x4 p4 = *(const PG8_LAS f32x4*)(xch + (rl * 2 + bj) * 4);
                    const float rstd = 1.0f / sqrtf(((p4[0] + p4[1]) + (p4[2] + p4[3])) * (1.0f / 128.0f) + eps);
                    f32x4 v0 = acc[ai][bj][m][0] * rstd * (bj ? gb0 : ga0), v1 = acc[ai][bj][m][1] * rstd * (bj ? gb1 : ga1);
                    if (wc == 0) { f32x4 q0, q1;
#pragma unroll
                        for (int e = 0; e < 4; ++e) { q0[e] = epi_shx(v0[e], 32, lane); q1[e] = epi_shx(v1[e], 32, lane); }
                        v0 = v0 * c0 + q0 * s0; v1 = v1 * c1 + q1 * s1; }
                    u32x4 w; w.x = cvt_pk_bf16(v0[0], v0[1]); w.y = cvt_pk_bf16(v0[2], v0[3]); w.z = cvt_pk_bf16(v1[0], v1[1]); w.w = cvt_pk_bf16(v1[2], v1[3]);
                    *(u32x4*)(rowp + bj * HALF) = w; }
                if (m & 1) asm volatile("" ::: "memory"); }
    }
};

template <class Epi, class Sched, bool ALIGN_EPI = false, bool SP2 = false>
__device__ __forceinline__ void gemm_phase(PG8_LAS unsigned char* lds, const Gemm g, const Sched& S, const Epi& E, const int tid  ) {
    const int wid = __builtin_amdgcn_readfirstlane(tid >> 6), lane = tid & 63, wr = wid >> 2, wc = wid & 3, fr = lane & 15, fq = lane >> 4;
    const int K = g.K, nt = K / BK;
    unsigned voffA[2], voffB[2];
#pragma unroll
    for (int i = 0; i < 2; ++i) { int R, C; stage_rc(tid * 16 + i * 8192, R, C); const int Rb = Epi::PERM ? ((R & ~31) + perm32(R & 31)) : R;
        voffA[i] = (unsigned)(R * K + C) * 2u; voffB[i] = (unsigned)(Rb * K + C) * 2u; }
    const size_t kstep = (size_t)(BK * 2);
    const size_t hstep = (size_t)HALF * K * 2;
    const size_t tstep = 2 * hstep;
    const unsigned ldsw = (unsigned)wid * 1024u;
    const int aoff = lds_byte(wr * 64 + fr, fq * 8), boff = lds_byte(wc * 32 + fr, fq * 8);
#define PG8_SA(b, h) (((b) * 2 + (h)) * HTB)
#define PG8_SB(b, h) ((4 + (b) * 2 + (h)) * HTB)
#define PG8_STAGE(bufoff, gbase, voff) do { _Pragma("unroll") for (int _i = 0; _i < 2; ++_i) \
        __builtin_amdgcn_global_load_lds((const unsigned*)((const char*)(gbase) + (voff)[_i]), (PG8_LAS unsigned*)(lds + (bufoff) + ldsw + _i * 8192), 16, 0, 0); } while (0)
#define PG8_LDA(dst, b, h) do { _Pragma("unroll") for (int m = 0; m < 4; ++m) _Pragma("unroll") for (int k = 0; k < 2; ++k) dst[m][k] = *(const PG8_LAS bf16x8*)(lds + PG8_SA(b, h) + aoff + m * 2048 + k * 1024); } while (0)
#define PG8_LDB(dst, b, h) do { _Pragma("unroll") for (int n = 0; n < 2; ++n) _Pragma("unroll") for (int k = 0; k < 2; ++k) dst[n][k] = *(const PG8_LAS bf16x8*)(lds + PG8_SB(b, h) + boff + n * 2048 + k * 1024); } while (0)
#define PG8_MMA(ai, bj, At, Bt) do { __builtin_amdgcn_s_setprio(1); _Pragma("unroll") for (int m = 0; m < 4; ++m) _Pragma("unroll") for (int n = 0; n < 2; ++n) _Pragma("unroll") for (int k = 0; k < 2; ++k) \
        acc[ai][bj][m][n] = __builtin_amdgcn_mfma_f32_16x16x32_bf16(Bt[n][k], At[m][k], acc[ai][bj][m][n], 0, 0, 0); __builtin_amdgcn_s_setprio(0); } while (0)
#define PG8_WAIT_V(n) asm volatile("s_waitcnt vmcnt(" #n ")" ::: "memory")
#define PG8_WAIT_L(n) asm volatile("s_waitcnt lgkmcnt(" #n ")" ::: "memory")
#define PG8_BAR __builtin_amdgcn_s_barrier()
#define PG8_SCHED __builtin_amdgcn_sched_barrier(0)
    Unit cur, nxt; int ui = 0;
    if (!S.next(0, cur)) return;
    f32x4 acc[2][2][4][2];
#pragma unroll
    for (int a = 0; a < 2; ++a)
#pragma unroll
        for (int b = 0; b < 2; ++b)
#pragma unroll
            for (int m = 0; m < 4; ++m)
#pragma unroll
                for (int n = 0; n < 2; ++n) acc[a][b][m][n] = (f32x4){0.f, 0.f, 0.f, 0.f};
    bf16x8 At[4][2], B0[2][2], B1[2][2];
    const char* cA = (const char*)g.A + (size_t)cur.pm * tstep; const char* cB = (const char*)g.Bt + (size_t)cur.pn * tstep;
    S.a_ready(cur);
    if constexpr (SP2) {
        PG8_STAGE(PG8_SB(0, 0), cB, voffB); PG8_STAGE(PG8_SB(0, 1), cB + hstep, voffB); PG8_STAGE(PG8_SA(0, 0), cA, voffA); PG8_STAGE(PG8_SA(0, 1), cA + hstep, voffA);
        if (wr == 1) PG8_BAR;
        PG8_WAIT_V(2); PG8_BAR;
        PG8_STAGE(PG8_SB(1, 0), cB + kstep, voffB); PG8_STAGE(PG8_SA(1, 0), cA + kstep, voffA); PG8_STAGE(PG8_SB(1, 1), cB + hstep + kstep, voffB);
        PG8_WAIT_V(6); PG8_BAR;
    } else {
        PG8_STAGE(PG8_SB(0, 0), cB, voffB); PG8_STAGE(PG8_SA(0, 0), cA, voffA); PG8_STAGE(PG8_SB(0, 1), cB + hstep, voffB); PG8_STAGE(PG8_SA(0, 1), cA + hstep, voffA);
        if (wr == 1) PG8_BAR;
        PG8_WAIT_V(4); PG8_BAR;
        PG8_STAGE(PG8_SB(1, 0), cB + kstep, voffB); PG8_STAGE(PG8_SA(1, 0), cA + kstep, voffA); PG8_STAGE(PG8_SB(1, 1), cB + hstep + kstep, voffB);
        PG8_WAIT_V(6); PG8_BAR;
    }
    for (;;) {
        const bool has_next = S.next(ui + 1, nxt);
        const char* nA = has_next ? (const char*)g.A + (size_t)nxt.pm * tstep : cA; const char* nB = has_next ? (const char*)g.Bt + (size_t)nxt.pn * tstep : cB;
        for (int t = 0; t < nt; t += 2) {
            const bool last = (t == nt - 2);
            const char* a1 = cA + (size_t)(t + 1) * kstep;
            const char* a2 = last ? nA : cA + (size_t)(t + 2) * kstep; const char* b2 = last ? nB : cB + (size_t)(t + 2) * kstep;
            const char* a3 = a2 + kstep; const char* b3 = b2 + kstep;
            if (last && has_next) S.a_ready(nxt);
            if constexpr (SP2) {
            PG8_LDB(B0, 0, 0); PG8_LDB(B1, 0, 1); PG8_SCHED; PG8_LDA(At, 0, 0); PG8_STAGE(PG8_SA(1, 1), a1 + hstep, voffA);
            PG8_WAIT_V(8); PG8_WAIT_L(0); PG8_BAR; PG8_MMA(0, 0, At, B0); PG8_MMA(0, 1, At, B1); PG8_BAR; PG8_SCHED;
            PG8_LDA(At, 0, 1); PG8_STAGE(PG8_SB(0, 0), b2, voffB); PG8_STAGE(PG8_SB(0, 1), b2 + hstep, voffB); PG8_STAGE(PG8_SA(0, 0), a2, voffA);
            PG8_WAIT_V(8); PG8_WAIT_L(0); PG8_BAR; PG8_MMA(1, 0, At, B0); PG8_MMA(1, 1, At, B1); PG8_BAR; PG8_SCHED;
            PG8_LDB(B0, 1, 0); PG8_LDB(B1, 1, 1); PG8_SCHED; PG8_LDA(At, 1, 0); PG8_STAGE(PG8_SA(0, 1), a2 + hstep, voffA);
            PG8_WAIT_V(8); PG8_WAIT_L(0); PG8_BAR; PG8_MMA(0, 0, At, B0); PG8_MMA(0, 1, At, B1); PG8_BAR; PG8_SCHED;
            PG8_LDA(At, 1, 1); PG8_STAGE(PG8_SB(1, 0), b3, voffB); PG8_STAGE(PG8_SB(1, 1), b3 + hstep, voffB); PG8_STAGE(PG8_SA(1, 0), a3, voffA);
            PG8_WAIT_V(8); PG8_WAIT_L(0); PG8_BAR; PG8_MMA(1, 0, At, B0); PG8_MMA(1, 1, At, B1); PG8_BAR; PG8_SCHED;
            } else {
            PG8_LDB(B0, 0, 0); PG8_SCHED; PG8_LDA(At, 0, 0); PG8_STAGE(PG8_SA(1, 1), a1 + hstep, voffA);
            PG8_WAIT_L(8); PG8_BAR; PG8_WAIT_L(0); PG8_MMA(0, 0, At, B0); PG8_BAR; PG8_SCHED;
            PG8_LDB(B1, 0, 1); PG8_STAGE(PG8_SB(0, 0), b2, voffB);
            PG8_BAR; PG8_WAIT_L(0); PG8_MMA(0, 1, At, B1); PG8_BAR;
            PG8_LDA(At, 0, 1); PG8_STAGE(PG8_SA(0, 0), a2, voffA);
            PG8_BAR; PG8_WAIT_L(0); PG8_MMA(1, 0, At, B0); PG8_BAR; PG8_SCHED;
            PG8_STAGE(PG8_SB(0, 1), b2 + hstep, voffB);
            PG8_WAIT_V(6); PG8_BAR; PG8_MMA(1, 1, At, B1); PG8_BAR;
            PG8_LDB(B0, 1, 0); PG8_SCHED; PG8_LDA(At, 1, 0); PG8_STAGE(PG8_SA(0, 1), a2 + hstep, voffA);
            PG8_WAIT_L(8); PG8_BAR; PG8_WAIT_L(0); PG8_MMA(0, 0, At, B0); PG8_BAR; PG8_SCHED;
            PG8_LDB(B1, 1, 1); PG8_STAGE(PG8_SB(1, 0), b3, voffB);
            PG8_BAR; PG8_WAIT_L(0); PG8_MMA(0, 1, At, B1); PG8_BAR;
            PG8_LDA(At, 1, 1); PG8_STAGE(PG8_SA(1, 0), a3, voffA);
            PG8_BAR; PG8_WAIT_L(0); PG8_MMA(1, 0, At, B0); PG8_BAR; PG8_SCHED;
            PG8_STAGE(PG8_SB(1, 1), b3 + hstep, voffB);
            PG8_WAIT_V(6); PG8_BAR; PG8_MMA(1, 1, At, B1); PG8_BAR;
            }
        }
        if constexpr (ALIGN_EPI) { if (wr == 0) PG8_BAR; }
        if constexpr (!Epi::AFTER_DRAIN) { E(acc, cur, wr, wc, fr, fq); S.done(cur); }
        if (!has_next) break;
#pragma unroll
        for (int a = 0; a < 2; ++a)
#pragma unroll
            for (int b = 0; b < 2; ++b)
#pragma unroll
                for (int m = 0; m < 4; ++m)
#pragma unroll
                    for (int n = 0; n < 2; ++n) acc[a][b][m][n] = (f32x4){0.f, 0.f, 0.f, 0.f};
        cur = nxt; cA = nA; cB = nB; ++ui;
        if constexpr (ALIGN_EPI) { if (wr == 1) PG8_BAR; }
    }
    PG8_WAIT_V(0);
    if constexpr (!ALIGN_EPI) { if (wr == 0) PG8_BAR; }
    PG8_BAR;
    if constexpr (Epi::AFTER_DRAIN) { E.fused(acc, cur, wr, wc, fr, fq, lds, wid, lane); S.done(cur); }
#undef PG8_SA
#undef PG8_SB
#undef PG8_STAGE
#undef PG8_LDA
#undef PG8_LDB
#undef PG8_MMA
#undef PG8_WAIT_V
#undef PG8_WAIT_L
#undef PG8_BAR
#undef PG8_SCHED
}
}
namespace swa {
using bf16 = __hip_bfloat16;
constexpr int D = 128;
constexpr float SCALE = 0.08838834764831845f;
constexpr float THR = 8.f;
constexpr int NW = 8, QBLK = 32, KVBLK = 64, QB = NW * QBLK;
constexpr int SHM_V = KVBLK * D * 2, SHM_K = KVBLK * D * 2;
constexpr int LDS_BYTES = 2 * SHM_V + 2 * SHM_K + NW * 64 * 4;

typedef short bf16x8 __attribute__((ext_vector_type(8)));
typedef short s16x4 __attribute__((ext_vector_type(4)));
typedef float f32x16 __attribute__((ext_vector_type(16)));
typedef float f32x4 __attribute__((ext_vector_type(4)));
typedef unsigned u32x4 __attribute__((ext_vector_type(4)));

#define KSWZ(row, colB) ((row) * 256 + ((colB) ^ (((row) & 7) << 4)))
#define SBAR() __builtin_amdgcn_sched_barrier(0)
__device__ __forceinline__ int v_st(int k, int c) { const int kk = (k & ~0xC) | ((k & 4) << 1) | ((k & 8) >> 1); return ((kk >> 3) * 4 + (c >> 5)) * 512 + ((kk & 7) * 32 + (c & 31)) * 2; }
__device__ __forceinline__ int v_rd_base(int lane) { return ((lane & 3) << 3) | (((lane >> 2) & 3) << 6) | (((lane >> 4) & 1) << 5) | (((lane >> 5) & 1) << 8); }
constexpr int v_rd_off(int d0, int ks, int half) { return d0 * 512 + ks * 4096 + half * 2048; }
__device__ __forceinline__ int crow(int r, int hi) { return (r & 3) + 8 * (r >> 2) + 4 * hi; }
__device__ __forceinline__ unsigned cvtpk(float lo, float hi) {
    unsigned r; asm volatile("v_cvt_pk_bf16_f32 %0, %1, %2" : "=v"(r) : "v"(lo), "v"(hi)); return r;
}
__device__ __forceinline__ bf16x8 load8(const bf16* p) { return *reinterpret_cast<const bf16x8*>(p); }
__device__ __forceinline__ void mask_tile(f32x16& p0, f32x16& p1, int dq, unsigned W) {
    const float NEG = -__builtin_inff();
    asm volatile("" : "+v"(dq));
#pragma unroll
    for (int r = 0; r < 16; ++r) {
        const int c = (r & 3) + 8 * (r >> 2);
        if ((unsigned)(dq - c) >= W) p0[r] = NEG;
        if ((unsigned)(dq - c - 32) >= W) p1[r] = NEG;
    }
}
__device__ __forceinline__ void partialSM(f32x16& p0, f32x16& p1, float& m_reg, float& mn, float& alpha) {
    float pmax = p0[0]; for (int r = 1; r < 16; ++r) pmax = fmaxf(pmax, p0[r]); for (int r = 0; r < 16; ++r) pmax = fmaxf(pmax, p1[r]);
    { auto rr = __builtin_amdgcn_permlane32_swap(__float_as_uint(pmax), __float_as_uint(pmax), false, false);
      pmax = fmaxf(__uint_as_float(rr[0]), __uint_as_float(rr[1])); }
    constexpr float C2 = 1.4426950408889634f * SCALE;
    if (__builtin_expect(__all((pmax - m_reg) * SCALE <= THR), 1)) { mn = m_reg; alpha = 1.f; }
    else { mn = fmaxf(m_reg, pmax); alpha = __builtin_amdgcn_exp2f((m_reg - mn) * C2); m_reg = mn; }
    const float mnL = -mn * C2;
    for (int r = 0; r < 16; ++r) p0[r] = fmaf(p0[r], C2, mnL); for (int r = 0; r < 16; ++r) p1[r] = fmaf(p1[r], C2, mnL);
    for (int r = 0; r < 16; ++r) p0[r] = __builtin_amdgcn_exp2f(p0[r]);
}
__device__ __forceinline__ void finishSM(f32x16& p0, f32x16& p1, float alpha, float& l_reg, bf16x8& pa0, bf16x8& pa1, bf16x8& pa2, bf16x8& pa3) {
    for (int r = 0; r < 16; ++r) p1[r] = __builtin_amdgcn_exp2f(p1[r]);
    float ps = 0; for (int r = 0; r < 16; ++r) ps += p0[r]; for (int r = 0; r < 16; ++r) ps += p1[r];
    { auto rr = __builtin_amdgcn_permlane32_swap(__float_as_uint(ps), __float_as_uint(ps), false, false);
      ps = __uint_as_float(rr[0]) + __uint_as_float(rr[1]); }
    l_reg = l_reg * alpha + ps;
#define PK4(P, B_, OUT) do { unsigned a0 = cvtpk(P[B_+0], P[B_+1]), a1 = cvtpk(P[B_+2], P[B_+3]);                          \
        unsigned b0 = cvtpk(P[B_+4], P[B_+5]), b1 = cvtpk(P[B_+6], P[B_+7]);                                             \
        auto r0 = __builtin_amdgcn_permlane32_swap(a0, b0, false, false); auto r1 = __builtin_amdgcn_permlane32_swap(a1, b1, false, false); \
        u32x4 w = {r0[0], r1[0], r0[1], r1[1]}; OUT = *reinterpret_cast<bf16x8*>(&w); } while (0)
    PK4(p0, 0, pa0); PK4(p0, 8, pa1); PK4(p1, 0, pa2); PK4(p1, 8, pa3);
#undef PK4
}
template <int KB, bool SK>
__device__ __forceinline__ void qkt(f32x16& p0, f32x16& p1, const char* K_lds, int r32, int hi, const bf16x8* qr, bool act) {
    if (SK && !act) { const float NEG = -__builtin_inff();
#pragma unroll
        for (int r = 0; r < 16; ++r) { p0[r] = NEG; p1[r] = NEG; } return; }
    p0 = f32x16{}; p1 = f32x16{};
    const char* kb[4];
#pragma unroll
    for (int dd = 0; dd < 4; ++dd) kb[dd] = K_lds + KB * SHM_K + KSWZ(r32, (dd * 16 + hi * 8) * 2);
#pragma unroll
    for (int d0 = 0; d0 < 8; ++d0) { const char* a = kb[d0 & 3] + (d0 >> 2) * 128;
        bf16x8 b0 = *reinterpret_cast<const bf16x8*>(a);
        bf16x8 b1 = *reinterpret_cast<const bf16x8*>(a + 32 * 256);
        p0 = __builtin_amdgcn_mfma_f32_32x32x16_bf16(b0, qr[d0], p0, 0, 0, 0);
        p1 = __builtin_amdgcn_mfma_f32_32x32x16_bf16(b1, qr[d0], p1, 0, 0, 0); }
}
template <int VB, bool SK>
__device__ __forceinline__ void pv_tile(f32x16* o, int vb0, bf16x8 pa0, bf16x8 pa1, bf16x8 pa2, bf16x8 pa3, bool act) {
    if (SK && !act) return;
#define TRRD(dst, off) asm volatile("ds_read_b64_tr_b16 %0, %1 offset:%2" : "=&v"(dst) : "v"(vb0), "i"(off) : "memory")
#define PV_D0(d0) do { s16x4 l0, l1, l2, l3, h0, h1, h2, h3; constexpr int b_ = VB * SHM_V + v_rd_off(d0, 0, 0);     \
        TRRD(l0, b_); TRRD(h0, b_ + 2048); TRRD(l1, b_ + 4096); TRRD(h1, b_ + 6144); TRRD(l2, b_ + 8192); TRRD(h2, b_ + 10240); TRRD(l3, b_ + 12288); TRRD(h3, b_ + 14336); \
        asm volatile("s_waitcnt lgkmcnt(0)" ::: "memory"); SBAR();                 \
        o[d0] = __builtin_amdgcn_mfma_f32_32x32x16_bf16(pa0, (bf16x8){l0[0], l0[1], l0[2], l0[3], h0[0], h0[1], h0[2], h0[3]}, o[d0], 0, 0, 0);   \
        o[d0] = __builtin_amdgcn_mfma_f32_32x32x16_bf16(pa1, (bf16x8){l1[0], l1[1], l1[2], l1[3], h1[0], h1[1], h1[2], h1[3]}, o[d0], 0, 0, 0);   \
        o[d0] = __builtin_amdgcn_mfma_f32_32x32x16_bf16(pa2, (bf16x8){l2[0], l2[1], l2[2], l2[3], h2[0], h2[1], h2[2], h2[3]}, o[d0], 0, 0, 0);   \
        o[d0] = __builtin_amdgcn_mfma_f32_32x32x16_bf16(pa3, (bf16x8){l3[0], l3[1], l3[2], l3[3], h3[0], h3[1], h3[2], h3[3]}, o[d0], 0, 0, 0); } while (0)
    PV_D0(0); PV_D0(1); PV_D0(2); PV_D0(3);
#undef PV_D0
#undef TRRD
}

struct BlockRef { const bf16* Q; const bf16* K; const bf16* V; bf16* O; float* L; int qs, kvs, os, ls, P0, skv; };
struct Seam {
    bf16x8 qr[8];
    bf16x8 st_v0, st_v1, st_k0, st_k1;
};
__device__ __forceinline__ int swa_jlo(int P0, int W) { const int lowk = P0 - W + 1; return lowk > 0 ? lowk / KVBLK : 0; }
#define ROWP(p, st, k0) ((p) + (size_t)(k0) * (size_t)(st))
#define VMW() asm volatile("s_waitcnt vmcnt(0)" ::: "memory")
#define VMWN(n) asm volatile("s_waitcnt vmcnt(%0)" :: "i"(n) : "memory")
#define SLOAD_H(Kp, Vp, st, k0) do { const bf16* kp_ = ROWP(Kp, st, k0); const bf16* vp_ = ROWP(Vp, st, k0); const unsigned o0_ = (unsigned)(sr * (st) + sc), o1_ = o0_ + 32u * (unsigned)(st); \
                         S.st_v0 = load8(vp_ + o0_); S.st_v1 = load8(vp_ + o1_); S.st_k0 = load8(kp_ + o0_); S.st_k1 = load8(kp_ + o1_); } while (0)
#define SWRITE_HK(bf) do { *(bf16x8*)(K_lds + (bf) * SHM_K + kws) = S.st_k0; *(bf16x8*)(K_lds + (bf) * SHM_K + kws + 32 * 256) = S.st_k1; } while (0)
#define SWRITE_HV(bf) do { *(bf16x8*)(V_lds + (bf) * SHM_V + vst0) = S.st_v0; *(bf16x8*)(V_lds + (bf) * SHM_V + vst1) = S.st_v1; } while (0)
#define SWRITE_H(bf) do { SWRITE_HV(bf); SWRITE_HK(bf); } while (0)
__device__ __forceinline__ void causal_swa_prime(const BlockRef& cur, int W, char* lds, Seam& S, int tid) {
    const int wid = __builtin_amdgcn_readfirstlane(tid >> 6), lane = tid & 63, r32 = lane & 31, hi = lane >> 5;
    const int sr = tid >> 4, sc = (tid & 15) * 8, kws = KSWZ(sr, sc * 2); char* K_lds = lds + 2 * SHM_V;
    const int kb0 = swa_jlo(cur.P0, W) * KVBLK;
    { const unsigned qo_ = (unsigned)((wid * QBLK + r32) * cur.qs + hi * 8);
    for (int d0 = 0; d0 < 8; ++d0) S.qr[d0] = load8(cur.Q + qo_ + d0 * 16); }
    SLOAD_H(cur.K, cur.V, cur.kvs, kb0); VMW(); SWRITE_HK(0);
    __syncthreads();
}
template <bool WSK>
__device__ __forceinline__ void causal_swa_block(const BlockRef& cur, const BlockRef& nxt, int W, char* lds, Seam& S, int tid) {
    const int wid = __builtin_amdgcn_readfirstlane(tid >> 6), lane = tid & 63, r32 = lane & 31, hi = lane >> 5;
    const int skv = cur.skv;
    const int j_lo = swa_jlo(cur.P0, W);
    int j_hi = (cur.P0 + QB - 1) / KVBLK + 1; if (j_hi > skv / KVBLK) j_hi = skv / KVBLK;
    const int NT = j_hi - j_lo;
    const int kbn = swa_jlo(nxt.P0, W) * KVBLK;
    const int qlo = cur.P0 + wid * QBLK, qm = qlo + r32 - 4 * hi;
    char* V_lds = lds; char* K_lds = lds + 2 * SHM_V;
    float* ws = (float*)(lds + 2 * SHM_V + 2 * SHM_K) + wid * 64; float* li_l = ws, * al_l = ws + 32;
    float m_reg = -1e30f, l_reg = 0; f32x16 o[4] = {};
    const int sr = tid >> 4, sc = (tid & 15) * 8, vst0 = v_st(sr, sc), vst1 = v_st(32 + sr, sc), kws = KSWZ(sr, sc * 2);
    const int vb0 = (int)(uintptr_t)V_lds + v_rd_base(lane);
    const bf16* Kh = cur.K; const bf16* Vh = cur.V; const int kvs = cur.kvs;
#define RESC(a) do { if (__any((a) < 1.f)) { if (hi == 0) al_l[r32] = (a); asm volatile("s_waitcnt lgkmcnt(0)" ::: "memory");              \
                     int h4_ = 4 * hi; asm volatile("" : "+v"(h4_));     \
                     for (int d_ = 0; d_ < 4; ++d_) for (int r = 0; r < 16; ++r) o[d_][r] *= al_l[(r & 3) + 8 * (r >> 2) + h4_]; } } while (0)
#define KBASE(t) ((j_lo + (t)) * KVBLK)
#define ACT(t) (KBASE(t) <= qlo + QBLK - 1 && KBASE(t) + KVBLK - 1 >= qlo - W + 1)
#define MASKT(P0_, P1_, t) do { const int kb_ = KBASE(t); if ((!SK || ACT(t)) && (kb_ + KVBLK - 1 > qlo || kb_ <= qlo + QBLK - 1 - W)) mask_tile(P0_, P1_, qm - kb_, (unsigned)W); } while (0)
    constexpr int NQL = 8;
    constexpr bool SK = WSK;
#define SEAM_K0() do { VMWN(NQL); SWRITE_HK(0); SBAR(); } while (0)
    f32x16 pA0, pA1, pB0, pB1; float mnA, mnB, alA, alB; bf16x8 pa0, pa1, pa2, pa3;
    SWRITE_HV(0); SBAR();
    if (NT > 1) { SLOAD_H(Kh, Vh, kvs, KBASE(1)); }
    SBAR(); qkt<0, SK>(pA0, pA1, K_lds, r32, hi, S.qr, ACT(0));
    MASKT(pA0, pA1, 0); partialSM(pA0, pA1, m_reg, mnA, alA);
    if (NT > 1) { VMW(); SWRITE_H(1); }
    __syncthreads();
#define HALF_STEP(PX0, PX1, mnX, alX, PY0, PY1, alY, t, KB, VB, SB) do {                                                      \
        SBAR(); qkt<KB, SK>(PX0, PX1, K_lds, r32, hi, S.qr, ACT(t));                                             \
        finishSM(PY0, PY1, alY, l_reg, pa0, pa1, pa2, pa3); SBAR();                                                           \
        if ((t) + 1 < NT) { SLOAD_H(Kh, Vh, kvs, KBASE((t) + 1)); SBAR(); }                                               \
        pv_tile<VB, SK>(o, vb0, pa0, pa1, pa2, pa3, ACT((t) - 1)); MASKT(PX0, PX1, (t)); partialSM(PX0, PX1, m_reg, mnX, alX);                                        \
        __syncthreads();                                                                                                      \
        if ((t) + 1 < NT) { VMW(); SWRITE_H(SB); }                                                                          \
        RESC(alX); __syncthreads(); } while (0)
    for (int t = 1; t + 1 < NT; t += 2) {
        HALF_STEP(pB0, pB1, mnB, alB, pA0, pA1, alA, t, 1, 0, 0);
        HALF_STEP(pA0, pA1, mnA, alA, pB0, pB1, alB, t + 1, 0, 1, 1);
    }
    const bool even = (NT & 1) == 0;
    if (even) { SBAR(); qkt<1, SK>(pB0, pB1, K_lds, r32, hi, S.qr, ACT(NT - 1)); SBAR(); }
    { int nkvs_ = nxt.kvs, nqs_ = nxt.qs; asm volatile("" : "+s"(nkvs_), "+s"(nqs_));
      SLOAD_H(nxt.K, nxt.V, nkvs_, kbn); SBAR();
#pragma unroll
        for (int d0 = 0; d0 < 8; ++d0) S.qr[d0] = load8(nxt.Q + (unsigned)((wid * QBLK + r32) * nqs_ + hi * 8) + d0 * 16); }
    SBAR();
    finishSM(pA0, pA1, alA, l_reg, pa0, pa1, pa2, pa3); SBAR();
    pv_tile<0, SK>(o, vb0, pa0, pa1, pa2, pa3, ACT(even ? NT - 2 : NT - 1));
    if (even) { MASKT(pB0, pB1, NT - 1); partialSM(pB0, pB1, m_reg, mnB, alB); __syncthreads(); RESC(alB);
        finishSM(pB0, pB1, alB, l_reg, pa0, pa1, pa2, pa3); SBAR(); pv_tile<1, SK>(o, vb0, pa0, pa1, pa2, pa3, ACT(NT - 1)); }
    SBAR(); SEAM_K0();
    if (hi == 0) li_l[r32] = l_reg; asm volatile("s_waitcnt lgkmcnt(0)" ::: "memory");
    if (cur.L != nullptr && hi == 0) cur.L[(unsigned)((wid * QBLK + r32) * cur.ls)] = m_reg * SCALE + __logf(l_reg);
    float rli[16];
    { int h4_ = 4 * hi; asm volatile("" : "+v"(h4_));
#pragma unroll
    for (int r = 0; r < 16; ++r) rli[r] = __builtin_amdgcn_rcpf(li_l[(r & 3) + 8 * (r >> 2) + h4_]); }
    int os_ = cur.os, hie_ = hi, r32e_ = r32; asm volatile("" : "+s"(os_), "+v"(hie_), "+v"(r32e_));
    bf16* Ow = cur.O + (size_t)(wid * QBLK) * (size_t)os_;
#pragma unroll
    for (int r = 0; r < 16; ++r) { const int orow = crow(r, hie_);
#pragma unroll
        for (int d0 = 0; d0 < 4; ++d0) { const float v = o[d0][r] * rli[r];
            const float vn = __int_as_float(__builtin_amdgcn_mov_dpp(__float_as_int(v), 0xB1, 0xF, 0xF, true));
            if ((r32e_ & 1) == 0) *(unsigned*)(Ow + (unsigned)(orow * os_ + d0 * 32 + r32e_)) = cvtpk(v, vn); } }
    __syncthreads();
#undef RESC
#undef KBASE
#undef ACT
#undef MASKT
#undef SEAM_K0
#undef HALF_STEP
}
#undef ROWP
#undef VMW
#undef VMWN
#undef SLOAD_H
#undef SWRITE_HK
#undef SWRITE_HV
#undef SWRITE_H
#undef KSWZ
#undef SBAR
}
#define GAS __attribute__((address_space(1)))
#define LAS __attribute__((address_space(3)))
typedef unsigned short bf16;
typedef unsigned v4u __attribute__((ext_vector_type(4)));
typedef float f32x4 __attribute__((ext_vector_type(4)));
typedef short bf16x8 __attribute__((ext_vector_type(8)));
typedef GAS unsigned gu32;
typedef GAS unsigned long long gu64;
#define RLX_AGENT __ATOMIC_RELAXED, __HIP_MEMORY_SCOPE_AGENT
#define LDS_WAIT() asm volatile("s_waitcnt lgkmcnt(0)" ::: "memory")
#define VM_WAIT() asm volatile("s_waitcnt vmcnt(0)" ::: "memory")
__device__ __forceinline__ unsigned long long rt() { return __builtin_amdgcn_s_memrealtime(); }
__device__ __forceinline__ unsigned f2bf(float f) { unsigned u = __builtin_bit_cast(unsigned, f); return (u + 0x7fffu + ((u >> 16) & 1u)) >> 16; }
__device__ __forceinline__ unsigned pk2(float lo, float hi) { return f2bf(lo) | (f2bf(hi) << 16); }

#define XB_TMO      128
#define XB_XCNT(j)  (256  + 64 * (j))
#define XB_XSUB(j)  (1280 + 64 * (j))
#define XB_XGEN(j)  (2304 + 64 * (j))
#define XB_TOP      3328
#define XB_TOPGEN   3392
#define XCD_BAR_WORDS 3456
#define XB_SPIN_CAP (1u << 18)

__device__ __forceinline__ unsigned xb_ld(unsigned* p)              { return __hip_atomic_load(p, __ATOMIC_RELAXED, __HIP_MEMORY_SCOPE_AGENT); }
__device__ __forceinline__ unsigned xb_add(unsigned* p, unsigned v) { return __hip_atomic_fetch_add(p, v, __ATOMIC_RELAXED, __HIP_MEMORY_SCOPE_AGENT); }
__device__ __forceinline__ unsigned xb_xcc_id() { return (unsigned)__builtin_amdgcn_s_getreg((3 << 11) | 20) & 0xFu; }
#define XB_SPIN(cond, bar) do { unsigned _sp = 0; while (cond) { __builtin_amdgcn_s_sleep(1); \
    if ((++_sp & 255u) == 0u) { if (xb_ld(&(bar)[XB_TMO])) break; if (_sp > XB_SPIN_CAP) { atomicAdd(&(bar)[XB_TMO], 1u); break; } } } } while (0)

struct XcdBarrier {
    unsigned* bar; unsigned x;
    volatile LAS unsigned* st;
};

__device__ __forceinline__ XcdBarrier xcd_barrier_post(unsigned* bar, volatile LAS unsigned* st, bool leader  ) {
    XcdBarrier b; b.bar = bar; b.x = xb_xcc_id(); b.st = st;
    if (leader) (void)xb_add(&bar[XB_XCNT(b.x)], 1u);
    return b;
}
__device__ __forceinline__ void xcd_barrier_complete(unsigned* bar, unsigned x, unsigned& nloc, unsigned& nx) {
    const unsigned G = gridDim.x * gridDim.y * gridDim.z;
    unsigned sum, cnt, mine, sp = 0u;
    for (;;) {
        sum = 0u; cnt = 0u; mine = 0u;
#pragma unroll
        for (unsigned j = 0; j < 16; ++j) { const unsigned c = xb_ld(&bar[XB_XCNT(j)]); sum += c; cnt += (c > 0u) ? 1u : 0u; mine = (j == x) ? c : mine; }
        if (sum == G) break;
        __builtin_amdgcn_s_sleep(1);
        if ((++sp & 255u) == 0u) { if (xb_ld(&bar[XB_TMO])) break; if (sp > XB_SPIN_CAP) { atomicAdd(&bar[XB_TMO], 1u); break; } }
    }
    nloc = mine > 0u ? mine : 1u; nx = cnt > 0u ? cnt : 1u;
}

__device__ __forceinline__ void xcd_barrier(const XcdBarrier& b, bool leader  ) {
    asm volatile("s_waitcnt vmcnt(0)" ::: "memory");
    __syncthreads();
    if (leader) {
        unsigned* bar = b.bar;
        __builtin_amdgcn_s_waitcnt(0);
        unsigned nloc = b.st[0], nx = b.st[1];
        if (nloc == 0u) { xcd_barrier_complete(bar, b.x, nloc, nx); b.st[0] = nloc; b.st[1] = nx; }
        const unsigned old = xb_add(&bar[XB_XSUB(b.x)], 1u);
        const unsigned gen = old / nloc;
        if (old + 1u == (gen + 1u) * nloc) {
            __builtin_amdgcn_fence(__ATOMIC_RELEASE, "agent");
            asm volatile("s_waitcnt vmcnt(0)" ::: "memory");
            const unsigned og = xb_add(&bar[XB_TOP], 1u);
            const unsigned tg = og / nx;
            if (og + 1u == (tg + 1u) * nx) xb_add(&bar[XB_TOPGEN], 1u);
            else XB_SPIN(xb_ld(&bar[XB_TOPGEN]) == tg, bar);
            __builtin_amdgcn_fence(__ATOMIC_ACQUIRE, "agent");
            xb_add(&bar[XB_XGEN(b.x)], 1u);
            asm volatile("s_waitcnt vmcnt(0)" ::: "memory");
        } else {
            XB_SPIN(xb_ld(&bar[XB_XGEN(b.x)]) == gen, bar);
            __builtin_amdgcn_fence(__ATOMIC_ACQUIRE, "agent");
            asm volatile("s_waitcnt vmcnt(0)" ::: "memory");
        }
    }
    __syncthreads();
}

constexpr int NWAVES = 8;
#ifndef MK_ONE_LAUNCH
#define MK_ONE_LAUNCH 1
#endif

constexpr int BATCH = 4, SEQ = 4096, DM = 2048, M = BATCH * SEQ, HD = 128;
constexpr int NQKV_A = 9216, AGW = 1024, DFF = 8192, NMOD = 6 * DM, NKV = 2 * DM;
constexpr float NORM_EPS = 1e-6f;
constexpr int N_STAGE = 5;
constexpr int N_PHASE = 36;

constexpr size_t MiB = 1u << 20;
constexpr size_t WS_CTL = 0, CTL_ZERO_BYTES = 1 * MiB;
constexpr size_t WS_MOD = 1 * MiB;
constexpr size_t WS_COS = 2 * MiB, WS_SIN = 3 * MiB;
constexpr size_t WS_LA = 4 * MiB;
constexpr size_t WS_MODP = 8 * MiB;
constexpr size_t WS_WQKVA = 40 * MiB;
constexpr size_t WS_WOA = 112 * MiB;
constexpr size_t WS_WKV = 120 * MiB;
constexpr size_t WS_WQB = 136 * MiB;
constexpr size_t WS_WOB = 152 * MiB;
constexpr size_t WS_W1 = 168 * MiB;
constexpr size_t WS_W2 = 296 * MiB;
constexpr size_t WS_H = 424 * MiB;
constexpr size_t WS_AO = 488 * MiB;
constexpr size_t WS_KVB = 552 * MiB;
constexpr size_t WS_QKV = 680 * MiB;
constexpr size_t WS_OP = 968 * MiB;
constexpr size_t WS_END = 1224 * MiB;
constexpr int MOD_TOTAL = 4 * BATCH * NMOD + BATCH * NKV;
constexpr int MOD_KV_OFF = 4 * BATCH * NMOD;
constexpr int GEMV_KC = 32, GEMV_KLEN = DM / GEMV_KC;
constexpr int CW_BAR = 4096;

constexpr int RING_OFF = 0, RING_BYTES = 131072;
constexpr int LDSCTL_OFF = RING_BYTES, MISC_OFF = LDSCTL_OFF + 320;
constexpr int XCH_OFF = RING_BYTES + 1024;
constexpr int LDS_BYTES = 147456;


struct Args {
    const float* x; const float* c; const int* pos; const float* ada_w; const float* ada_b; const float* norm_g;
    const float* a_w_qkv; const float* a_q_gain; const float* a_k_gain; const float* a_w_o;
    const float* kv_ada_w; const float* kv_ada_b; const float* kv_norm_g; const float* kv_w_k; const float* kv_w_v; const float* kv_k_gain;
    const float* b_w_q; const float* b_q_gain; const float* b_lambda; const float* b_subln_g; const float* b_w_o;
    const float* mlp_w1; const float* mlp_w2;
    float* out; unsigned char* ws;
    float inv_freq[16]; float lam_init[2];
    int ph_lo, ph_hi;
};
static_assert(sizeof(Args) == 25 * 8 + 16 * 4 + 2 * 4 + 2 * 4, "Args has no padding bytes");
typedef __attribute__((address_space(4))) const Args* ArgsP;
__device__ __forceinline__ ArgsP get_args() { ArgsP p = (ArgsP)__builtin_amdgcn_kernarg_segment_ptr(); asm volatile("" : "+s"(p)); return p; }
struct Ctx { int tid, lane, wave, G, bx, vcu, gw, NGW; };
__device__ __forceinline__ Ctx fresh_ctx(int wave_s) {
    Ctx c; int ln; asm volatile("v_mbcnt_lo_u32_b32 %0, -1, 0\n\tv_mbcnt_hi_u32_b32 %0, -1, %0" : "=v"(ln));     const int t = wave_s * 64 + ln;
    int G = gridDim.x, bx = blockIdx.x; asm volatile("" : "+s"(G), "+s"(bx));
    c.tid = t; c.lane = t & 63; c.wave = __builtin_amdgcn_readfirstlane(t >> 6); c.G = G; c.bx = bx;
    c.vcu = (G % 8 == 0) ? (bx % 8) * (G / 8) + bx / 8 : bx;
    c.gw = c.vcu * 8 + c.wave; c.NGW = G * 8; return c;
}

typedef unsigned short bfu;
typedef unsigned u32x2 __attribute__((ext_vector_type(2)));

__device__ __forceinline__ float shx(float v, int o, int lane) { return __int_as_float(__builtin_amdgcn_ds_bpermute((lane ^ o) << 2, __float_as_int(v))); }
__device__ __forceinline__ float wave_sum(float v, int lane) {
#pragma unroll
    for (int o = 1; o < 64; o <<= 1) v += shx(v, o, lane);
    return v;
}
__device__ __forceinline__ float bf2f(unsigned bits16) { return __uint_as_float(bits16 << 16); }
__device__ __forceinline__ unsigned pkbf(float lo, float hi) { return pg8::cvt_pk_bf16(lo, hi); }

struct TItem { const float* W; bfu* WT; int K, N, item; };
__device__ __forceinline__ TItem titem_decode(ArgsP a, int it) {
    unsigned char* ws = a->ws; TItem t; int r = it;
    if (r < 4608) { const int l = r / 2304; t.W = a->a_w_qkv + (size_t)l * DM * NQKV_A; t.K = DM; t.N = NQKV_A; t.WT = (bfu*)(ws + WS_WQKVA) + (size_t)l * NQKV_A * DM; t.item = r - l * 2304; }
    else if ((r -= 4608) < 512) { const int l = r / 256; t.W = a->a_w_o + (size_t)l * AGW * DM; t.K = AGW; t.N = DM; t.WT = (bfu*)(ws + WS_WOA) + (size_t)l * DM * AGW; t.item = r - l * 256; }
    else if ((r -= 512) < 512) { t.W = a->kv_w_k; t.K = DM; t.N = DM; t.WT = (bfu*)(ws + WS_WKV); t.item = r; }
    else if ((r -= 512) < 512) { t.W = a->kv_w_v; t.K = DM; t.N = DM; t.WT = (bfu*)(ws + WS_WKV) + (size_t)DM * DM; t.item = r; }
    else if ((r -= 512) < 1024) { const int j = r / 512; t.W = a->b_w_q + (size_t)j * DM * DM; t.K = DM; t.N = DM; t.WT = (bfu*)(ws + WS_WQB) + (size_t)j * DM * DM; t.item = r - j * 512; }
    else if ((r -= 1024) < 1024) { const int j = r / 512; t.W = a->b_w_o + (size_t)j * DM * DM; t.K = DM; t.N = DM; t.WT = (bfu*)(ws + WS_WOB) + (size_t)j * DM * DM; t.item = r - j * 512; }
    else if ((r -= 1024) < 8192) { const int l = r / 2048; t.W = a->mlp_w1 + (size_t)l * DM * DFF; t.K = DM; t.N = DFF; t.WT = (bfu*)(ws + WS_W1) + (size_t)l * DFF * DM; t.item = r - l * 2048; }
    else { r -= 8192; const int l = r / 2048; t.W = a->mlp_w2 + (size_t)l * DFF * DM; t.K = DFF; t.N = DM; t.WT = (bfu*)(ws + WS_W2) + (size_t)l * DM * DFF; t.item = r - l * 2048; }
    return t;
}
typedef float f32x2t __attribute__((ext_vector_type(2)));
__device__ __forceinline__ void titem_run(const TItem& t, int lane, LAS unsigned char* scr  ) {
    const int nb = t.N >> 7, kb = t.item / nb, nbi = t.item - kb * nb, k0 = kb << 6, n0 = nbi << 7;
    const float* src = t.W + (size_t)k0 * t.N + n0 + 2 * lane;
    f32x2t v[64];
#pragma unroll
    for (int i = 0; i < 64; ++i) v[i] = *(const f32x2t*)(src + (size_t)i * t.N);
    const int c = lane & 7, rsub = lane >> 3;
#pragma unroll
    for (int h = 0; h < 2; ++h) {
#pragma unroll
        for (int kk = 0; kk < 8; ++kk) { v4u o; o.x = pkbf(v[8 * kk + 0][h], v[8 * kk + 1][h]); o.y = pkbf(v[8 * kk + 2][h], v[8 * kk + 3][h]); o.z = pkbf(v[8 * kk + 4][h], v[8 * kk + 5][h]); o.w = pkbf(v[8 * kk + 6][h], v[8 * kk + 7][h]);
            *(LAS v4u*)(scr + lane * 144 + kk * 16) = o; }
        asm volatile("s_waitcnt lgkmcnt(0)" ::: "memory");
        bfu* dst = t.WT + (size_t)(n0 + 2 * rsub + h) * t.K + k0 + 8 * c;
#pragma unroll
        for (int j = 0; j < 8; ++j) { const v4u o = *(const LAS v4u*)(scr + (8 * j + rsub) * 144 + c * 16); *(v4u*)(dst + (size_t)(16 * j) * t.K) = o; }
        asm volatile("s_waitcnt lgkmcnt(0)" ::: "memory");
    }
}

__device__ __forceinline__ void p0_prologue(ArgsP a, LAS unsigned char* lds, int tid, int lane, int wave, int vcu, int G) {
    unsigned char* ws = a->ws;
    LAS float* cact = (LAS float*)lds;
    LAS float* ifr = (LAS float*)(lds + 32768);
    for (int i = tid; i < BATCH * DM; i += NWAVES * 64) { const int b = i / DM, k = i - b * DM; const float v = a->c[i]; cact[k * 4 + b] = v / (1.f + expf(-v)); }
    if (tid == 0) {
        ifr[0] = a->inv_freq[0]; ifr[1] = a->inv_freq[1]; ifr[2] = a->inv_freq[2]; ifr[3] = a->inv_freq[3]; ifr[4] = a->inv_freq[4]; ifr[5] = a->inv_freq[5]; ifr[6] = a->inv_freq[6]; ifr[7] = a->inv_freq[7];
        ifr[8] = a->inv_freq[8]; ifr[9] = a->inv_freq[9]; ifr[10] = a->inv_freq[10]; ifr[11] = a->inv_freq[11]; ifr[12] = a->inv_freq[12]; ifr[13] = a->inv_freq[13]; ifr[14] = a->inv_freq[14]; ifr[15] = a->inv_freq[15];
    }
    __syncthreads();
    const int gw = vcu * NWAVES + wave, NGW = G * NWAVES;
    {
        constexpr int ITEMS_L = (NMOD / 256) * GEMV_KC, ITEMS_KV = (NKV / 256) * GEMV_KC, NITEMS = 4 * ITEMS_L + ITEMS_KV;
        float* MODP = (float*)(ws + WS_MODP);
        for (int it = gw; it < NITEMS; it += NGW) {
            const float* W; int N, slab, kc, moff;
            if (it < 4 * ITEMS_L) { const int l = it / ITEMS_L, r = it - l * ITEMS_L; slab = r / GEMV_KC; kc = r - slab * GEMV_KC; W = a->ada_w + (size_t)l * DM * NMOD; N = NMOD; moff = l * BATCH * NMOD; }
            else { const int r = it - 4 * ITEMS_L; slab = r / GEMV_KC; kc = r - slab * GEMV_KC; W = a->kv_ada_w; N = NKV; moff = MOD_KV_OFF; }
            const int n0 = slab * 256 + lane * 4, k0 = kc * GEMV_KLEN;
            f32x4 acc0 = {0.f, 0.f, 0.f, 0.f}, acc1 = acc0, acc2 = acc0, acc3 = acc0;
            const float* wp = W + (size_t)k0 * N + n0;
#pragma unroll 16
            for (int k = 0; k < GEMV_KLEN; ++k) {
                const f32x4 w = *(const f32x4*)(wp + (size_t)k * N);
                const f32x4 cv = *(const LAS f32x4*)(cact + (k0 + k) * 4);
                acc0 += w * cv.x; acc1 += w * cv.y; acc2 += w * cv.z; acc3 += w * cv.w;
            }
            float* mp = MODP + (size_t)kc * MOD_TOTAL + moff + n0;
            *(f32x4*)(mp) = acc0; *(f32x4*)(mp + N) = acc1; *(f32x4*)(mp + 2 * N) = acc2; *(f32x4*)(mp + 3 * N) = acc3;
        }
    }
    {
        float* cosT = (float*)(ws + WS_COS); float* sinT = (float*)(ws + WS_SIN);
        for (int i = vcu * (NWAVES * 64) + tid; i < M * 16; i += G * NWAVES * 64) {
            const int row = i >> 4, j = i & 15; const float ang = (float)a->pos[row] * ifr[j];
            cosT[i] = cosf(ang); sinT[i] = sinf(ang); }
    }
    {
        constexpr int NT_ITEMS = 24576;
        LAS unsigned char* scr = lds + 40960 + wave * 9216;
        for (int it = gw; it < NT_ITEMS; it += NGW) { const TItem t = titem_decode(a, it); titem_run(t, lane, scr); }
    }
}

__device__ __forceinline__ void p0b_modreduce(ArgsP a, int tid, int vcu, int G) {
    const float* MODP = (const float*)(a->ws + WS_MODP); float* MOD = (float*)(a->ws + WS_MOD);
    for (int i4 = vcu * (NWAVES * 64) + tid; i4 < MOD_TOTAL / 4; i4 += G * NWAVES * 64) {
        const int i = i4 * 4; f32x4 s;
        if (i < MOD_KV_OFF) { const int l = i / (BATCH * NMOD), n = i % NMOD; s = *(const f32x4*)(a->ada_b + (size_t)l * NMOD + n); }
        else { const int n = (i - MOD_KV_OFF) % NKV; s = *(const f32x4*)(a->kv_ada_b + n); }
#pragma unroll 8
        for (int kc = 0; kc < GEMV_KC; ++kc) s += *(const f32x4*)(MODP + (size_t)kc * MOD_TOTAL + i);
        *(f32x4*)(MOD + i) = s;
    }
}

__device__ __forceinline__ void norm_phase(const float* X, const float* g, const float* shift, const float* scale, int bstride, bfu* H, int lane, int gw, int NGW) {
    for (int rb = gw; rb < M / 8; rb += NGW) {
        const int row0 = rb * 8, b = row0 / SEQ;
        f32x4 gs[8], sh[8];
#pragma unroll
        for (int j = 0; j < 8; ++j) { const int col = 4 * lane + 256 * j;
            const f32x4 gv = *(const f32x4*)(g + col), sc = *(const f32x4*)(scale + (size_t)b * bstride + col);
            gs[j] = gv * (sc + 1.0f); sh[j] = *(const f32x4*)(shift + (size_t)b * bstride + col); }
        for (int r = 0; r < 8; ++r) {
            const float* xr = X + (size_t)(row0 + r) * DM + 4 * lane; f32x4 v[8]; float ss = 0.f;
#pragma unroll
            for (int j = 0; j < 8; ++j) { v[j] = *(const f32x4*)(xr + 256 * j); ss += (v[j].x * v[j].x + v[j].y * v[j].y) + (v[j].z * v[j].z + v[j].w * v[j].w); }
            ss = wave_sum(ss, lane);
            const float rstd = 1.0f / sqrtf(ss * (1.0f / DM) + NORM_EPS);
            bfu* hr = H + (size_t)(row0 + r) * DM + 4 * lane;
#pragma unroll
            for (int j = 0; j < 8; ++j) { const f32x4 o = v[j] * rstd * gs[j] + sh[j]; u32x2 w; w.x = pkbf(o.x, o.y); w.y = pkbf(o.z, o.w); *(u32x2*)(hr + 256 * j) = w; }
        }
    }
}

template <int KIND>
__device__ __forceinline__ void qknorm_phase(bfu* buf, const float* gq, const float* gk, const float* cosT, const float* sinT, int lane, int gw, int NGW) {
    constexpr int NQUAD = KIND == 0 ? 12 : 4; constexpr int LD = KIND == 0 ? NQKV_A : (KIND == 1 ? NKV : DM);
    const int sub = lane & 15, ql = lane >> 4;
    for (int it = gw; it < M * NQUAD; it += NGW) {
        const int row = it / NQUAD, q = it - row * NQUAD; const int j = q * 4 + ql;
        int col; const float* gain;
        if (KIND == 0) { const int g = j >> 4, typ = (j >> 3) & 1, h = j & 7; col = g * 3072 + typ * 1024 + h * 128; gain = (typ ? gk : gq) + g * 128; }
        else { col = j * 128; gain = gq + (j & 1) * 128; }
        bfu* p = buf + (size_t)row * LD + col + sub * 8;
        const v4u raw = *(const v4u*)p;
        float v[8];
        v[0] = bf2f(raw.x & 0xffffu); v[1] = bf2f(raw.x >> 16); v[2] = bf2f(raw.y & 0xffffu); v[3] = bf2f(raw.y >> 16);
        v[4] = bf2f(raw.z & 0xffffu); v[5] = bf2f(raw.z >> 16); v[6] = bf2f(raw.w & 0xffffu); v[7] = bf2f(raw.w >> 16);
        float ss = 0.f;
#pragma unroll
        for (int i = 0; i < 8; ++i) ss += v[i] * v[i];
        ss += shx(ss, 1, lane); ss += shx(ss, 2, lane); ss += shx(ss, 4, lane); ss += shx(ss, 8, lane);
        const float rstd = 1.0f / sqrtf(ss * (1.0f / HD) + NORM_EPS);
        const f32x4 g0 = *(const f32x4*)(gain + sub * 8), g1 = *(const f32x4*)(gain + sub * 8 + 4);
        v[0] *= rstd * g0.x; v[1] *= rstd * g0.y; v[2] *= rstd * g0.z; v[3] *= rstd * g0.w; v[4] *= rstd * g1.x; v[5] *= rstd * g1.y; v[6] *= rstd * g1.z; v[7] *= rstd * g1.w;
        float pv[8];
#pragma unroll
        for (int i = 0; i < 8; ++i) pv[i] = shx(v[i], 2, lane);
        if (sub < 4) {
            const float* cp = cosT + (size_t)row * 16 + (sub & 1) * 8; const float* sp = sinT + (size_t)row * 16 + (sub & 1) * 8;
            const f32x4 c0 = *(const f32x4*)cp, c1 = *(const f32x4*)(cp + 4), s0 = *(const f32x4*)sp, s1 = *(const f32x4*)(sp + 4);
            const float cs[8] = {c0.x, c0.y, c0.z, c0.w, c1.x, c1.y, c1.z, c1.w}; const float sn[8] = {s0.x, s0.y, s0.z, s0.w, s1.x, s1.y, s1.z, s1.w};
            const float sgn = (sub < 2) ? -1.0f : 1.0f;
#pragma unroll
            for (int i = 0; i < 8; ++i) v[i] = v[i] * cs[i] + sgn * pv[i] * sn[i];
        }
        v4u o; o.x = pkbf(v[0], v[1]); o.y = pkbf(v[2], v[3]); o.z = pkbf(v[4], v[5]); o.w = pkbf(v[6], v[7]);
        *(v4u*)p = o;
    }
}

__device__ __forceinline__ f32x4 ld_bf4(const bfu* p) { const u32x2 w = *(const u32x2*)p; return (f32x4){bf2f(w.x & 0xffffu), bf2f(w.x >> 16), bf2f(w.y & 0xffffu), bf2f(w.y >> 16)}; }
__device__ __forceinline__ void combineA_phase(const bfu* OP, const float* LA, bfu* AO, int lane, int gw, int NGW) {
    for (int row = gw; row < M; row += NGW) {
#pragma unroll
        for (int j = 0; j < 4; ++j) { const int col = 4 * lane + 256 * j, h = col >> 7;
            const float l0 = LA[(size_t)row * 8 + h], l1 = LA[(size_t)M * 8 + (size_t)row * 8 + h], l2 = LA[(size_t)2 * M * 8 + (size_t)row * 8 + h];
            const float mx = fmaxf(l0, fmaxf(l1, l2)); const float e0 = expf(l0 - mx), e1 = expf(l1 - mx), e2 = expf(l2 - mx); const float inv = 1.0f / (e0 + e1 + e2);
            const f32x4 o0 = ld_bf4(OP + (size_t)row * AGW + col), o1 = ld_bf4(OP + (size_t)M * AGW + (size_t)row * AGW + col), o2 = ld_bf4(OP + (size_t)2 * M * AGW + (size_t)row * AGW + col);
            const f32x4 o = (o0 * e0 + o1 * e1 + o2 * e2) * inv;
            u32x2 w; w.x = pkbf(o.x, o.y); w.y = pkbf(o.z, o.w); *(u32x2*)(AO + (size_t)row * AGW + col) = w; }
    }
}
__device__ __forceinline__ void combineB_phase(const bfu* OP, const float* lp, const float* subg, float lam_init, bfu* AO, int lane, int gw, int NGW) {
    float s1 = lp[lane] * lp[128 + lane] + lp[64 + lane] * lp[192 + lane], s2 = lp[256 + lane] * lp[384 + lane] + lp[320 + lane] * lp[448 + lane];
    s1 = wave_sum(s1, lane); s2 = wave_sum(s2, lane);
    const float lam = expf(s1) - expf(s2) + lam_init;
    const f32x4 sg = *(const f32x4*)(subg + 4 * lane) * (1.0f - lam_init);
    for (int row = gw; row < M; row += NGW) {
        const bfu* p0 = OP + (size_t)row * DM + 4 * lane; const bfu* p1 = p0 + (size_t)M * DM;
        bfu* ao = AO + (size_t)row * DM + 4 * lane;
#pragma unroll
        for (int j = 0; j < 8; ++j) {
            const f32x4 o = ld_bf4(p0 + 256 * j) - ld_bf4(p1 + 256 * j) * lam;
            float ss = (o.x * o.x + o.y * o.y) + (o.z * o.z + o.w * o.w); ss = wave_sum(ss, lane);
            const float rstd = 1.0f / sqrtf(ss * (1.0f / 256.0f) + NORM_EPS);
            const f32x4 r = o * rstd * sg; u32x2 w; w.x = pkbf(r.x, r.y); w.y = pkbf(r.z, r.w); *(u32x2*)(ao + 256 * j) = w; }
    }
}

__device__ __forceinline__ swa::BlockRef attnA_ref(int L, const bfu* QKV, bfu* OP, float* LA) {
    const int g = L >> 9, rem = L & 511, bh = rem >> 4, sub = rem & 15, dsh = 2 * g, d = 1 << dsh;
    const int r = sub >> (4 - dsh), qb = sub & ((16 >> dsh) - 1), b = bh >> 3, h = bh & 7;
    const size_t tok0 = (size_t)b * SEQ + r, tq = tok0 + (size_t)d * 256 * qb;
    swa::BlockRef R;
    R.Q = (const swa::bf16*)(QKV + tq * NQKV_A + g * 3072 + h * 128);
    R.K = (const swa::bf16*)(QKV + tok0 * NQKV_A + g * 3072 + 1024 + h * 128);
    R.V = (const swa::bf16*)(QKV + tok0 * NQKV_A + g * 3072 + 2048 + h * 128);
    R.O = (swa::bf16*)(OP + (size_t)g * M * AGW + tq * AGW + h * 128); R.L = LA + (size_t)g * M * 8 + tq * 8 + h;
    R.qs = d * NQKV_A; R.kvs = d * NQKV_A; R.os = d * AGW; R.ls = d * 8; R.P0 = 256 * qb; R.skv = SEQ >> dsh;
    return R;
}
__device__ __forceinline__ swa::BlockRef attnB_ref(int I, int pass, const bfu* Qb, const bfu* KVB, bfu* OP) {
    const int bh = I >> 5, slot = I & 31, c = slot >> 4, vh = (slot >> 3) & 1, x = slot & 7, qb = pass ? 15 - x : x, b = bh >> 3, h = bh & 7;
    const size_t tq = (size_t)b * SEQ + 256 * qb;
    swa::BlockRef R;
    R.Q = (const swa::bf16*)(Qb + tq * DM + h * 256 + c * 128);
    R.K = (const swa::bf16*)(KVB + (size_t)b * SEQ * NKV + h * 256 + c * 128);
    R.V = (const swa::bf16*)(KVB + (size_t)b * SEQ * NKV + DM + h * 256 + vh * 128);
    R.O = (swa::bf16*)(OP + (size_t)c * M * DM + tq * DM + h * 256 + vh * 128); R.L = nullptr;
    R.qs = DM; R.kvs = NKV; R.os = DM; R.ls = 0; R.P0 = 256 * qb; R.skv = SEQ;
    return R;
}

__global__ void __launch_bounds__(NWAVES * 64, 2) yoco_fwd(Args args_unused) {
    (void)args_unused;
    extern __shared__ __attribute__((aligned(16))) unsigned char lds_raw[];
    LAS unsigned char* lds = (LAS unsigned char*)lds_raw;
    volatile LAS unsigned* MISC = (volatile LAS unsigned*)(lds + MISC_OFF);
    const int wave_s = __builtin_amdgcn_readfirstlane((int)threadIdx.x >> 6);
    for (int u = threadIdx.x; u < (LDS_BYTES - LDSCTL_OFF) / 4; u += NWAVES * 64) ((LAS unsigned*)(lds + LDSCTL_OFF))[u] = 0u;
    __syncthreads();
    int lo, hi; XcdBarrier bar;
    { ArgsP a = get_args(); const Ctx c = fresh_ctx(wave_s); lo = a->ph_lo; hi = a->ph_hi; unsigned* bw = (unsigned*)(a->ws + WS_CTL) + CW_BAR;
      bar.bar = bw; bar.x = 0; bar.st = nullptr;
      if (hi - lo > 1) bar = xcd_barrier_post(bw, MISC + 8, threadIdx.x == 0); }
#define IN(k) (lo <= (k) && (k) < hi)
#define SEAM(k) do { if (IN(k) && IN((k) + 1)) { XcdBarrier bb_ = bar; { GAS unsigned* gb_ = (GAS unsigned*)bar.bar; asm volatile("" : "+s"(gb_), "+s"(bb_.x)); bb_.bar = (unsigned*)gb_; } const Ctx cb_ = fresh_ctx(wave_s); xcd_barrier(bb_, cb_.tid == 0); } } while (0)
#define WSP(T, off) ((T*)(a->ws + (off)))
#ifndef DUP_MASK
#define DUP_MASK 0
#endif
#define NREP(k) (1 + ((DUP_MASK >> (k)) & 1))
#define REPBAR() do { if (rep_ && hi - lo > 1) { XcdBarrier bb_ = bar; { GAS unsigned* gb_ = (GAS unsigned*)bar.bar; asm volatile("" : "+s"(gb_), "+s"(bb_.x)); bb_.bar = (unsigned*)gb_; } const Ctx cb_ = fresh_ctx(wave_s); xcd_barrier(bb_, cb_.tid == 0); } } while (0)

    if ((DUP_MASK >> 15) & 1) { const unsigned long long t0_ = __builtin_amdgcn_s_memrealtime(); while (__builtin_amdgcn_s_memrealtime() - t0_ < 20000ull) __builtin_amdgcn_s_sleep(8); }
    if (IN(0)) for (int rep_ = 0; rep_ < NREP(9); ++rep_) { REPBAR(); const Ctx c = fresh_ctx(wave_s); p0_prologue(get_args(), lds, c.tid, c.lane, c.wave, c.vcu, c.G); }
    SEAM(0);
    if (IN(1)) { const Ctx c = fresh_ctx(wave_s); p0b_modreduce(get_args(), c.tid, c.vcu, c.G); }
    SEAM(1);
    if ((DUP_MASK >> 14) & 1) { for (int xb_ = 0; xb_ < 20; ++xb_) { const int rep_ = 1; REPBAR(); } }

    for (int s = 0; s < N_STAGE; ++s) {
        const int kind = (s < 2) ? 0 : (s == 2 ? 1 : 2);
        const int layer = (s < 2) ? s : s - 1;
        const int jb = s - 3;
        const int pb = (s == 0) ? 2 : (s == 1) ? 10 : (s == 2) ? 18 : (s == 3) ? 20 : 28;

        if (IN(pb + 0)) for (int rep_ = 0; rep_ < NREP(0); ++rep_) { REPBAR();
            ArgsP a = get_args(); const Ctx c = fresh_ctx(wave_s); const float* MOD = WSP(const float, WS_MOD); bfu* Hb = WSP(bfu, WS_H);
            if (kind == 1) norm_phase(a->out, a->kv_norm_g, MOD + MOD_KV_OFF, MOD + MOD_KV_OFF + DM, NKV, Hb, c.lane, c.gw, c.NGW);
            else { const float* modl = MOD + (size_t)layer * BATCH * NMOD; norm_phase((s == 0) ? a->x : (const float*)a->out, a->norm_g + (size_t)(layer * 2) * DM, modl, modl + DM, NMOD, Hb, c.lane, c.gw, c.NGW); }
        }
        SEAM(pb + 0);
        if (IN(pb + 1)) for (int rep_ = 0; rep_ < NREP(kind == 0 ? 1 : (kind == 1 ? 12 : 13)); ++rep_) { REPBAR();
            ArgsP a = get_args(); const Ctx c = fresh_ctx(wave_s);
            const bfu* Wt; int N; bfu* O; const float* gq; const float* gk;
            if (kind == 0) { Wt = WSP(const bfu, WS_WQKVA) + (size_t)layer * NQKV_A * DM; N = NQKV_A; O = WSP(bfu, WS_QKV); gq = a->a_q_gain + (size_t)layer * 3 * HD; gk = a->a_k_gain + (size_t)layer * 3 * HD; }
            else if (kind == 1) { Wt = WSP(const bfu, WS_WKV); N = NKV; O = WSP(bfu, WS_KVB); gq = a->kv_k_gain; gk = gq; }
            else { Wt = WSP(const bfu, WS_WQB) + (size_t)jb * DM * DM; N = DM; O = WSP(bfu, WS_QKV); gq = a->b_q_gain + (size_t)jb * 2 * HD; gk = gq; }
            pg8::Gemm g{WSP(const bfu, WS_H), Wt, M, N, DM}; pg8::StaticOrder S; S.init(M, N, c.G, c.bx);
            pg8::EpiQK E{O, N, kind, gq, gk, WSP(const float, WS_COS), WSP(const float, WS_SIN), (LAS float*)(lds + XCH_OFF), NORM_EPS};
            pg8::gemm_phase<pg8::EpiQK, pg8::StaticOrder, true, true>(lds + RING_OFF, g, S, E, c.tid);
        }
        SEAM(pb + 1);
        if (kind == 1) continue;
        if (IN(pb + 2)) for (int rep_ = 0; rep_ < NREP(kind == 0 ? 2 : 10); ++rep_) { REPBAR();
            if (kind == 0) {
                ArgsP a = get_args(); const Ctx c = fresh_ctx(wave_s);
                const bfu* QKV = WSP(const bfu, WS_QKV); bfu* OP = WSP(bfu, WS_OP);
                float* LA = WSP(float, WS_LA);
                const int total = 1536; const int G = c.G; int L = c.bx;
                if (L < total) {
                    swa::BlockRef cur = attnA_ref(L, QKV, OP, LA); swa::Seam SS;
                    swa::causal_swa_prime(cur, 129, (char*)lds_raw, SS, c.tid);
                    for (;;) {
                        const bool more = L + G < total;
                        const swa::BlockRef nxt = more ? attnA_ref(L + G, QKV, OP, LA) : cur;
                        swa::causal_swa_block<true>(cur, nxt, 129, (char*)lds_raw, SS, c.tid);
                        if (!more) break;
                        cur = nxt; L += G;
                    }
                }
            } else {
                ArgsP a = get_args(); const Ctx c = fresh_ctx(wave_s);
                const bfu* QKV = WSP(const bfu, WS_QKV); bfu* OP = WSP(bfu, WS_OP);
                const bfu* KVB = WSP(const bfu, WS_KVB); const int G = c.G, vcu = c.vcu;
                const int nit = (G == 256) ? 4 : (vcu < 1024 ? (1024 - vcu + G - 1) / G : 0);
                int n = 0; const int nblk = 2 * nit;
#define ITEM_OF(i) ((G == 256) ? ((vcu >> 5) * 128 + (i) * 32 + (vcu & 31)) : (vcu + (i) * G))
                if (nblk > 0) {
                    swa::BlockRef cur = attnB_ref(ITEM_OF(0), 0, QKV, KVB, OP); swa::Seam SS;
                    swa::causal_swa_prime(cur, SEQ, (char*)lds_raw, SS, c.tid);
                    for (;;) {
                        const bool more = n + 1 < nblk;
                        const swa::BlockRef nxt = more ? attnB_ref(ITEM_OF((n + 1) >> 1), (n + 1) & 1, QKV, KVB, OP) : cur;
                        swa::causal_swa_block<false>(cur, nxt, SEQ, (char*)lds_raw, SS, c.tid);
                        if (!more) break;
                        cur = nxt; ++n;
                    }
                }
#undef ITEM_OF
            }
        }
        SEAM(pb + 2);
        if (IN(pb + 3)) for (int rep_ = 0; rep_ < NREP(kind == 0 ? 3 : 11); ++rep_) { REPBAR();
            ArgsP a = get_args(); const Ctx c = fresh_ctx(wave_s);
            if (kind == 0) combineA_phase(WSP(const bfu, WS_OP), WSP(const float, WS_LA), WSP(bfu, WS_AO), c.lane, c.gw, c.NGW);
            else combineB_phase(WSP(const bfu, WS_OP), a->b_lambda + (size_t)jb * 4 * HD, a->b_subln_g + (size_t)jb * 256, jb == 0 ? a->lam_init[0] : a->lam_init[1], WSP(bfu, WS_AO), c.lane, c.gw, c.NGW);
        }
        SEAM(pb + 3);
        if (IN(pb + 4)) for (int rep_ = 0; rep_ < NREP(4); ++rep_) { REPBAR();
            ArgsP a = get_args(); const Ctx c = fresh_ctx(wave_s);
            const bfu* Wt; int K;
            if (kind == 0) { Wt = WSP(const bfu, WS_WOA) + (size_t)layer * DM * AGW; K = AGW; }
            else { Wt = WSP(const bfu, WS_WOB) + (size_t)jb * DM * DM; K = DM; }
            pg8::Gemm g{WSP(const bfu, WS_AO), Wt, M, DM, K}; pg8::StaticOrder S; S.init(M, DM, c.G, c.bx);
            pg8::EpiRes E{(s == 0) ? a->x : (const float*)a->out, rep_ ? WSP(float, WS_OP) : a->out, DM, WSP(const float, WS_MOD) + (size_t)layer * BATCH * NMOD + 2 * DM, NMOD, SEQ};
            pg8::gemm_phase<pg8::EpiRes, pg8::StaticOrder, true, true>(lds + RING_OFF, g, S, E, c.tid);
        }
        SEAM(pb + 4);
        if (IN(pb + 5)) for (int rep_ = 0; rep_ < NREP(5); ++rep_) { REPBAR();
            ArgsP a = get_args(); const Ctx c = fresh_ctx(wave_s); const float* modl = WSP(const float, WS_MOD) + (size_t)layer * BATCH * NMOD;
            norm_phase(a->out, a->norm_g + (size_t)(layer * 2 + 1) * DM, modl + 3 * DM, modl + 4 * DM, NMOD, WSP(bfu, WS_H), c.lane, c.gw, c.NGW);
        }
        SEAM(pb + 5);
        if (IN(pb + 6)) for (int rep_ = 0; rep_ < NREP(6); ++rep_) { REPBAR();
            ArgsP a = get_args(); const Ctx c = fresh_ctx(wave_s);
            pg8::Gemm g{WSP(const bfu, WS_H), WSP(const bfu, WS_W1) + (size_t)layer * DFF * DM, M, DFF, DM}; pg8::StaticOrder S; S.init(M, DFF, c.G, c.bx);
            pg8::EpiBf16<1> E{WSP(bfu, WS_QKV), DFF};
            pg8::gemm_phase<pg8::EpiBf16<1>, pg8::StaticOrder, true, true>(lds + RING_OFF, g, S, E, c.tid);
        }
        SEAM(pb + 6);
        if (IN(pb + 7)) for (int rep_ = 0; rep_ < NREP(7); ++rep_) { REPBAR();
            ArgsP a = get_args(); const Ctx c = fresh_ctx(wave_s);
            pg8::Gemm g{WSP(const bfu, WS_QKV), WSP(const bfu, WS_W2) + (size_t)layer * DM * DFF, M, DM, DFF}; pg8::StaticOrder S; S.init(M, DM, c.G, c.bx);
            pg8::EpiRes E{a->out, rep_ ? WSP(float, WS_OP) : a->out, DM, WSP(const float, WS_MOD) + (size_t)layer * BATCH * NMOD + 5 * DM, NMOD, SEQ};
            pg8::gemm_phase<pg8::EpiRes, pg8::StaticOrder, true, true>(lds + RING_OFF, g, S, E, c.tid);
        }
        SEAM(pb + 7);
    }
#undef IN
#undef SEAM
#undef WSP
#undef REPBAR
}

extern "C" void kernel_launch(void* const* d_in, const int* in_sizes, int n_in, void* d_out, int out_size, void* d_ws, size_t ws_size, hipStream_t stream) {
    static int grid = 0;
    if (grid == 0) {
        if (n_in != 23 || in_sizes[0] != M * DM || out_size != M * DM || ws_size < WS_END) { fprintf(stderr, "kernel_launch: unexpected shapes (n_in %d, in0 %d, out %d, ws %zu); nothing launched\n", n_in, n_in > 0 ? in_sizes[0] : -1, out_size, ws_size); grid = -1; return; }
        int dev = 0, cus = 0, per_cu = 0;
        if (hipGetDevice(&dev) != hipSuccess || hipDeviceGetAttribute(&cus, hipDeviceAttributeMultiprocessorCount, dev) != hipSuccess) { fprintf(stderr, "kernel_launch: hipGetDevice / hipDeviceGetAttribute failed\n"); grid = -1; return; }
        if (hipFuncSetAttribute((const void*)yoco_fwd, hipFuncAttributeMaxDynamicSharedMemorySize, LDS_BYTES) != hipSuccess) { fprintf(stderr, "kernel_launch: hipFuncSetAttribute failed\n"); grid = -1; return; }
        if (hipOccupancyMaxActiveBlocksPerMultiprocessor(&per_cu, (const void*)yoco_fwd, NWAVES * 64, LDS_BYTES) != hipSuccess || per_cu < 1)
            fprintf(stderr, "kernel_launch: note: occupancy query reports %d workgroups per CU\n", per_cu);
        (void)hipGetLastError();
        grid = cus;
    }
    if (grid < 0) return;
    if (hipMemsetAsync((char*)d_ws + WS_CTL, 0, CTL_ZERO_BYTES, stream) != hipSuccess) { fprintf(stderr, "kernel_launch: hipMemsetAsync failed\n"); return; }
    Args ha{};
    ha.x = (const float*)d_in[0]; ha.c = (const float*)d_in[1]; ha.pos = (const int*)d_in[2]; ha.ada_w = (const float*)d_in[3]; ha.ada_b = (const float*)d_in[4]; ha.norm_g = (const float*)d_in[5];
    ha.a_w_qkv = (const float*)d_in[6]; ha.a_q_gain = (const float*)d_in[7]; ha.a_k_gain = (const float*)d_in[8]; ha.a_w_o = (const float*)d_in[9];
    ha.kv_ada_w = (const float*)d_in[10]; ha.kv_ada_b = (const float*)d_in[11]; ha.kv_norm_g = (const float*)d_in[12]; ha.kv_w_k = (const float*)d_in[13]; ha.kv_w_v = (const float*)d_in[14]; ha.kv_k_gain = (const float*)d_in[15];
    ha.b_w_q = (const float*)d_in[16]; ha.b_q_gain = (const float*)d_in[17]; ha.b_lambda = (const float*)d_in[18]; ha.b_subln_g = (const float*)d_in[19]; ha.b_w_o = (const float*)d_in[20];
    ha.mlp_w1 = (const float*)d_in[21]; ha.mlp_w2 = (const float*)d_in[22];
    ha.out = (float*)d_out; ha.ws = (unsigned char*)d_ws;
    for (int j = 0; j < 16; ++j) ha.inv_freq[j] = (float)pow(500000.0, -(double)(2 * j) / 32.0);
    ha.lam_init[0] = (float)(0.8 - 0.6 * exp(-0.3 * 2.0)); ha.lam_init[1] = (float)(0.8 - 0.6 * exp(-0.3 * 3.0));
#if MK_ONE_LAUNCH
    ha.ph_lo = 0; ha.ph_hi = N_PHASE;
    hipLaunchKernelGGL(yoco_fwd, dim3(grid), dim3(NWAVES * 64), LDS_BYTES, stream, ha);
    { const hipError_t le = hipPeekAtLastError(); if (le != hipSuccess) fprintf(stderr, "kernel_launch: launch failed: %s\n", hipGetErrorName(le)); }
#else
    for (int p = 0; p < N_PHASE; ++p) {
        ha.ph_lo = p; ha.ph_hi = p + 1;
        hipLaunchKernelGGL(yoco_fwd, dim3(grid), dim3(NWAVES * 64), LDS_BYTES, stream, ha);
        const hipError_t le = hipPeekAtLastError(); if (le != hipSuccess) { fprintf(stderr, "kernel_launch: launch %d failed: %s\n", p, hipGetErrorName(le)); break; }
    }
#endif
}
```

```cpp
#include <hip/hip_runtime.h>
#include <hip/hip_bf16.h>
#include <cstdio>
#include <cstdint>
#include <cmath>
namespace pg8 {
#define PG8_LAS __attribute__((address_space(3)))
typedef unsigned short bf16_t;
typedef short bf16x8 __attribute__((ext_vector_type(8)));
typedef float f32x4 __attribute__((ext_vector_type(4)));
typedef unsigned u32x4 __attribute__((ext_vector_type(4)));
constexpr int BM = 256, BK = 64, HALF = 128, HTB = HALF * BK * 2  , STAGE_BYTES = 8 * HTB, NXCD = 8, WGM = 8;

__host__ __device__ __forceinline__ int lds_byte(int r, int c) { const int st = (r >> 4) * 2 + (c >> 5), rr = r & 15, cc = c & 31, ob = rr * 64 + cc * 2; return st * 1024 + (ob ^ (((ob >> 9) & 1) << 5)); }
__host__ __device__ __forceinline__ void stage_rc(int b, int& R, int& C) { const int st = b / 1024, sb = b % 1024, swz = sb ^ (((sb >> 9) & 1) << 5); R = (st >> 1) * 16 + swz / 64; C = (st & 1) * 32 + (swz % 64) / 2; }
__host__ __device__ __forceinline__ int perm32(int rho) { const int n = rho >> 4, i = rho & 15; return 8 * (i >> 2) + 4 * n + (i & 3); }

struct Unit { int pm, pn; };
struct Gemm { const bf16_t* A; const bf16_t* Bt; int M, N, K; };

struct StaticOrder {
    int nM, nN, nwg, G, c, i0, i1;
    __host__ __device__ void init(int M, int N, int G_, int c_) { nM = M / BM; nN = N / BM; nwg = nM * nN; G = G_; c = c_; i0 = 0; i1 = 0x7fffffff; }
    __host__ __device__ bool next(int i, Unit& u) const {
        if (i + i0 >= i1) return false;
        const long L = (long)(i + i0) * G + c; if (L >= nwg) return false;
        int wgid = (int)L; { const int q = nwg / NXCD, r = nwg % NXCD, xcd = wgid % NXCD, off = wgid / NXCD; wgid = (xcd < r ? xcd * (q + 1) : r * (q + 1) + (xcd - r) * q) + off; }
        const int nig = WGM * nN, gid = wgid / nig, fm = gid * WGM, gsz = (nM - fm) < WGM ? (nM - fm) : WGM;
        u.pm = fm + ((wgid % nig) % gsz); u.pn = (wgid % nig) / gsz; return true;
    }
    __device__ __forceinline__ void a_ready(const Unit&) const {}
    __device__ __forceinline__ void done(const Unit&) const {}
};


__device__ __forceinline__ unsigned cvt_pk_bf16(float lo, float hi) { unsigned r; asm volatile("v_cvt_pk_bf16_f32 %0, %1, %2" : "=v"(r) : "v"(lo), "v"(hi)); return r; }

template <int ACT  > struct EpiBf16 {
    static constexpr bool PERM = true, AFTER_DRAIN = false;
    bf16_t* O; int ldc;
    __device__ __forceinline__ void operator()(const f32x4 (&acc)[2][2][4][2], const Unit& u, int wr, int wc, int fr, int fq) const {
        const int row0 = u.pm * BM + wr * 64 + fr; const int col0 = u.pn * BM + wc * 32 + 8 * fq;
#pragma unroll
        for (int ai = 0; ai < 2; ++ai)
#pragma unroll
            for (int m = 0; m < 4; ++m) { bf16_t* rowp = O + (size_t)(row0 + ai * HALF + m * 16) * ldc + col0;
#pragma unroll
                for (int bj = 0; bj < 2; ++bj) { f32x4 v0 = acc[ai][bj][m][0], v1 = acc[ai][bj][m][1];
                    if (ACT == 1) {
#pragma unroll
                        for (int e = 0; e < 4; ++e) { const float a = fmaxf(v0[e], 0.f), b = fmaxf(v1[e], 0.f); v0[e] = a * a; v1[e] = b * b; } }
                    u32x4 w; w.x = cvt_pk_bf16(v0[0], v0[1]); w.y = cvt_pk_bf16(v0[2], v0[3]); w.z = cvt_pk_bf16(v1[0], v1[1]); w.w = cvt_pk_bf16(v1[2], v1[3]);
                    *(u32x4*)(rowp + bj * HALF) = w; } }
    }
};

struct EpiRes {
    static constexpr bool PERM = false, AFTER_DRAIN = false;
    const float* base; float* out; int ldc; const float* gate; int gate_bstride; int rows_per_batch;
    __device__ __forceinline__ void operator()(const f32x4 (&acc)[2][2][4][2], const Unit& u, int wr, int wc, int fr, int fq) const {
        const int row0 = u.pm * BM + wr * 64 + fr, col0 = u.pn * BM + wc * 32 + 4 * fq;
        const float* gp = gate + (size_t)((u.pm * BM) / rows_per_batch) * gate_bstride + col0;
        f32x4 gv[2][2];
#pragma unroll
        for (int bj = 0; bj < 2; ++bj)
#pragma unroll
            for (int n = 0; n < 2; ++n) gv[bj][n] = *(const f32x4*)(gp + bj * HALF + n * 16);
#pragma unroll
        for (int ai = 0; ai < 2; ++ai)
#pragma unroll
            for (int m = 0; m < 4; ++m) { const size_t off = (size_t)(row0 + ai * HALF + m * 16) * ldc + col0;
#pragma unroll
                for (int bj = 0; bj < 2; ++bj)
#pragma unroll
                    for (int n = 0; n < 2; ++n) { const f32x4 bs = *(const f32x4*)(base + off + bj * HALF + n * 16);
                        *(f32x4*)(out + off + bj * HALF + n * 16) = bs + gv[bj][n] * acc[ai][bj][m][n]; }
                if (m & 1) asm volatile("" ::: "memory"); }
    }
};

__device__ __forceinline__ float epi_shx(float v, int o, int lane) { return __int_as_float(__builtin_amdgcn_ds_bpermute((lane ^ o) << 2, __float_as_int(v))); }
struct EpiQK {
    static constexpr bool PERM = true, AFTER_DRAIN = false;
    bf16_t* O; int ldc; int kind; const float* gq; const float* gk; const float* cosT; const float* sinT; PG8_LAS float* xch; float eps;
    __device__ __forceinline__ void operator()(const f32x4 (&acc)[2][2][4][2], const Unit& u, int wr, int wc, int fr, int fq) const {
        const int row0 = u.pm * BM + wr * 64 + fr; const int col0 = u.pn * BM + wc * 32 + 8 * fq;
        bool norm; const float* g0; const float* g1;
        if (kind == 0) { const int cb = u.pn * BM, g = cb / 3072, typ = (cb - g * 3072) >> 10; norm = typ < 2; g0 = (typ ? gk : gq) + g * 128; g1 = g0; }
        else if (kind == 1) { norm = u.pn < 8; g0 = gq; g1 = gq + 128; }
        else { norm = true; g0 = gq; g1 = gq + 128; }
        if (!norm) {
#pragma unroll
            for (int ai = 0; ai < 2; ++ai)
#pragma unroll
                for (int m = 0; m < 4; ++m) { bf16_t* rowp = O + (size_t)(row0 + ai * HALF + m * 16) * ldc + col0;
#pragma unroll
                    for (int bj = 0; bj < 2; ++bj) { const f32x4 v0 = acc[ai][bj][m][0], v1 = acc[ai][bj][m][1];
                        u32x4 w; w.x = cvt_pk_bf16(v0[0], v0[1]); w.y = cvt_pk_bf16(v0[2], v0[3]); w.z = cvt_pk_bf16(v1[0], v1[1]); w.w = cvt_pk_bf16(v1[2], v1[3]);
                        *(u32x4*)(rowp + bj * HALF) = w; } }
            return;
        }
        const int lane = fq * 16 + fr;
        const f32x4 ga0 = *(const f32x4*)(g0 + wc * 32 + 8 * fq), ga1 = *(const f32x4*)(g0 + wc * 32 + 8 * fq + 4), gb0 = *(const f32x4*)(g1 + wc * 32 + 8 * fq), gb1 = *(const f32x4*)(g1 + wc * 32 + 8 * fq + 4);
#pragma unroll
        for (int ai = 0; ai < 2; ++ai)
#pragma unroll
            for (int m = 0; m < 4; ++m)
#pragma unroll
                for (int bj = 0; bj < 2; ++bj) { const f32x4 a = acc[ai][bj][m][0], b = acc[ai][bj][m][1];
                    float s = ((a[0] * a[0] + a[1] * a[1]) + (a[2] * a[2] + a[3] * a[3])) + ((b[0] * b[0] + b[1] * b[1]) + (b[2] * b[2] + b[3] * b[3]));
                    s += epi_shx(s, 16, lane); s += epi_shx(s, 32, lane);
                    if (fq == 0) xch[((ai * HALF + wr * 64 + m * 16 + fr) * 2 + bj) * 4 + wc] = s; }
        asm volatile("s_waitcnt lgkmcnt(0)" ::: "memory"); __builtin_amdgcn_s_barrier(); asm volatile("" ::: "memory");
#pragma unroll
        for (int ai = 0; ai < 2; ++ai)
#pragma unroll
            for (int m = 0; m < 4; ++m) { const int rl = ai * HALF + wr * 64 + m * 16 + fr; const size_t grow = (size_t)(u.pm * BM + rl);
                bf16_t* rowp = O + grow * ldc + col0;
                f32x4 c0 = {1.f, 1.f, 1.f, 1.f}, c1 = c0, s0 = {0.f, 0.f, 0.f, 0.f}, s1 = s0;
                if (wc == 0) { const float* cp = cosT + grow * 16 + (fq & 1) * 8; const float* sp = sinT + grow * 16 + (fq & 1) * 8;
                    c0 = *(const f32x4*)cp; c1 = *(const f32x4*)(cp + 4); s0 = *(const f32x4*)sp; s1 = *(const f32x4*)(sp + 4);
                    if (fq < 2) { s0 = -s0; s1 = -s1; } }
#pragma unroll
                for (int bj = 0; bj < 2; ++bj) { const f32x4 p4 = *(const PG8_LAS f32x4*)(xch + (rl * 2 + bj) * 4);
                    const float rstd = 1.0f / sqrtf(((p4[0] + p4[1]) + (p4[2] + p4[3])) * (1.0f / 128.0f) + eps);
                    f32x4 v0 = acc[ai][bj][m][0] * rstd * (bj ? gb0 : ga0), v1 = acc[ai][bj][m][1] * rstd * (bj ? gb1 : ga1);
                    if (wc == 0) { f32x4 q0, q1;
#pragma unroll
                        for (int e = 0; e < 4; ++e) { q0[e] = epi_shx(v0[e], 32, lane); q1[e] = epi_shx(v1[e], 32, lane); }
                        v0 = v0 * c0 + q0 * s0; v1 = v1 * c1 + q1 * s1; }
                    u32x4 w; w.x = cvt_pk_bf16(v0[0], v0[1]); w.y = cvt_pk_bf16(v0[2], v0[3]); w.z = cvt_pk_bf16(v1[0], v1[1]); w.w = cvt_pk_bf16(v1[2], v1[3]);
                    *(u32x4*)(rowp + bj * HALF) = w; }
                if (m & 1) asm volatile("" ::: "memory"); }
    }
};

template <class Epi, class Sched, bool ALIGN_EPI = false, bool SP2 = false>
__device__ __forceinline__ void gemm_phase(PG8_LAS unsigned char* lds, const Gemm g, const Sched& S, const Epi& E, const int tid  ) {
    const int wid = __builtin_amdgcn_readfirstlane(tid >> 6), lane = tid & 63, wr = wid >> 2, wc = wid & 3, fr = lane & 15, fq = lane >> 4;
    const int K = g.K, nt = K / BK;
    unsigned voffA[2], voffB[2];
#pragma unroll
    for (int i = 0; i < 2; ++i) { int R, C; stage_rc(tid * 16 + i * 8192, R, C); const int Rb = Epi::PERM ? ((R & ~31) + perm32(R & 31)) : R;
        voffA[i] = (unsigned)(R * K + C) * 2u; voffB[i] = (unsigned)(Rb * K + C) * 2u; }
    const size_t kstep = (size_t)(BK * 2);
    const size_t hstep = (size_t)HALF * K * 2;
    const size_t tstep = 2 * hstep;
    const unsigned ldsw = (unsigned)wid * 1024u;
    const int aoff = lds_byte(wr * 64 + fr, fq * 8), boff = lds_byte(wc * 32 + fr, fq * 8);
#define PG8_SA(b, h) (((b) * 2 + (h)) * HTB)
#define PG8_SB(b, h) ((4 + (b) * 2 + (h)) * HTB)
#define PG8_STAGE(bufoff, gbase, voff) do { _Pragma("unroll") for (int _i = 0; _i < 2; ++_i) \
        __builtin_amdgcn_global_load_lds((const unsigned*)((const char*)(gbase) + (voff)[_i]), (PG8_LAS unsigned*)(lds + (bufoff) + ldsw + _i * 8192), 16, 0, 0); } while (0)
#define PG8_LDA(dst, b, h) do { _Pragma("unroll") for (int m = 0; m < 4; ++m) _Pragma("unroll") for (int k = 0; k < 2; ++k) dst[m][k] = *(const PG8_LAS bf16x8*)(lds + PG8_SA(b, h) + aoff + m * 2048 + k * 1024); } while (0)
#define PG8_LDB(dst, b, h) do { _Pragma("unroll") for (int n = 0; n < 2; ++n) _Pragma("unroll") for (int k = 0; k < 2; ++k) dst[n][k] = *(const PG8_LAS bf16x8*)(lds + PG8_SB(b, h) + boff + n * 2048 + k * 1024); } while (0)
#define PG8_MMA(ai, bj, At, Bt) do { __builtin_amdgcn_s_setprio(1); _Pragma("unroll") for (int m = 0; m < 4; ++m) _Pragma("unroll") for (int n = 0; n < 2; ++n) _Pragma("unroll") for (int k = 0; k < 2; ++k) \
        acc[ai][bj][m][n] = __builtin_amdgcn_mfma_f32_16x16x32_bf16(Bt[n][k], At[m][k], acc[ai][bj][m][n], 0, 0, 0); __builtin_amdgcn_s_setprio(0); } while (0)
#define PG8_WAIT_V(n) asm volatile("s_waitcnt vmcnt(" #n ")" ::: "memory")
#define PG8_WAIT_L(n) asm volatile("s_waitcnt lgkmcnt(" #n ")" ::: "memory")
#define PG8_BAR __builtin_amdgcn_s_barrier()
#define PG8_SCHED __builtin_amdgcn_sched_barrier(0)
    Unit cur, nxt; int ui = 0;
    if (!S.next(0, cur)) return;
    f32x4 acc[2][2][4][2];
#pragma unroll
    for (int a = 0; a < 2; ++a)
#pragma unroll
        for (int b = 0; b < 2; ++b)
#pragma unroll
            for (int m = 0; m < 4; ++m)
#pragma unroll
                for (int n = 0; n < 2; ++n) acc[a][b][m][n] = (f32x4){0.f, 0.f, 0.f, 0.f};
    bf16x8 At[4][2], B0[2][2], B1[2][2];
    const char* cA = (const char*)g.A + (size_t)cur.pm * tstep; const char* cB = (const char*)g.Bt + (size_t)cur.pn * tstep;
    S.a_ready(cur);
    if constexpr (SP2) {
        PG8_STAGE(PG8_SB(0, 0), cB, voffB); PG8_STAGE(PG8_SB(0, 1), cB + hstep, voffB); PG8_STAGE(PG8_SA(0, 0), cA, voffA); PG8_STAGE(PG8_SA(0, 1), cA + hstep, voffA);
        if (wr == 1) PG8_BAR;
        PG8_WAIT_V(2); PG8_BAR;
        PG8_STAGE(PG8_SB(1, 0), cB + kstep, voffB); PG8_STAGE(PG8_SA(1, 0), cA + kstep, voffA); PG8_STAGE(PG8_SB(1, 1), cB + hstep + kstep, voffB);
        PG8_WAIT_V(6); PG8_BAR;
    } else {
        PG8_STAGE(PG8_SB(0, 0), cB, voffB); PG8_STAGE(PG8_SA(0, 0), cA, voffA); PG8_STAGE(PG8_SB(0, 1), cB + hstep, voffB); PG8_STAGE(PG8_SA(0, 1), cA + hstep, voffA);
        if (wr == 1) PG8_BAR;
        PG8_WAIT_V(4); PG8_BAR;
        PG8_STAGE(PG8_SB(1, 0), cB + kstep, voffB); PG8_STAGE(PG8_SA(1, 0), cA + kstep, voffA); PG8_STAGE(PG8_SB(1, 1), cB + hstep + kstep, voffB);
        PG8_WAIT_V(6); PG8_BAR;
    }
    for (;;) {
        const bool has_next = S.next(ui + 1, nxt);
        const char* nA = has_next ? (const char*)g.A + (size_t)nxt.pm * tstep : cA; const char* nB = has_next ? (const char*)g.Bt + (size_t)nxt.pn * tstep : cB;
        for (int t = 0; t < nt; t += 2) {
            const bool last = (t == nt - 2);
            const char* a1 = cA + (size_t)(t + 1) * kstep;
            const char* a2 = last ? nA : cA + (size_t)(t + 2) * kstep; const char* b2 = last ? nB : cB + (size_t)(t + 2) * kstep;
            const char* a3 = a2 + kstep; const char* b3 = b2 + kstep;
            if (last && has_next) S.a_ready(nxt);
            if constexpr (SP2) {
            PG8_LDB(B0, 0, 0); PG8_LDB(B1, 0, 1); PG8_SCHED; PG8_LDA(At, 0, 0); PG8_STAGE(PG8_SA(1, 1), a1 + hstep, voffA);
            PG8_WAIT_V(8); PG8_WAIT_L(0); PG8_BAR; PG8_MMA(0, 0, At, B0); PG8_MMA(0, 1, At, B1); PG8_BAR; PG8_SCHED;
            PG8_LDA(At, 0, 1); PG8_STAGE(PG8_SB(0, 0), b2, voffB); PG8_STAGE(PG8_SB(0, 1), b2 + hstep, voffB); PG8_STAGE(PG8_SA(0, 0), a2, voffA);
            PG8_WAIT_V(8); PG8_WAIT_L(0); PG8_BAR; PG8_MMA(1, 0, At, B0); PG8_MMA(1, 1, At, B1); PG8_BAR; PG8_SCHED;
            PG8_LDB(B0, 1, 0); PG8_LDB(B1, 1, 1); PG8_SCHED; PG8_LDA(At, 1, 0); PG8_STAGE(PG8_SA(0, 1), a2 + hstep, voffA);
            PG8_WAIT_V(8); PG8_WAIT_L(0); PG8_BAR; PG8_MMA(0, 0, At, B0); PG8_MMA(0, 1, At, B1); PG8_BAR; PG8_SCHED;
            PG8_LDA(At, 1, 1); PG8_STAGE(PG8_SB(1, 0), b3, voffB); PG8_STAGE(PG8_SB(1, 1), b3 + hstep, voffB); PG8_STAGE(PG8_SA(1, 0), a3, voffA);
            PG8_WAIT_V(8); PG8_WAIT_L(0); PG8_BAR; PG8_MMA(1, 0, At, B0); PG8_MMA(1, 1, At, B1); PG8_BAR; PG8_SCHED;
            } else {
            PG8_LDB(B0, 0, 0); PG8_SCHED; PG8_LDA(At, 0, 0); PG8_STAGE(PG8_SA(1, 1), a1 + hstep, voffA);
            PG8_WAIT_L(8); PG8_BAR; PG8_WAIT_L(0); PG8_MMA(0, 0, At, B0); PG8_BAR; PG8_SCHED;
            PG8_LDB(B1, 0, 1); PG8_STAGE(PG8_SB(0, 0), b2, voffB);
            PG8_BAR; PG8_WAIT_L(0); PG8_MMA(0, 1, At, B1); PG8_BAR;
            PG8_LDA(At, 0, 1); PG8_STAGE(PG8_SA(0, 0), a2, voffA);
            PG8_BAR; PG8_WAIT_L(0); PG8_MMA(1, 0, At, B0); PG8_BAR; PG8_SCHED;
            PG8_STAGE(PG8_SB(0, 1), b2 + hstep, voffB);
            PG8_WAIT_V(6); PG8_BAR; PG8_MMA(1, 1, At, B1); PG8_BAR;
            PG8_LDB(B0, 1, 0); PG8_SCHED; PG8_LDA(At, 1, 0); PG8_STAGE(PG8_SA(0, 1), a2 + hstep, voffA);
            PG8_WAIT_L(8); PG8_BAR; PG8_WAIT_L(0); PG8_MMA(0, 0, At, B0); PG8_BAR; PG8_SCHED;
            PG8_LDB(B1, 1, 1); PG8_STAGE(PG8_SB(1, 0), b3, voffB);
            PG8_BAR; PG8_WAIT_L(0); PG8_MMA(0, 1, At, B1); PG8_BAR;
            PG8_LDA(At, 1, 1); PG8_STAGE(PG8_SA(1, 0), a3, voffA);
            PG8_BAR; PG8_WAIT_L(0); PG8_MMA(1, 0, At, B0); PG8_BAR; PG8_SCHED;
            PG8_STAGE(PG8_SB(1, 1), b3 + hstep, voffB);
            PG8_WAIT_V(6); PG8_BAR; PG8_MMA(1, 1, At, B1); PG8_BAR;
            }
        }
        if constexpr (ALIGN_EPI) { if (wr == 0) PG8_BAR; }
        if constexpr (!Epi::AFTER_DRAIN) { E(acc, cur, wr, wc, fr, fq); S.done(cur); }
        if (!has_next) break;
#pragma unroll
        for (int a = 0; a < 2; ++a)
#pragma unroll
            for (int b = 0; b < 2; ++b)
#pragma unroll
                for (int m = 0; m < 4; ++m)
#pragma unroll
                    for (int n = 0; n < 2; ++n) acc[a][b][m][n] = (f32x4){0.f, 0.f, 0.f, 0.f};
        cur = nxt; cA = nA; cB = nB; ++ui;
        if constexpr (ALIGN_EPI) { if (wr == 1) PG8_BAR; }
    }
    PG8_WAIT_V(0);
    if constexpr (!ALIGN_EPI) { if (wr == 0) PG8_BAR; }
    PG8_BAR;
    if constexpr (Epi::AFTER_DRAIN) { E.fused(acc, cur, wr, wc, fr, fq, lds, wid, lane); S.done(cur); }
#undef PG8_SA
#undef PG8_SB
#undef PG8_STAGE
#undef PG8_LDA
#undef PG8_LDB
#undef PG8_MMA
#undef PG8_WAIT_V
#undef PG8_WAIT_L
#undef PG8_BAR
#undef PG8_SCHED
}
}
namespace swa {
using bf16 = __hip_bfloat16;
constexpr int D = 128;
constexpr float SCALE = 0.08838834764831845f;
constexpr float THR = 8.f;
constexpr int NW = 8, QBLK = 32, KVBLK = 64, QB = NW * QBLK;
constexpr int SHM_V = KVBLK * D * 2, SHM_K = KVBLK * D * 2;
constexpr int LDS_BYTES = 2 * SHM_V + 2 * SHM_K + NW * 64 * 4;

typedef short bf16x8 __attribute__((ext_vector_type(8)));
typedef short s16x4 __attribute__((ext_vector_type(4)));
typedef float f32x16 __attribute__((ext_vector_type(16)));
typedef float f32x4 __attribute__((ext_vector_type(4)));
typedef unsigned u32x4 __attribute__((ext_vector_type(4)));

#define KSWZ(row, colB) ((row) * 256 + ((colB) ^ (((row) & 7) << 4)))
#define SBAR() __builtin_amdgcn_sched_barrier(0)
__device__ __forceinline__ int v_st(int k, int c) { const int kk = (k & ~0xC) | ((k & 4) << 1) | ((k & 8) >> 1); return ((kk >> 3) * 4 + (c >> 5)) * 512 + ((kk & 7) * 32 + (c & 31)) * 2; }
__device__ __forceinline__ int v_rd_base(int lane) { return ((lane & 3) << 3) | (((lane >> 2) & 3) << 6) | (((lane >> 4) & 1) << 5) | (((lane >> 5) & 1) << 8); }
constexpr int v_rd_off(int d0, int ks, int half) { return d0 * 512 + ks * 4096 + half * 2048; }
__device__ __forceinline__ int crow(int r, int hi) { return (r & 3) + 8 * (r >> 2) + 4 * hi; }
__device__ __forceinline__ unsigned cvtpk(float lo, float hi) {
    unsigned r; asm volatile("v_cvt_pk_bf16_f32 %0, %1, %2" : "=v"(r) : "v"(lo), "v"(hi)); return r;
}
__device__ __forceinline__ bf16x8 load8(const bf16* p) { return *reinterpret_cast<const bf16x8*>(p); }
__device__ __forceinline__ void mask_tile(f32x16& p0, f32x16& p1, int dq, unsigned W) {
    const float NEG = -__builtin_inff();
    asm volatile("" : "+v"(dq));
#pragma unroll
    for (int r = 0; r < 16; ++r) {
        const int c = (r & 3) + 8 * (r >> 2);
        if ((unsigned)(dq - c) >= W) p0[r] = NEG;
        if ((unsigned)(dq - c - 32) >= W) p1[r] = NEG;
    }
}
__device__ __forceinline__ void partialSM(f32x16& p0, f32x16& p1, float& m_reg, float& mn, float& alpha) {
    float pmax = p0[0]; for (int r = 1; r < 16; ++r) pmax = fmaxf(pmax, p0[r]); for (int r = 0; r < 16; ++r) pmax = fmaxf(pmax, p1[r]);
    { auto rr = __builtin_amdgcn_permlane32_swap(__float_as_uint(pmax), __float_as_uint(pmax), false, false);
      pmax = fmaxf(__uint_as_float(rr[0]), __uint_as_float(rr[1])); }
    constexpr float C2 = 1.4426950408889634f * SCALE;
    if (__builtin_expect(__all((pmax - m_reg) * SCALE <= THR), 1)) { mn = m_reg; alpha = 1.f; }
    else { mn = fmaxf(m_reg, pmax); alpha = __builtin_amdgcn_exp2f((m_reg - mn) * C2); m_reg = mn; }
    const float mnL = -mn * C2;
    for (int r = 0; r < 16; ++r) p0[r] = fmaf(p0[r], C2, mnL); for (int r = 0; r < 16; ++r) p1[r] = fmaf(p1[r], C2, mnL);
    for (int r = 0; r < 16; ++r) p0[r] = __builtin_amdgcn_exp2f(p0[r]);
}
__device__ __forceinline__ void finishSM(f32x16& p0, f32x16& p1, float alpha, float& l_reg, bf16x8& pa0, bf16x8& pa1, bf16x8& pa2, bf16x8& pa3) {
    for (int r = 0; r < 16; ++r) p1[r] = __builtin_amdgcn_exp2f(p1[r]);
    float ps = 0; for (int r = 0; r < 16; ++r) ps += p0[r]; for (int r = 0; r < 16; ++r) ps += p1[r];
    { auto rr = __builtin_amdgcn_permlane32_swap(__float_as_uint(ps), __float_as_uint(ps), false, false);
      ps = __uint_as_float(rr[0]) + __uint_as_float(rr[1]); }
    l_reg = l_reg * alpha + ps;
#define PK4(P, B_, OUT) do { unsigned a0 = cvtpk(P[B_+0], P[B_+1]), a1 = cvtpk(P[B_+2], P[B_+3]);                          \
        unsigned b0 = cvtpk(P[B_+4], P[B_+5]), b1 = cvtpk(P[B_+6], P[B_+7]);                                             \
        auto r0 = __builtin_amdgcn_permlane32_swap(a0, b0, false, false); auto r1 = __builtin_amdgcn_permlane32_swap(a1, b1, false, false); \
        u32x4 w = {r0[0], r1[0], r0[1], r1[1]}; OUT = *reinterpret_cast<bf16x8*>(&w); } while (0)
    PK4(p0, 0, pa0); PK4(p0, 8, pa1); PK4(p1, 0, pa2); PK4(p1, 8, pa3);
#undef PK4
}
template <int KB, bool SK>
__device__ __forceinline__ void qkt(f32x16& p0, f32x16& p1, const char* K_lds, int r32, int hi, const bf16x8* qr, bool act) {
    if (SK && !act) { const float NEG = -__builtin_inff();
#pragma unroll
        for (int r = 0; r < 16; ++r) { p0[r] = NEG; p1[r] = NEG; } return; }
    p0 = f32x16{}; p1 = f32x16{};
    const char* kb[4];
#pragma unroll
    for (int dd = 0; dd < 4; ++dd) kb[dd] = K_lds + KB * SHM_K + KSWZ(r32, (dd * 16 + hi * 8) * 2);
#pragma unroll
    for (int d0 = 0; d0 < 8; ++d0) { const char* a = kb[d0 & 3] + (d0 >> 2) * 128;
        bf16x8 b0 = *reinterpret_cast<const bf16x8*>(a);
        bf16x8 b1 = *reinterpret_cast<const bf16x8*>(a + 32 * 256);
        p0 = __builtin_amdgcn_mfma_f32_32x32x16_bf16(b0, qr[d0], p0, 0, 0, 0);
        p1 = __builtin_amdgcn_mfma_f32_32x32x16_bf16(b1, qr[d0], p1, 0, 0, 0); }
}
template <int VB, bool SK>
__device__ __forceinline__ void pv_tile(f32x16* o, int vb0, bf16x8 pa0, bf16x8 pa1, bf16x8 pa2, bf16x8 pa3, bool act) {
    if (SK && !act) return;
#define TRRD(dst, off) asm volatile("ds_read_b64_tr_b16 %0, %1 offset:%2" : "=&v"(dst) : "v"(vb0), "i"(off) : "memory")
#define PV_D0(d0) do { s16x4 l0, l1, l2, l3, h0, h1, h2, h3; constexpr int b_ = VB * SHM_V + v_rd_off(d0, 0, 0);     \
        TRRD(l0, b_); TRRD(h0, b_ + 2048); TRRD(l1, b_ + 4096); TRRD(h1, b_ + 6144); TRRD(l2, b_ + 8192); TRRD(h2, b_ + 10240); TRRD(l3, b_ + 12288); TRRD(h3, b_ + 14336); \
        asm volatile("s_waitcnt lgkmcnt(0)" ::: "memory"); SBAR();                 \
        o[d0] = __builtin_amdgcn_mfma_f32_32x32x16_bf16(pa0, (bf16x8){l0[0], l0[1], l0[2], l0[3], h0[0], h0[1], h0[2], h0[3]}, o[d0], 0, 0, 0);   \
        o[d0] = __builtin_amdgcn_mfma_f32_32x32x16_bf16(pa1, (bf16x8){l1[0], l1[1], l1[2], l1[3], h1[0], h1[1], h1[2], h1[3]}, o[d0], 0, 0, 0);   \
        o[d0] = __builtin_amdgcn_mfma_f32_32x32x16_bf16(pa2, (bf16x8){l2[0], l2[1], l2[2], l2[3], h2[0], h2[1], h2[2], h2[3]}, o[d0], 0, 0, 0);   \
        o[d0] = __builtin_amdgcn_mfma_f32_32x32x16_bf16(pa3, (bf16x8){l3[0], l3[1], l3[2], l3[3], h3[0], h3[1], h3[2], h3[3]}, o[d0], 0, 0, 0); } while (0)
    PV_D0(0); PV_D0(1); PV_D0(2); PV_D0(3);
#undef PV_D0
#undef TRRD
}

struct BlockRef { const bf16* Q; const bf16* K; const bf16* V; bf16* O; float* L; int qs, kvs, os, ls, P0, skv; };
struct Seam {
    bf16x8 qr[8];
    bf16x8 st_v0, st_v1, st_k0, st_k1;
};
__device__ __forceinline__ int swa_jlo(int P0, int W) { const int lowk = P0 - W + 1; return lowk > 0 ? lowk / KVBLK : 0; }
#define ROWP(p, st, k0) ((p) + (size_t)(k0) * (size_t)(st))
#define VMW() asm volatile("s_waitcnt vmcnt(0)" ::: "memory")
#define VMWN(n) asm volatile("s_waitcnt vmcnt(%0)" :: "i"(n) : "memory")
#define SLOAD_H(Kp, Vp, st, k0) do { const bf16* kp_ = ROWP(Kp, st, k0); const bf16* vp_ = ROWP(Vp, st, k0); const unsigned o0_ = (unsigned)(sr * (st) + sc), o1_ = o0_ + 32u * (unsigned)(st); \
                         S.st_v0 = load8(vp_ + o0_); S.st_v1 = load8(vp_ + o1_); S.st_k0 = load8(kp_ + o0_); S.st_k1 = load8(kp_ + o1_); } while (0)
#define SWRITE_HK(bf) do { *(bf16x8*)(K_lds + (bf) * SHM_K + kws) = S.st_k0; *(bf16x8*)(K_lds + (bf) * SHM_K + kws + 32 * 256) = S.st_k1; } while (0)
#define SWRITE_HV(bf) do { *(bf16x8*)(V_lds + (bf) * SHM_V + vst0) = S.st_v0; *(bf16x8*)(V_lds + (bf) * SHM_V + vst1) = S.st_v1; } while (0)
#define SWRITE_H(bf) do { SWRITE_HV(bf); SWRITE_HK(bf); } while (0)
__device__ __forceinline__ void causal_swa_prime(const BlockRef& cur, int W, char* lds, Seam& S, int tid) {
    const int wid = __builtin_amdgcn_readfirstlane(tid >> 6), lane = tid & 63, r32 = lane & 31, hi = lane >> 5;
    const int sr = tid >> 4, sc = (tid & 15) * 8, kws = KSWZ(sr, sc * 2); char* K_lds = lds + 2 * SHM_V;
    const int kb0 = swa_jlo(cur.P0, W) * KVBLK;
    { const unsigned qo_ = (unsigned)((wid * QBLK + r32) * cur.qs + hi * 8);
    for (int d0 = 0; d0 < 8; ++d0) S.qr[d0] = load8(cur.Q + qo_ + d0 * 16); }
    SLOAD_H(cur.K, cur.V, cur.kvs, kb0); VMW(); SWRITE_HK(0);
    __syncthreads();
}
template <bool WSK>
__device__ __forceinline__ void causal_swa_block(const BlockRef& cur, const BlockRef& nxt, int W, char* lds, Seam& S, int tid) {
    const int wid = __builtin_amdgcn_readfirstlane(tid >> 6), lane = tid & 63, r32 = lane & 31, hi = lane >> 5;
    const int skv = cur.skv;
    const int j_lo = swa_jlo(cur.P0, W);
    int j_hi = (cur.P0 + QB - 1) / KVBLK + 1; if (j_hi > skv / KVBLK) j_hi = skv / KVBLK;
    const int NT = j_hi - j_lo;
    const int kbn = swa_jlo(nxt.P0, W) * KVBLK;
    const int qlo = cur.P0 + wid * QBLK, qm = qlo + r32 - 4 * hi;
    char* V_lds = lds; char* K_lds = lds + 2 * SHM_V;
    float* ws = (float*)(lds + 2 * SHM_V + 2 * SHM_K) + wid * 64; float* li_l = ws, * al_l = ws + 32;
    float m_reg = -1e30f, l_reg = 0; f32x16 o[4] = {};
    const int sr = tid >> 4, sc = (tid & 15) * 8, vst0 = v_st(sr, sc), vst1 = v_st(32 + sr, sc), kws = KSWZ(sr, sc * 2);
    const int vb0 = (int)(uintptr_t)V_lds + v_rd_base(lane);
    const bf16* Kh = cur.K; const bf16* Vh = cur.V; const int kvs = cur.kvs;
#define RESC(a) do { if (__any((a) < 1.f)) { if (hi == 0) al_l[r32] = (a); asm volatile("s_waitcnt lgkmcnt(0)" ::: "memory");              \
                     int h4_ = 4 * hi; asm volatile("" : "+v"(h4_));     \
                     for (int d_ = 0; d_ < 4; ++d_) for (int r = 0; r < 16; ++r) o[d_][r] *= al_l[(r & 3) + 8 * (r >> 2) + h4_]; } } while (0)
#define KBASE(t) ((j_lo + (t)) * KVBLK)
#define ACT(t) (KBASE(t) <= qlo + QBLK - 1 && KBASE(t) + KVBLK - 1 >= qlo - W + 1)
#define MASKT(P0_, P1_, t) do { const int kb_ = KBASE(t); if ((!SK || ACT(t)) && (kb_ + KVBLK - 1 > qlo || kb_ <= qlo + QBLK - 1 - W)) mask_tile(P0_, P1_, qm - kb_, (unsigned)W); } while (0)
    constexpr int NQL = 8;
    constexpr bool SK = WSK;
#define SEAM_K0() do { VMWN(NQL); SWRITE_HK(0); SBAR(); } while (0)
    f32x16 pA0, pA1, pB0, pB1; float mnA, mnB, alA, alB; bf16x8 pa0, pa1, pa2, pa3;
    SWRITE_HV(0); SBAR();
    if (NT > 1) { SLOAD_H(Kh, Vh, kvs, KBASE(1)); }
    SBAR(); qkt<0, SK>(pA0, pA1, K_lds, r32, hi, S.qr, ACT(0));
    MASKT(pA0, pA1, 0); partialSM(pA0, pA1, m_reg, mnA, alA);
    if (NT > 1) { VMW(); SWRITE_H(1); }
    __syncthreads();
#define HALF_STEP(PX0, PX1, mnX, alX, PY0, PY1, alY, t, KB, VB, SB) do {                                                      \
        SBAR(); qkt<KB, SK>(PX0, PX1, K_lds, r32, hi, S.qr, ACT(t));                                             \
        finishSM(PY0, PY1, alY, l_reg, pa0, pa1, pa2, pa3); SBAR();                                                           \
        if ((t) + 1 < NT) { SLOAD_H(Kh, Vh, kvs, KBASE((t) + 1)); SBAR(); }                                               \
        pv_tile<VB, SK>(o, vb0, pa0, pa1, pa2, pa3, ACT((t) - 1)); MASKT(PX0, PX1, (t)); partialSM(PX0, PX1, m_reg, mnX, alX);                                        \
        __syncthreads();                                                                                                      \
        if ((t) + 1 < NT) { VMW(); SWRITE_H(SB); }                                                                          \
        RESC(alX); __syncthreads(); } while (0)
    for (int t = 1; t + 1 < NT; t += 2) {
        HALF_STEP(pB0, pB1, mnB, alB, pA0, pA1, alA, t, 1, 0, 0);
        HALF_STEP(pA0, pA1, mnA, alA, pB0, pB1, alB, t + 1, 0, 1, 1);
    }
    const bool even = (NT & 1) == 0;
    if (even) { SBAR(); qkt<1, SK>(pB0, pB1, K_lds, r32, hi, S.qr, ACT(NT - 1)); SBAR(); }
    { int nkvs_ = nxt.kvs, nqs_ = nxt.qs; asm volatile("" : "+s"(nkvs_), "+s"(nqs_));
      SLOAD_H(nxt.K, nxt.V, nkvs_, kbn); SBAR();
#pragma unroll
        for (int d0 = 0; d0 < 8; ++d0) S.qr[d0] = load8(nxt.Q + (unsigned)((wid * QBLK + r32) * nqs_ + hi * 8) + d0 * 16); }
    SBAR();
    finishSM(pA0, pA1, alA, l_reg, pa0, pa1, pa2, pa3); SBAR();
    pv_tile<0, SK>(o, vb0, pa0, pa1, pa2, pa3, ACT(even ? NT - 2 : NT - 1));
    if (even) { MASKT(pB0, pB1, NT - 1); partialSM(pB0, pB1, m_reg, mnB, alB); __syncthreads(); RESC(alB);
        finishSM(pB0, pB1, alB, l_reg, pa0, pa1, pa2, pa3); SBAR(); pv_tile<1, SK>(o, vb0, pa0, pa1, pa2, pa3, ACT(NT - 1)); }
    SBAR(); SEAM_K0();
    if (hi == 0) li_l[r32] = l_reg; asm volatile("s_waitcnt lgkmcnt(0)" ::: "memory");
    if (cur.L != nullptr && hi == 0) cur.L[(unsigned)((wid * QBLK + r32) * cur.ls)] = m_reg * SCALE + __logf(l_reg);
    float rli[16];
    { int h4_ = 4 * hi; asm volatile("" : "+v"(h4_));
#pragma unroll
    for (int r = 0; r < 16; ++r) rli[r] = __builtin_amdgcn_rcpf(li_l[(r & 3) + 8 * (r >> 2) + h4_]); }
    int os_ = cur.os, hie_ = hi, r32e_ = r32; asm volatile("" : "+s"(os_), "+v"(hie_), "+v"(r32e_));
    bf16* Ow = cur.O + (size_t)(wid * QBLK) * (size_t)os_;
#pragma unroll
    for (int r = 0; r < 16; ++r) { const int orow = crow(r, hie_);
#pragma unroll
        for (int d0 = 0; d0 < 4; ++d0) { const float v = o[d0][r] * rli[r];
            const float vn = __int_as_float(__builtin_amdgcn_mov_dpp(__float_as_int(v), 0xB1, 0xF, 0xF, true));
            if ((r32e_ & 1) == 0) *(unsigned*)(Ow + (unsigned)(orow * os_ + d0 * 32 + r32e_)) = cvtpk(v, vn); } }
    __syncthreads();
#undef RESC
#undef KBASE
#undef ACT
#undef MASKT
#undef SEAM_K0
#undef HALF_STEP
}
#undef ROWP
#undef VMW
#undef VMWN
#undef SLOAD_H
#undef SWRITE_HK
#undef SWRITE_HV
#undef SWRITE_H
#undef KSWZ
#undef SBAR
}
#define GAS __attribute__((address_space(1)))
#define LAS __attribute__((address_space(3)))
typedef unsigned short bf16;
typedef unsigned v4u __attribute__((ext_vector_type(4)));
typedef float f32x4 __attribute__((ext_vector_type(4)));
typedef short bf16x8 __attribute__((ext_vector_type(8)));
typedef GAS unsigned gu32;
typedef GAS unsigned long long gu64;
#define RLX_AGENT __ATOMIC_RELAXED, __HIP_MEMORY_SCOPE_AGENT
#define LDS_WAIT() asm volatile("s_waitcnt lgkmcnt(0)" ::: "memory")
#define VM_WAIT() asm volatile("s_waitcnt vmcnt(0)" ::: "memory")
__device__ __forceinline__ unsigned long long rt() { return __builtin_amdgcn_s_memrealtime(); }
__device__ __forceinline__ unsigned f2bf(float f) { unsigned u = __builtin_bit_cast(unsigned, f); return (u + 0x7fffu + ((u >> 16) & 1u)) >> 16; }
__device__ __forceinline__ unsigned pk2(float lo, float hi) { return f2bf(lo) | (f2bf(hi) << 16); }

#define XB_TMO      128
#define XB_XCNT(j)  (256  + 64 * (j))
#define XB_XSUB(j)  (1280 + 64 * (j))
#define XB_XGEN(j)  (2304 + 64 * (j))
#define XB_TOP      3328
#define XB_TOPGEN   3392
#define XCD_BAR_WORDS 3456
#define XB_SPIN_CAP (1u << 18)

__device__ __forceinline__ unsigned xb_ld(unsigned* p)              { return __hip_atomic_load(p, __ATOMIC_RELAXED, __HIP_MEMORY_SCOPE_AGENT); }
__device__ __forceinline__ unsigned xb_add(unsigned* p, unsigned v) { return __hip_atomic_fetch_add(p, v, __ATOMIC_RELAXED, __HIP_MEMORY_SCOPE_AGENT); }
__device__ __forceinline__ unsigned xb_xcc_id() { return (unsigned)__builtin_amdgcn_s_getreg((3 << 11) | 20) & 0xFu; }
#define XB_SPIN(cond, bar) do { unsigned _sp = 0; while (cond) { __builtin_amdgcn_s_sleep(1); \
    if ((++_sp & 255u) == 0u) { if (xb_ld(&(bar)[XB_TMO])) break; if (_sp > XB_SPIN_CAP) { atomicAdd(&(bar)[XB_TMO], 1u); break; } } } } while (0)

struct XcdBarrier {
    unsigned* bar; unsigned x;
    volatile LAS unsigned* st;
};

__device__ __forceinline__ XcdBarrier xcd_barrier_post(unsigned* bar, volatile LAS unsigned* st, bool leader  ) {
    XcdBarrier b; b.bar = bar; b.x = xb_xcc_id(); b.st = st;
    if (leader) (void)xb_add(&bar[XB_XCNT(b.x)], 1u);
    return b;
}
__device__ __forceinline__ void xcd_barrier_complete(unsigned* bar, unsigned x, unsigned& nloc, unsigned& nx) {
    const unsigned G = gridDim.x * gridDim.y * gridDim.z;
    unsigned sum, cnt, mine, sp = 0u;
    for (;;) {
        sum = 0u; cnt = 0u; mine = 0u;
#pragma unroll
        for (unsigned j = 0; j < 16; ++j) { const unsigned c = xb_ld(&bar[XB_XCNT(j)]); sum += c; cnt += (c > 0u) ? 1u : 0u; mine = (j == x) ? c : mine; }
        if (sum == G) break;
        __builtin_amdgcn_s_sleep(1);
        if ((++sp & 255u) == 0u) { if (xb_ld(&bar[XB_TMO])) break; if (sp > XB_SPIN_CAP) { atomicAdd(&bar[XB_TMO], 1u); break; } }
    }
    nloc = mine > 0u ? mine : 1u; nx = cnt > 0u ? cnt : 1u;
}

__device__ __forceinline__ void xcd_barrier(const XcdBarrier& b, bool leader  ) {
    asm volatile("s_waitcnt vmcnt(0)" ::: "memory");
    __syncthreads();
    if (leader) {
        unsigned* bar = b.bar;
        __builtin_amdgcn_s_waitcnt(0);
        unsigned nloc = b.st[0], nx = b.st[1];
        if (nloc == 0u) { xcd_barrier_complete(bar, b.x, nloc, nx); b.st[0] = nloc; b.st[1] = nx; }
        const unsigned old = xb_add(&bar[XB_XSUB(b.x)], 1u);
        const unsigned gen = old / nloc;
        if (old + 1u == (gen + 1u) * nloc) {
            __builtin_amdgcn_fence(__ATOMIC_RELEASE, "agent");
            asm volatile("s_waitcnt vmcnt(0)" ::: "memory");
            const unsigned og = xb_add(&bar[XB_TOP], 1u);
            const unsigned tg = og / nx;
            if (og + 1u == (tg + 1u) * nx) xb_add(&bar[XB_TOPGEN], 1u);
            else XB_SPIN(xb_ld(&bar[XB_TOPGEN]) == tg, bar);
            __builtin_amdgcn_fence(__ATOMIC_ACQUIRE, "agent");
            xb_add(&bar[XB_XGEN(b.x)], 1u);
            asm volatile("s_waitcnt vmcnt(0)" ::: "memory");
        } else {
            XB_SPIN(xb_ld(&bar[XB_XGEN(b.x)]) == gen, bar);
            __builtin_amdgcn_fence(__ATOMIC_ACQUIRE, "agent");
            asm volatile("s_waitcnt vmcnt(0)" ::: "memory");
        }
    }
    __syncthreads();
}

constexpr int NWAVES = 8;
#ifndef MK_ONE_LAUNCH
#define MK_ONE_LAUNCH 1
#endif

constexpr int BATCH = 4, SEQ = 4096, DM = 2048, M = BATCH * SEQ, HD = 128;
constexpr int NQKV_A = 9216, AGW = 1024, DFF = 8192, NMOD = 6 * DM, NKV = 2 * DM;
constexpr float NORM_EPS = 1e-6f;
constexpr int N_STAGE = 4;
constexpr int N_PHASE = 34;

constexpr size_t MiB = 1u << 20;
constexpr size_t WS_CTL = 0, CTL_ZERO_BYTES = 1 * MiB;
constexpr size_t WS_MOD = 1 * MiB;
constexpr size_t WS_COS = 2 * MiB, WS_SIN = 3 * MiB;
constexpr size_t WS_LA = 4 * MiB;
constexpr size_t WS_MODP = 8 * MiB;
constexpr size_t WS_WQKVA = 40 * MiB;
constexpr size_t WS_WOA = 112 * MiB;
constexpr size_t WS_WKV = 120 * MiB;
constexpr size_t WS_WQB = 136 * MiB;
constexpr size_t WS_WOB = 152 * MiB;
constexpr size_t WS_W1 = 168 * MiB;
constexpr size_t WS_W2 = 296 * MiB;
constexpr size_t WS_H = 424 * MiB;
constexpr size_t WS_AO = 488 * MiB;
constexpr size_t WS_KVB = 552 * MiB;
constexpr size_t WS_QKV = 680 * MiB;
constexpr size_t WS_OP = 968 * MiB;
constexpr size_t WS_H2 = 1224 * MiB;
constexpr size_t WS_END = 1288 * MiB;
constexpr int MOD_TOTAL = 4 * BATCH * NMOD + BATCH * NKV;
constexpr int MOD_KV_OFF = 4 * BATCH * NMOD;
constexpr int GEMV_KC = 32, GEMV_KLEN = DM / GEMV_KC;
constexpr int CW_BAR = 4096;

constexpr int RING_OFF = 0, RING_BYTES = 131072;
constexpr int LDSCTL_OFF = RING_BYTES, MISC_OFF = LDSCTL_OFF + 320;
constexpr int XCH_OFF = RING_BYTES + 1024;
constexpr int LDS_BYTES = 147456;


struct Args {
    const float* x; const float* c; const int* pos; const float* ada_w; const float* ada_b; const float* norm_g;
    const float* a_w_qkv; const float* a_q_gain; const float* a_k_gain; const float* a_w_o;
    const float* kv_ada_w; const float* kv_ada_b; const float* kv_norm_g; const float* kv_w_k; const float* kv_w_v; const float* kv_k_gain;
    const float* b_w_q; const float* b_q_gain; const float* b_lambda; const float* b_subln_g; const float* b_w_o;
    const float* mlp_w1; const float* mlp_w2;
    float* out; unsigned char* ws;
    float inv_freq[16]; float lam_init[2];
    int ph_lo, ph_hi;
};
static_assert(sizeof(Args) == 25 * 8 + 16 * 4 + 2 * 4 + 2 * 4, "Args has no padding bytes");
typedef __attribute__((address_space(4))) const Args* ArgsP;
__device__ __forceinline__ ArgsP get_args() { ArgsP p = (ArgsP)__builtin_amdgcn_kernarg_segment_ptr(); asm volatile("" : "+s"(p)); return p; }
struct Ctx { int tid, lane, wave, G, bx, vcu, gw, NGW; };
__device__ __forceinline__ Ctx fresh_ctx(int wave_s) {
    Ctx c; int ln; asm volatile("v_mbcnt_lo_u32_b32 %0, -1, 0\n\tv_mbcnt_hi_u32_b32 %0, -1, %0" : "=v"(ln));     const int t = wave_s * 64 + ln;
    int G = gridDim.x, bx = blockIdx.x; asm volatile("" : "+s"(G), "+s"(bx));
    c.tid = t; c.lane = t & 63; c.wave = __builtin_amdgcn_readfirstlane(t >> 6); c.G = G; c.bx = bx;
    c.vcu = (G % 8 == 0) ? (bx % 8) * (G / 8) + bx / 8 : bx;
    c.gw = c.vcu * 8 + c.wave; c.NGW = G * 8; return c;
}

typedef unsigned short bfu;
typedef unsigned u32x2 __attribute__((ext_vector_type(2)));

__device__ __forceinline__ float shx(float v, int o, int lane) { return __int_as_float(__builtin_amdgcn_ds_bpermute((lane ^ o) << 2, __float_as_int(v))); }
__device__ __forceinline__ float wave_sum(float v, int lane) {
#pragma unroll
    for (int o = 1; o < 64; o <<= 1) v += shx(v, o, lane);
    return v;
}
__device__ __forceinline__ float bf2f(unsigned bits16) { return __uint_as_float(bits16 << 16); }
__device__ __forceinline__ unsigned pkbf(float lo, float hi) { return pg8::cvt_pk_bf16(lo, hi); }

struct TItem { const float* W; bfu* WT; int K, N, item; };
__device__ __forceinline__ TItem titem_decode(ArgsP a, int it) {
    unsigned char* ws = a->ws; TItem t; int r = it;
    if (r < 4608) { const int l = r / 2304; t.W = a->a_w_qkv + (size_t)l * DM * NQKV_A; t.K = DM; t.N = NQKV_A; t.WT = (bfu*)(ws + WS_WQKVA) + (size_t)l * NQKV_A * DM; t.item = r - l * 2304; }
    else if ((r -= 4608) < 512) { const int l = r / 256; t.W = a->a_w_o + (size_t)l * AGW * DM; t.K = AGW; t.N = DM; t.WT = (bfu*)(ws + WS_WOA) + (size_t)l * DM * AGW; t.item = r - l * 256; }
    else if ((r -= 512) < 512) { t.W = a->kv_w_k; t.K = DM; t.N = DM; t.WT = (bfu*)(ws + WS_WKV); t.item = r; }
    else if ((r -= 512) < 512) { t.W = a->kv_w_v; t.K = DM; t.N = DM; t.WT = (bfu*)(ws + WS_WKV) + (size_t)DM * DM; t.item = r; }
    else if ((r -= 512) < 1024) { const int j = r / 512; t.W = a->b_w_q + (size_t)j * DM * DM; t.K = DM; t.N = DM; t.WT = (bfu*)(ws + WS_WQB) + (size_t)j * DM * DM; t.item = r - j * 512; }
    else if ((r -= 1024) < 1024) { const int j = r / 512; t.W = a->b_w_o + (size_t)j * DM * DM; t.K = DM; t.N = DM; t.WT = (bfu*)(ws + WS_WOB) + (size_t)j * DM * DM; t.item = r - j * 512; }
    else if ((r -= 1024) < 8192) { const int l = r / 2048; t.W = a->mlp_w1 + (size_t)l * DM * DFF; t.K = DM; t.N = DFF; t.WT = (bfu*)(ws + WS_W1) + (size_t)l * DFF * DM; t.item = r - l * 2048; }
    else { r -= 8192; const int l = r / 2048; t.W = a->mlp_w2 + (size_t)l * DFF * DM; t.K = DFF; t.N = DM; t.WT = (bfu*)(ws + WS_W2) + (size_t)l * DM * DFF; t.item = r - l * 2048; }
    return t;
}
typedef float f32x2t __attribute__((ext_vector_type(2)));
__device__ __forceinline__ void titem_run(const TItem& t, int lane, LAS unsigned char* scr  ) {
    const int nb = t.N >> 7, kb = t.item / nb, nbi = t.item - kb * nb, k0 = kb << 6, n0 = nbi << 7;
    const float* src = t.W + (size_t)k0 * t.N + n0 + 2 * lane;
    f32x2t v[64];
#pragma unroll
    for (int i = 0; i < 64; ++i) v[i] = *(const f32x2t*)(src + (size_t)i * t.N);
    const int c = lane & 7, rsub = lane >> 3;
#pragma unroll
    for (int h = 0; h < 2; ++h) {
#pragma unroll
        for (int kk = 0; kk < 8; ++kk) { v4u o; o.x = pkbf(v[8 * kk + 0][h], v[8 * kk + 1][h]); o.y = pkbf(v[8 * kk + 2][h], v[8 * kk + 3][h]); o.z = pkbf(v[8 * kk + 4][h], v[8 * kk + 5][h]); o.w = pkbf(v[8 * kk + 6][h], v[8 * kk + 7][h]);
            *(LAS v4u*)(scr + lane * 144 + kk * 16) = o; }
        asm volatile("s_waitcnt lgkmcnt(0)" ::: "memory");
        bfu* dst = t.WT + (size_t)(n0 + 2 * rsub + h) * t.K + k0 + 8 * c;
#pragma unroll
        for (int j = 0; j < 8; ++j) { const v4u o = *(const LAS v4u*)(scr + (8 * j + rsub) * 144 + c * 16); *(v4u*)(dst + (size_t)(16 * j) * t.K) = o; }
        asm volatile("s_waitcnt lgkmcnt(0)" ::: "memory");
    }
}

__device__ __forceinline__ void p0_prologue(ArgsP a, LAS unsigned char* lds, int tid, int lane, int wave, int vcu, int G) {
    unsigned char* ws = a->ws;
    LAS float* cact = (LAS float*)lds;
    LAS float* ifr = (LAS float*)(lds + 32768);
    for (int i = tid; i < BATCH * DM; i += NWAVES * 64) { const int b = i / DM, k = i - b * DM; const float v = a->c[i]; cact[k * 4 + b] = v / (1.f + expf(-v)); }
    if (tid == 0) {
        ifr[0] = a->inv_freq[0]; ifr[1] = a->inv_freq[1]; ifr[2] = a->inv_freq[2]; ifr[3] = a->inv_freq[3]; ifr[4] = a->inv_freq[4]; ifr[5] = a->inv_freq[5]; ifr[6] = a->inv_freq[6]; ifr[7] = a->inv_freq[7];
        ifr[8] = a->inv_freq[8]; ifr[9] = a->inv_freq[9]; ifr[10] = a->inv_freq[10]; ifr[11] = a->inv_freq[11]; ifr[12] = a->inv_freq[12]; ifr[13] = a->inv_freq[13]; ifr[14] = a->inv_freq[14]; ifr[15] = a->inv_freq[15];
    }
    __syncthreads();
    const int gw = vcu * NWAVES + wave, NGW = G * NWAVES;
    {
        constexpr int ITEMS_L = (NMOD / 256) * GEMV_KC, ITEMS_KV = (NKV / 256) * GEMV_KC, NITEMS = 4 * ITEMS_L + ITEMS_KV;
        float* MODP = (float*)(ws + WS_MODP);
        for (int it = gw; it < NITEMS; it += NGW) {
            const float* W; int N, slab, kc, moff;
            if (it < 4 * ITEMS_L) { const int l = it / ITEMS_L, r = it - l * ITEMS_L; slab = r / GEMV_KC; kc = r - slab * GEMV_KC; W = a->ada_w + (size_t)l * DM * NMOD; N = NMOD; moff = l * BATCH * NMOD; }
            else { const int r = it - 4 * ITEMS_L; slab = r / GEMV_KC; kc = r - slab * GEMV_KC; W = a->kv_ada_w; N = NKV; moff = MOD_KV_OFF; }
            const int n0 = slab * 256 + lane * 4, k0 = kc * GEMV_KLEN;
            f32x4 acc0 = {0.f, 0.f, 0.f, 0.f}, acc1 = acc0, acc2 = acc0, acc3 = acc0;
            const float* wp = W + (size_t)k0 * N + n0;
#pragma unroll 16
            for (int k = 0; k < GEMV_KLEN; ++k) {
                const f32x4 w = *(const f32x4*)(wp + (size_t)k * N);
                const f32x4 cv = *(const LAS f32x4*)(cact + (k0 + k) * 4);
                acc0 += w * cv.x; acc1 += w * cv.y; acc2 += w * cv.z; acc3 += w * cv.w;
            }
            float* mp = MODP + (size_t)kc * MOD_TOTAL + moff + n0;
            *(f32x4*)(mp) = acc0; *(f32x4*)(mp + N) = acc1; *(f32x4*)(mp + 2 * N) = acc2; *(f32x4*)(mp + 3 * N) = acc3;
        }
    }
    {
        float* cosT = (float*)(ws + WS_COS); float* sinT = (float*)(ws + WS_SIN);
        for (int i = vcu * (NWAVES * 64) + tid; i < M * 16; i += G * NWAVES * 64) {
            const int row = i >> 4, j = i & 15; const float ang = (float)a->pos[row] * ifr[j];
            cosT[i] = cosf(ang); sinT[i] = sinf(ang); }
    }
    {
        constexpr int NT_ITEMS = 24576;
        LAS unsigned char* scr = lds + 40960 + wave * 9216;
        for (int it = gw; it < NT_ITEMS; it += NGW) { const TItem t = titem_decode(a, it); titem_run(t, lane, scr); }
    }
}

__device__ __forceinline__ void p0b_modreduce(ArgsP a, int tid, int vcu, int G) {
    const float* MODP = (const float*)(a->ws + WS_MODP); float* MOD = (float*)(a->ws + WS_MOD);
    for (int i4 = vcu * (NWAVES * 64) + tid; i4 < MOD_TOTAL / 4; i4 += G * NWAVES * 64) {
        const int i = i4 * 4; f32x4 s;
        if (i < MOD_KV_OFF) { const int l = i / (BATCH * NMOD), n = i % NMOD; s = *(const f32x4*)(a->ada_b + (size_t)l * NMOD + n); }
        else { const int n = (i - MOD_KV_OFF) % NKV; s = *(const f32x4*)(a->kv_ada_b + n); }
#pragma unroll 8
        for (int kc = 0; kc < GEMV_KC; ++kc) s += *(const f32x4*)(MODP + (size_t)kc * MOD_TOTAL + i);
        *(f32x4*)(MOD + i) = s;
    }
}

template <bool DUAL>
__device__ __forceinline__ void norm_phase(const float* X, const float* g, const float* shift, const float* scale, int bstride, bfu* H,
                                           const float* g2, const float* shift2, const float* scale2, int bstride2, bfu* H2, int lane, int gw, int NGW) {
    for (int rb = gw; rb < M / 8; rb += NGW) {
        const int row0 = rb * 8, b = row0 / SEQ;
        f32x4 gs[8], sh[8];
#pragma unroll
        for (int j = 0; j < 8; ++j) { const int col = 4 * lane + 256 * j;
            const f32x4 gv = *(const f32x4*)(g + col), sc = *(const f32x4*)(scale + (size_t)b * bstride + col);
            gs[j] = gv * (sc + 1.0f); sh[j] = *(const f32x4*)(shift + (size_t)b * bstride + col); }
        for (int r = 0; r < 8; ++r) {
            const float* xr = X + (size_t)(row0 + r) * DM + 4 * lane; f32x4 v[8]; float ss = 0.f;
#pragma unroll
            for (int j = 0; j < 8; ++j) { v[j] = *(const f32x4*)(xr + 256 * j); ss += (v[j].x * v[j].x + v[j].y * v[j].y) + (v[j].z * v[j].z + v[j].w * v[j].w); }
            ss = wave_sum(ss, lane);
            const float rstd = 1.0f / sqrtf(ss * (1.0f / DM) + NORM_EPS);
            bfu* hr = H + (size_t)(row0 + r) * DM + 4 * lane;
#pragma unroll
            for (int j = 0; j < 8; ++j) { const f32x4 o = v[j] * rstd * gs[j] + sh[j]; u32x2 w; w.x = pkbf(o.x, o.y); w.y = pkbf(o.z, o.w); *(u32x2*)(hr + 256 * j) = w; }
            if (DUAL) { bfu* hr2 = H2 + (size_t)(row0 + r) * DM + 4 * lane;
#pragma unroll
                for (int j = 0; j < 8; ++j) { const int col = 4 * lane + 256 * j;
                    const f32x4 gv2 = *(const f32x4*)(g2 + col), sc2 = *(const f32x4*)(scale2 + (size_t)b * bstride2 + col), sh2 = *(const f32x4*)(shift2 + (size_t)b * bstride2 + col);
                    const f32x4 o = v[j] * rstd * (gv2 * (sc2 + 1.0f)) + sh2; u32x2 w; w.x = pkbf(o.x, o.y); w.y = pkbf(o.z, o.w); *(u32x2*)(hr2 + 256 * j) = w; } }
        }
    }
}

__device__ __forceinline__ f32x4 ld_bf4(const bfu* p) { const u32x2 w = *(const u32x2*)p; return (f32x4){bf2f(w.x & 0xffffu), bf2f(w.x >> 16), bf2f(w.y & 0xffffu), bf2f(w.y >> 16)}; }
__device__ __forceinline__ void combineA_phase(const bfu* OP, const float* LA, bfu* AO, int lane, int gw, int NGW) {
    for (int row = gw; row < M; row += NGW) {
#pragma unroll
        for (int j = 0; j < 4; ++j) { const int col = 4 * lane + 256 * j, h = col >> 7;
            const float l0 = LA[(size_t)row * 8 + h], l1 = LA[(size_t)M * 8 + (size_t)row * 8 + h], l2 = LA[(size_t)2 * M * 8 + (size_t)row * 8 + h];
            const float mx = fmaxf(l0, fmaxf(l1, l2)); const float e0 = expf(l0 - mx), e1 = expf(l1 - mx), e2 = expf(l2 - mx); const float inv = 1.0f / (e0 + e1 + e2);
            const f32x4 o0 = ld_bf4(OP + (size_t)row * AGW + col), o1 = ld_bf4(OP + (size_t)M * AGW + (size_t)row * AGW + col), o2 = ld_bf4(OP + (size_t)2 * M * AGW + (size_t)row * AGW + col);
            const f32x4 o = (o0 * e0 + o1 * e1 + o2 * e2) * inv;
            u32x2 w; w.x = pkbf(o.x, o.y); w.y = pkbf(o.z, o.w); *(u32x2*)(AO + (size_t)row * AGW + col) = w; }
    }
}
__device__ __forceinline__ void combineB_phase(const bfu* OP, const float* lp, const float* subg, float lam_init, bfu* AO, int lane, int gw, int NGW) {
    float s1 = lp[lane] * lp[128 + lane] + lp[64 + lane] * lp[192 + lane], s2 = lp[256 + lane] * lp[384 + lane] + lp[320 + lane] * lp[448 + lane];
    s1 = wave_sum(s1, lane); s2 = wave_sum(s2, lane);
    const float lam = expf(s1) - expf(s2) + lam_init;
    const f32x4 sg = *(const f32x4*)(subg + 4 * lane) * (1.0f - lam_init);
    for (int row = gw; row < M; row += NGW) {
        const bfu* p0 = OP + (size_t)row * DM + 4 * lane; const bfu* p1 = p0 + (size_t)M * DM;
        bfu* ao = AO + (size_t)row * DM + 4 * lane;
#pragma unroll
        for (int j = 0; j < 8; ++j) {
            const f32x4 o = ld_bf4(p0 + 256 * j) - ld_bf4(p1 + 256 * j) * lam;
            float ss = (o.x * o.x + o.y * o.y) + (o.z * o.z + o.w * o.w); ss = wave_sum(ss, lane);
            const float rstd = 1.0f / sqrtf(ss * (1.0f / 256.0f) + NORM_EPS);
            const f32x4 r = o * rstd * sg; u32x2 w; w.x = pkbf(r.x, r.y); w.y = pkbf(r.z, r.w); *(u32x2*)(ao + 256 * j) = w; }
    }
}

__device__ __forceinline__ swa::BlockRef attnA_ref(int L, const bfu* QKV, bfu* OP, float* LA) {
    const int g = L >> 9, rem = L & 511, bh = rem >> 4, sub = rem & 15, dsh = 2 * g, d = 1 << dsh;
    const int r = sub >> (4 - dsh), qb = sub & ((16 >> dsh) - 1), b = bh >> 3, h = bh & 7;
    const size_t tok0 = (size_t)b * SEQ + r, tq = tok0 + (size_t)d * 256 * qb;
    swa::BlockRef R;
    R.Q = (const swa::bf16*)(QKV + tq * NQKV_A + g * 3072 + h * 128);
    R.K = (const swa::bf16*)(QKV + tok0 * NQKV_A + g * 3072 + 1024 + h * 128);
    R.V = (const swa::bf16*)(QKV + tok0 * NQKV_A + g * 3072 + 2048 + h * 128);
    R.O = (swa::bf16*)(OP + (size_t)g * M * AGW + tq * AGW + h * 128); R.L = LA + (size_t)g * M * 8 + tq * 8 + h;
    R.qs = d * NQKV_A; R.kvs = d * NQKV_A; R.os = d * AGW; R.ls = d * 8; R.P0 = 256 * qb; R.skv = SEQ >> dsh;
    return R;
}
__device__ __forceinline__ swa::BlockRef attnB_ref(int I, int pass, const bfu* Qb, const bfu* KVB, bfu* OP) {
    const int bh = I >> 5, slot = I & 31, c = slot >> 4, vh = (slot >> 3) & 1, x = slot & 7, qb = pass ? 15 - x : x, b = bh >> 3, h = bh & 7;
    const size_t tq = (size_t)b * SEQ + 256 * qb;
    swa::BlockRef R;
    R.Q = (const swa::bf16*)(Qb + tq * DM + h * 256 + c * 128);
    R.K = (const swa::bf16*)(KVB + (size_t)b * SEQ * NKV + h * 256 + c * 128);
    R.V = (const swa::bf16*)(KVB + (size_t)b * SEQ * NKV + DM + h * 256 + vh * 128);
    R.O = (swa::bf16*)(OP + (size_t)c * M * DM + tq * DM + h * 256 + vh * 128); R.L = nullptr;
    R.qs = DM; R.kvs = NKV; R.os = DM; R.ls = 0; R.P0 = 256 * qb; R.skv = SEQ;
    return R;
}

__global__ void __launch_bounds__(NWAVES * 64, 2) yoco_fwd(Args args_unused) {
    (void)args_unused;
    extern __shared__ __attribute__((aligned(16))) unsigned char lds_raw[];
    LAS unsigned char* lds = (LAS unsigned char*)lds_raw;
    volatile LAS unsigned* MISC = (volatile LAS unsigned*)(lds + MISC_OFF);
    const int wave_s = __builtin_amdgcn_readfirstlane((int)threadIdx.x >> 6);
    for (int u = threadIdx.x; u < (LDS_BYTES - LDSCTL_OFF) / 4; u += NWAVES * 64) ((LAS unsigned*)(lds + LDSCTL_OFF))[u] = 0u;
    __syncthreads();
    int lo, hi; XcdBarrier bar;
    { ArgsP a = get_args(); const Ctx c = fresh_ctx(wave_s); lo = a->ph_lo; hi = a->ph_hi; unsigned* bw = (unsigned*)(a->ws + WS_CTL) + CW_BAR;
      bar.bar = bw; bar.x = 0; bar.st = nullptr;
      if (hi - lo > 1) bar = xcd_barrier_post(bw, MISC + 8, threadIdx.x == 0); }
#define IN(k) (lo <= (k) && (k) < hi)
#define SEAM(k) do { if (IN(k) && IN((k) + 1)) { XcdBarrier bb_ = bar; { GAS unsigned* gb_ = (GAS unsigned*)bar.bar; asm volatile("" : "+s"(gb_), "+s"(bb_.x)); bb_.bar = (unsigned*)gb_; } const Ctx cb_ = fresh_ctx(wave_s); xcd_barrier(bb_, cb_.tid == 0); } } while (0)
#define WSP(T, off) ((T*)(a->ws + (off)))
#ifndef DUP_MASK
#define DUP_MASK 0
#endif
#define NREP(k) (1 + ((DUP_MASK >> (k)) & 1))
#define REPBAR() do { if (rep_ && hi - lo > 1) { XcdBarrier bb_ = bar; { GAS unsigned* gb_ = (GAS unsigned*)bar.bar; asm volatile("" : "+s"(gb_), "+s"(bb_.x)); bb_.bar = (unsigned*)gb_; } const Ctx cb_ = fresh_ctx(wave_s); xcd_barrier(bb_, cb_.tid == 0); } } while (0)

    if ((DUP_MASK >> 15) & 1) { const unsigned long long t0_ = __builtin_amdgcn_s_memrealtime(); while (__builtin_amdgcn_s_memrealtime() - t0_ < 20000ull) __builtin_amdgcn_s_sleep(8); }
    if (IN(0)) for (int rep_ = 0; rep_ < NREP(9); ++rep_) { REPBAR(); const Ctx c = fresh_ctx(wave_s); p0_prologue(get_args(), lds, c.tid, c.lane, c.wave, c.vcu, c.G); }
    SEAM(0);
    if (IN(1)) { const Ctx c = fresh_ctx(wave_s); p0b_modreduce(get_args(), c.tid, c.vcu, c.G); }
    SEAM(1);
    if ((DUP_MASK >> 14) & 1) { for (int xb_ = 0; xb_ < 20; ++xb_) { const int rep_ = 1; REPBAR(); } }

    for (int s = 0; s < N_STAGE; ++s) {
        const int kind = (s < 2) ? 0 : 2;
        const int layer = s;
        const int jb = s - 2;
        const int pb = 2 + 8 * s;
        const bool with_kv = (s == 2);

        if (IN(pb + 0)) for (int rep_ = 0; rep_ < NREP(0); ++rep_) { REPBAR();
            ArgsP a = get_args(); const Ctx c = fresh_ctx(wave_s); const float* MOD = WSP(const float, WS_MOD); bfu* Hb = WSP(bfu, WS_H);
            const float* modl = MOD + (size_t)layer * BATCH * NMOD; const float* Xin = (s == 0) ? a->x : (const float*)a->out;
            if (with_kv) norm_phase<true>(Xin, a->norm_g + (size_t)(layer * 2) * DM, modl, modl + DM, NMOD, Hb, a->kv_norm_g, MOD + MOD_KV_OFF, MOD + MOD_KV_OFF + DM, NKV, WSP(bfu, WS_H2), c.lane, c.gw, c.NGW);
            else norm_phase<false>(Xin, a->norm_g + (size_t)(layer * 2) * DM, modl, modl + DM, NMOD, Hb, nullptr, nullptr, nullptr, 0, nullptr, c.lane, c.gw, c.NGW);
        }
        SEAM(pb + 0);
        if (IN(pb + 1)) for (int rep_ = 0; rep_ < NREP(kind == 0 ? 1 : 13); ++rep_) { REPBAR();
            for (int part = with_kv ? 0 : 1; part < 2; ++part) {
                ArgsP a = get_args(); const Ctx c = fresh_ctx(wave_s);
                const bfu* A; const bfu* Wt; int N; bfu* O; const float* gq; const float* gk; int ek;
                if (part == 0) { A = WSP(const bfu, WS_H2); Wt = WSP(const bfu, WS_WKV); N = NKV; O = WSP(bfu, WS_KVB); gq = a->kv_k_gain; gk = gq; ek = 1; }
                else if (kind == 0) { A = WSP(const bfu, WS_H); Wt = WSP(const bfu, WS_WQKVA) + (size_t)layer * NQKV_A * DM; N = NQKV_A; O = WSP(bfu, WS_QKV); gq = a->a_q_gain + (size_t)layer * 3 * HD; gk = a->a_k_gain + (size_t)layer * 3 * HD; ek = 0; }
                else { A = WSP(const bfu, WS_H); Wt = WSP(const bfu, WS_WQB) + (size_t)jb * DM * DM; N = DM; O = WSP(bfu, WS_QKV); gq = a->b_q_gain + (size_t)jb * 2 * HD; gk = gq; ek = 2; }
                pg8::Gemm g{A, Wt, M, N, DM}; pg8::StaticOrder S; S.init(M, N, c.G, c.bx);
                pg8::EpiQK E{O, N, ek, gq, gk, WSP(const float, WS_COS), WSP(const float, WS_SIN), (LAS float*)(lds + XCH_OFF), NORM_EPS};
                pg8::gemm_phase<pg8::EpiQK, pg8::StaticOrder, true, true>(lds + RING_OFF, g, S, E, c.tid);
            }
        }
        SEAM(pb + 1);
        if (IN(pb + 2)) for (int rep_ = 0; rep_ < NREP(kind == 0 ? 2 : 10); ++rep_) { REPBAR();
            if (kind == 0) {
                ArgsP a = get_args(); const Ctx c = fresh_ctx(wave_s);
                const bfu* QKV = WSP(const bfu, WS_QKV); bfu* OP = WSP(bfu, WS_OP);
                float* LA = WSP(float, WS_LA);
                const int total = 1536; const int G = c.G; int L = c.bx;
                if (L < total) {
                    swa::BlockRef cur = attnA_ref(L, QKV, OP, LA); swa::Seam SS;
                    swa::causal_swa_prime(cur, 129, (char*)lds_raw, SS, c.tid);
                    for (;;) {
                        const bool more = L + G < total;
                        const swa::BlockRef nxt = more ? attnA_ref(L + G, QKV, OP, LA) : cur;
                        swa::causal_swa_block<true>(cur, nxt, 129, (char*)lds_raw, SS, c.tid);
                        if (!more) break;
                        cur = nxt; L += G;
                    }
                }
            } else {
                ArgsP a = get_args(); const Ctx c = fresh_ctx(wave_s);
                const bfu* QKV = WSP(const bfu, WS_QKV); bfu* OP = WSP(bfu, WS_OP);
                const bfu* KVB = WSP(const bfu, WS_KVB); const int G = c.G, vcu = c.vcu;
                const int nit = (G == 256) ? 4 : (vcu < 1024 ? (1024 - vcu + G - 1) / G : 0);
                int n = 0; const int nblk = 2 * nit;
#define ITEM_OF(i) ((G == 256) ? ((vcu >> 5) * 128 + (i) * 32 + (vcu & 31)) : (vcu + (i) * G))
                if (nblk > 0) {
                    swa::BlockRef cur = attnB_ref(ITEM_OF(0), 0, QKV, KVB, OP); swa::Seam SS;
                    swa::causal_swa_prime(cur, SEQ, (char*)lds_raw, SS, c.tid);
                    for (;;) {
                        const bool more = n + 1 < nblk;
                        const swa::BlockRef nxt = more ? attnB_ref(ITEM_OF((n + 1) >> 1), (n + 1) & 1, QKV, KVB, OP) : cur;
                        swa::causal_swa_block<false>(cur, nxt, SEQ, (char*)lds_raw, SS, c.tid);
                        if (!more) break;
                        cur = nxt; ++n;
                    }
                }
#undef ITEM_OF
            }
        }
        SEAM(pb + 2);
        if (IN(pb + 3)) for (int rep_ = 0; rep_ < NREP(kind == 0 ? 3 : 11); ++rep_) { REPBAR();
            ArgsP a = get_args(); const Ctx c = fresh_ctx(wave_s);
            if (kind == 0) combineA_phase(WSP(const bfu, WS_OP), WSP(const float, WS_LA), WSP(bfu, WS_AO), c.lane, c.gw, c.NGW);
            else combineB_phase(WSP(const bfu, WS_OP), a->b_lambda + (size_t)jb * 4 * HD, a->b_subln_g + (size_t)jb * 256, jb == 0 ? a->lam_init[0] : a->lam_init[1], WSP(bfu, WS_AO), c.lane, c.gw, c.NGW);
        }
        SEAM(pb + 3);
        if (IN(pb + 4)) for (int rep_ = 0; rep_ < NREP(4); ++rep_) { REPBAR();
            ArgsP a = get_args(); const Ctx c = fresh_ctx(wave_s);
            const bfu* Wt; int K;
            if (kind == 0) { Wt = WSP(const bfu, WS_WOA) + (size_t)layer * DM * AGW; K = AGW; }
            else { Wt = WSP(const bfu, WS_WOB) + (size_t)jb * DM * DM; K = DM; }
            pg8::Gemm g{WSP(const bfu, WS_AO), Wt, M, DM, K}; pg8::StaticOrder S; S.init(M, DM, c.G, c.bx);
            pg8::EpiRes E{(s == 0) ? a->x : (const float*)a->out, rep_ ? WSP(float, WS_OP) : a->out, DM, WSP(const float, WS_MOD) + (size_t)layer * BATCH * NMOD + 2 * DM, NMOD, SEQ};
            pg8::gemm_phase<pg8::EpiRes, pg8::StaticOrder, true, true>(lds + RING_OFF, g, S, E, c.tid);
        }
        SEAM(pb + 4);
        if (IN(pb + 5)) for (int rep_ = 0; rep_ < NREP(5); ++rep_) { REPBAR();
            ArgsP a = get_args(); const Ctx c = fresh_ctx(wave_s); const float* modl = WSP(const float, WS_MOD) + (size_t)layer * BATCH * NMOD;
            norm_phase<false>(a->out, a->norm_g + (size_t)(layer * 2 + 1) * DM, modl + 3 * DM, modl + 4 * DM, NMOD, WSP(bfu, WS_H), nullptr, nullptr, nullptr, 0, nullptr, c.lane, c.gw, c.NGW);
        }
        SEAM(pb + 5);
        if (IN(pb + 6)) for (int rep_ = 0; rep_ < (((DUP_MASK >> 16) & 1) ? 2 : NREP(6)); ++rep_) { REPBAR();
            ArgsP a = get_args(); const Ctx c = fresh_ctx(wave_s);
            pg8::Gemm g{WSP(const bfu, WS_H), WSP(const bfu, WS_W1) + (size_t)layer * DFF * DM, M, DFF, DM}; pg8::StaticOrder S; S.init(M, DFF, c.G, c.bx);
            if ((DUP_MASK >> 16) & 1) { S.i0 = rep_ * 4; S.i1 = rep_ * 4 + 4; }
            pg8::EpiBf16<1> E{WSP(bfu, WS_QKV), DFF};
            pg8::gemm_phase<pg8::EpiBf16<1>, pg8::StaticOrder, true, true>(lds + RING_OFF, g, S, E, c.tid);
        }
        SEAM(pb + 6);
        if (IN(pb + 7)) for (int rep_ = 0; rep_ < NREP(7); ++rep_) { REPBAR();
            ArgsP a = get_args(); const Ctx c = fresh_ctx(wave_s);
            pg8::Gemm g{WSP(const bfu, WS_QKV), WSP(const bfu, WS_W2) + (size_t)layer * DM * DFF, M, DM, DFF}; pg8::StaticOrder S; S.init(M, DM, c.G, c.bx);
            pg8::EpiRes E{a->out, rep_ ? WSP(float, WS_OP) : a->out, DM, WSP(const float, WS_MOD) + (size_t)layer * BATCH * NMOD + 5 * DM, NMOD, SEQ};
            pg8::gemm_phase<pg8::EpiRes, pg8::StaticOrder, true, true>(lds + RING_OFF, g, S, E, c.tid);
        }
        SEAM(pb + 7);
    }
#undef IN
#undef SEAM
#undef WSP
#undef REPBAR
}

extern "C" void kernel_launch(void* const* d_in, const int* in_sizes, int n_in, void* d_out, int out_size, void* d_ws, size_t ws_size, hipStream_t stream) {
    static int grid = 0;
    if (grid == 0) {
        if (n_in != 23 || in_sizes[0] != M * DM || out_size != M * DM || ws_size < WS_END) { fprintf(stderr, "kernel_launch: unexpected shapes (n_in %d, in0 %d, out %d, ws %zu); nothing launched\n", n_in, n_in > 0 ? in_sizes[0] : -1, out_size, ws_size); grid = -1; return; }
        int dev = 0, cus = 0, per_cu = 0;
        if (hipGetDevice(&dev) != hipSuccess || hipDeviceGetAttribute(&cus, hipDeviceAttributeMultiprocessorCount, dev) != hipSuccess) { fprintf(stderr, "kernel_launch: hipGetDevice / hipDeviceGetAttribute failed\n"); grid = -1; return; }
        if (hipFuncSetAttribute((const void*)yoco_fwd, hipFuncAttributeMaxDynamicSharedMemorySize, LDS_BYTES) != hipSuccess) { fprintf(stderr, "kernel_launch: hipFuncSetAttribute failed\n"); grid = -1; return; }
        if (hipOccupancyMaxActiveBlocksPerMultiprocessor(&per_cu, (const void*)yoco_fwd, NWAVES * 64, LDS_BYTES) != hipSuccess || per_cu < 1)
            fprintf(stderr, "kernel_launch: note: occupancy query reports %d workgroups per CU\n", per_cu);
        (void)hipGetLastError();
        grid = cus;
    }
    if (grid < 0) return;
    if (hipMemsetAsync((char*)d_ws + WS_CTL, 0, CTL_ZERO_BYTES, stream) != hipSuccess) { fprintf(stderr, "kernel_launch: hipMemsetAsync failed\n"); return; }
    Args ha{};
    ha.x = (const float*)d_in[0]; ha.c = (const float*)d_in[1]; ha.pos = (const int*)d_in[2]; ha.ada_w = (const float*)d_in[3]; ha.ada_b = (const float*)d_in[4]; ha.norm_g = (const float*)d_in[5];
    ha.a_w_qkv = (const float*)d_in[6]; ha.a_q_gain = (const float*)d_in[7]; ha.a_k_gain = (const float*)d_in[8]; ha.a_w_o = (const float*)d_in[9];
    ha.kv_ada_w = (const float*)d_in[10]; ha.kv_ada_b = (const float*)d_in[11]; ha.kv_norm_g = (const float*)d_in[12]; ha.kv_w_k = (const float*)d_in[13]; ha.kv_w_v = (const float*)d_in[14]; ha.kv_k_gain = (const float*)d_in[15];
    ha.b_w_q = (const float*)d_in[16]; ha.b_q_gain = (const float*)d_in[17]; ha.b_lambda = (const float*)d_in[18]; ha.b_subln_g = (const float*)d_in[19]; ha.b_w_o = (const float*)d_in[20];
    ha.mlp_w1 = (const float*)d_in[21]; ha.mlp_w2 = (const float*)d_in[22];
    ha.out = (float*)d_out; ha.ws = (unsigned char*)d_ws;
    for (int j = 0; j < 16; ++j) ha.inv_freq[j] = (float)pow(500000.0, -(double)(2 * j) / 32.0);
    ha.lam_init[0] = (float)(0.8 - 0.6 * exp(-0.3 * 2.0)); ha.lam_init[1] = (float)(0.8 - 0.6 * exp(-0.3 * 3.0));
#if MK_ONE_LAUNCH
    ha.ph_lo = 0; ha.ph_hi = N_PHASE;
    hipLaunchKernelGGL(yoco_fwd, dim3(grid), dim3(NWAVES * 64), LDS_BYTES, stream, ha);
    { const hipError_t le = hipPeekAtLastError(); if (le != hipSuccess) fprintf(stderr, "kernel_launch: launch failed: %s\n", hipGetErrorName(le)); }
#else
    for (int p = 0; p < N_PHASE; ++p) {
        ha.ph_lo = p; ha.ph_hi = p + 1;
        hipLaunchKernelGGL(yoco_fwd, dim3(grid), dim3(NWAVES * 64), LDS_BYTES, stream, ha);
        const hipError_t le = hipPeekAtLastError(); if (le != hipSuccess) { fprintf(stderr, "kernel_launch: launch %d failed: %s\n", p, hipGetErrorName(le)); break; }
    }
#endif
}
```
